# Optimizing an MI355X kernel written in HIP

```python
import numpy as np
import jax
import jax.numpy as jnp
from jax import lax

D_MODEL = 2048
BATCH = 4
SEQ = 2048
DEPTH = 2

GRID_W = 64
CTX_LEN = 256
NORM_EPS = 1e-6
ROPE_BASE = 10000.0
Q_BLOCK = 128
CHUNK = 64

MLA_HEADS = 8
MLA_Q_RANK = 512
MLA_KV_RANK = 256
MLA_NOPE = 128
MLA_ROPE = 64
MLA_V = 128

GLA_HEADS = 4
GLA_DK = 64
GLA_DV = 128
GLA_GATE_RANK = 16
GLA_TAU = 16.0

RET_HEADS = 4
RET_DK = 128
RET_DV = 128
RET_DECAY_EXP0 = 5.0

N_EXPERTS = 16
EXPERT_FF = 2048
EC_CAPACITY = 2

MIX_WIDTH = MLA_HEADS * MLA_V + GLA_HEADS * GLA_DV + RET_HEADS * RET_DV
IN_SPLITS = (MLA_Q_RANK, MLA_KV_RANK, MLA_ROPE,
             GLA_HEADS * GLA_DK, GLA_HEADS * GLA_DK, GLA_HEADS * GLA_DV, 2 * GLA_GATE_RANK, GLA_HEADS * GLA_DV,
             RET_HEADS * RET_DK, RET_HEADS * RET_DK, RET_HEADS * RET_DV, RET_HEADS * RET_DV)
IN_COLS = sum(IN_SPLITS)

kernel_name = 'hybrid_mla_gla_retention_ecmoe_dit'


def rms_norm(x, gain=None):
    xf = x.astype(jnp.float32)
    y = xf * lax.rsqrt(jnp.mean(xf * xf, axis=-1, keepdims=True) + NORM_EPS)
    if gain is not None:
        y = y * gain.astype(jnp.float32)
    return y.astype(x.dtype)


def heads(t, n_heads):
    b, n, _ = t.shape
    return t.reshape(b, n, n_heads, -1).transpose(0, 2, 1, 3)


def merge_heads(t):
    b, h, n, d = t.shape
    return t.transpose(0, 2, 1, 3).reshape(b, n, h * d)


def rotate_pairs(x, cos, sin):
    cos = cos.astype(x.dtype)
    sin = sin.astype(x.dtype)
    x1 = x[..., 0::2]
    x2 = x[..., 1::2]
    return jnp.stack([x1 * cos - x2 * sin, x1 * sin + x2 * cos], axis=-1).reshape(x.shape)


def axial_rope_angles(rows):
    row = jnp.repeat(jnp.arange(rows, dtype=jnp.float32), GRID_W)
    col = jnp.tile(jnp.arange(GRID_W, dtype=jnp.float32), rows)
    n_freq = MLA_ROPE // 4
    inv = jnp.power(ROPE_BASE, -jnp.arange(n_freq, dtype=jnp.float32) / n_freq)
    ang = jnp.concatenate([row[:, None] * inv, col[:, None] * inv], axis=-1)
    return jnp.cos(ang), jnp.sin(ang)


def retention_angles(n_tokens):
    inv = 1.0 / jnp.power(ROPE_BASE, jnp.linspace(0.0, 1.0, RET_DK // 2, dtype=jnp.float32))
    ang = jnp.arange(n_tokens, dtype=jnp.float32)[:, None] * inv
    return jnp.cos(ang), jnp.sin(ang)


def retention_log_decay(direction):
    e = RET_DECAY_EXP0 + direction + 2.0 * jnp.arange(RET_HEADS, dtype=jnp.float32)
    return jnp.log1p(-jnp.exp2(-e))


def block_attention(q, k, v):
    b, h, n, dq = q.shape
    nb = n // Q_BLOCK
    qb = jnp.moveaxis(q.reshape(b, h, nb, Q_BLOCK, dq), 2, 0)

    def one_block(qblk):
        s = jnp.einsum('bhqd,bhkd->bhqk', qblk, k, preferred_element_type=jnp.float32)
        p = jax.nn.softmax(s, axis=-1).astype(v.dtype)
        return jnp.einsum('bhqk,bhkd->bhqd', p, v)

    o = lax.map(one_block, qb)
    return jnp.moveaxis(o, 0, 2).reshape(b, h, n, v.shape[-1])


def chunk_scan(q, k, v, log_a, s0, strict):
    b, h, n, kd = q.shape
    vd = v.shape[-1]
    nc = n // CHUNK

    def split(t):
        return jnp.moveaxis(t.astype(jnp.float32).reshape(b, h, nc, CHUNK, t.shape[-1]), 2, 0)

    mask = jnp.tril(jnp.ones((CHUNK, CHUNK), dtype=bool), -1 if strict else 0)

    def step(state, inp):
        qc, kc, vc, ac = inp
        cum = jnp.cumsum(ac, axis=2)
        q_dec = qc * jnp.exp(cum)
        k_inv = kc * jnp.exp(-cum)
        att = jnp.where(mask, jnp.einsum('bhik,bhjk->bhij', q_dec, k_inv), 0.0)
        o = jnp.einsum('bhij,bhjv->bhiv', att, vc) + jnp.einsum('bhik,bhkv->bhiv', q_dec, state)
        cum_end = cum[:, :, -1:, :]
        k_end = kc * jnp.exp(cum_end - cum)
        new_state = jnp.exp(cum_end[:, :, 0, :])[..., None] * state + jnp.einsum('bhjk,bhjv->bhkv', k_end, vc)
        return new_state, o

    final, o = lax.scan(step, s0.astype(jnp.float32), (split(q), split(k), split(v), split(log_a)))
    o = jnp.moveaxis(o, 0, 2).reshape(b, h, n, vd)
    return o.astype(v.dtype), final


def bidirectional_recurrence(q, k, v, la_f, la_b, qc, kc, vc, lac_f, lac_b):
    b, h, _, kd = q.shape
    s0 = jnp.zeros((b, h, kd, v.shape[-1]), jnp.float32)

    def flip(t):
        return jnp.flip(t, axis=2)

    oc_f, sc_f = chunk_scan(qc, kc, vc, lac_f, s0, False)
    oc_b, sc_b = chunk_scan(flip(qc), flip(kc), flip(vc), flip(lac_b), s0, True)
    o_f, _ = chunk_scan(q, k, v, la_f, sc_f, False)
    o_b, _ = chunk_scan(flip(q), flip(k), flip(v), flip(la_b), sc_b, True)
    return o_f + flip(o_b), oc_f + flip(oc_b)


def mla_mixer(lat, ctx, q_norm, w_uq, kv_norm, w_ukv, cos_a, sin_a, need_ctx):
    cq, ckv, kr = lat
    cq_c, ckv_c, kr_c = ctx
    scale = (MLA_NOPE + MLA_ROPE) ** -0.5

    def project_q(cq_):
        return heads(rms_norm(cq_, q_norm) @ w_uq, MLA_HEADS)

    def project_kv(ckv_):
        kv = heads(rms_norm(ckv_, kv_norm) @ w_ukv, MLA_HEADS)
        return kv[..., :MLA_NOPE], kv[..., MLA_NOPE:]

    def full_key(k_nope, k_rope):
        return jnp.concatenate([k_nope, jnp.broadcast_to(k_rope[:, None], k_nope.shape[:3] + (MLA_ROPE,))], axis=-1)

    q = project_q(cq)
    q = jnp.concatenate([q[..., :MLA_NOPE], rotate_pairs(q[..., MLA_NOPE:], cos_a, sin_a)], axis=-1) * scale
    k_nope, v = project_kv(ckv)
    k = full_key(k_nope, rotate_pairs(kr, cos_a, sin_a))
    kc_nope, vc = project_kv(ckv_c)
    kc = full_key(kc_nope, kr_c)
    o = block_attention(q, jnp.concatenate([kc, k], axis=2), jnp.concatenate([vc, v], axis=2))
    y = merge_heads(o)
    yc = None
    if need_ctx:
        qc = project_q(cq_c) * scale
        yc = merge_heads(block_attention(qc, kc, vc))
    return y, yc


def gla_mixer(lat, ctx, w2, b2, need_ctx):
    def prep(q, k, v, z):
        b, n, _ = z.shape
        z = z.reshape(b, n, 2, GLA_GATE_RANK)
        logits = jnp.einsum('bndr,drk->bndk', z, w2) + b2
        log_a = jax.nn.log_sigmoid(logits.astype(jnp.float32)) / GLA_TAU
        return (heads(q, GLA_HEADS) * GLA_DK ** -0.5, heads(k, GLA_HEADS), heads(v, GLA_HEADS),
                heads(log_a[:, :, 0], GLA_HEADS), heads(log_a[:, :, 1], GLA_HEADS))

    q, k, v, z, og = lat
    qc, kc, vc, zc, ogc = ctx
    o, oc = bidirectional_recurrence(*prep(q, k, v, z), *prep(qc, kc, vc, zc))
    y = merge_heads(rms_norm(o)) * jax.nn.silu(og)
    yc = merge_heads(rms_norm(oc)) * jax.nn.silu(ogc) if need_ctx else None
    return y, yc


def retention_mixer(lat, ctx, cos_r, sin_r, need_ctx):
    q, k, v, g = lat
    qc, kc, vc, gc = ctx
    sk = RET_DK ** -0.5
    q = rotate_pairs(heads(q, RET_HEADS), cos_r, sin_r)
    k = rotate_pairs(heads(k, RET_HEADS), cos_r, sin_r) * sk
    v = heads(v, RET_HEADS)
    qc = heads(qc, RET_HEADS)
    kc = heads(kc, RET_HEADS) * sk
    vc = heads(vc, RET_HEADS)
    ld_f = retention_log_decay(0.0)
    ld_b = retention_log_decay(1.0)

    def decay(ld, t):
        return jnp.broadcast_to(ld[None, :, None, None], t.shape)

    o, oc = bidirectional_recurrence(q, k, v, decay(ld_f, q), decay(ld_b, q),
                                     qc, kc, vc, decay(ld_f, qc), decay(ld_b, qc))
    y = merge_heads(rms_norm(o)) * jax.nn.silu(g)
    yc = merge_heads(rms_norm(oc)) * jax.nn.silu(gc) if need_ctx else None
    return y, yc


def token_mixers(h, hc, w_in, q_norm, w_uq, kv_norm, w_ukv, gla_w2, gla_b, cos_a, sin_a, cos_r, sin_r, need_ctx):
    cuts = np.cumsum(IN_SPLITS)[:-1].tolist()
    lat = jnp.split(h @ w_in, cuts, axis=-1)
    ctx = jnp.split(hc @ w_in, cuts, axis=-1)
    y_a, yc_a = mla_mixer(lat[0:3], ctx[0:3], q_norm, w_uq, kv_norm, w_ukv, cos_a, sin_a, need_ctx)
    y_b, yc_b = gla_mixer(lat[3:8], ctx[3:8], gla_w2, gla_b, need_ctx)
    y_c, yc_c = retention_mixer(lat[8:12], ctx[8:12], cos_r, sin_r, need_ctx)
    y = jnp.concatenate([y_a, y_b, y_c], axis=-1)
    yc = jnp.concatenate([yc_a, yc_b, yc_c], axis=-1) if need_ctx else None
    return y, yc


def expert_choice_ffn(h, router_w, w_gate, w_up, w_down):
    b, n, _ = h.shape
    cap = EC_CAPACITY * n // N_EXPERTS
    aff = jax.nn.softmax((h @ router_w).astype(jnp.float32), axis=-1)
    gate, idx = lax.top_k(jnp.swapaxes(aff, 1, 2), cap)
    bidx = jnp.arange(b)[:, None, None]
    xs = h[bidx, idx]
    a = jnp.einsum('becd,edf->becf', xs, w_gate)
    u = jnp.einsum('becd,edf->becf', xs, w_up)
    y = jnp.einsum('becf,efd->becd', jax.nn.silu(a) * u, w_down) * gate[..., None].astype(h.dtype)
    return jnp.zeros_like(h).at[bidx, idx].add(y)


def setup_inputs(seed: int = 0) -> dict:
    key = jax.random.key(seed)
    ks = jax.random.split(key, 19)

    def nrm(k, shape, s):
        return jax.random.normal(k, shape, jnp.float32) * s

    L = DEPTH
    D = D_MODEL
    return {
        'x': nrm(ks[0], (BATCH, SEQ, D), 1.0),
        'c': nrm(ks[1], (BATCH, D), 1.0),
        'ctx': nrm(ks[2], (BATCH, CTX_LEN, D), 1.0),
        'c_ctx': nrm(ks[3], (D,), 1.0),
        'ada_w': nrm(ks[4], (L, D, 6 * D), 0.5 * D ** -0.5),
        'ada_b': nrm(ks[5], (L, 6 * D), 0.01),
        'w_in': nrm(ks[6], (L, D, IN_COLS), D ** -0.5),
        'mla_q_norm': 1.0 + nrm(ks[7], (L, MLA_Q_RANK), 0.02),
        'mla_w_uq': nrm(ks[8], (L, MLA_Q_RANK, MLA_HEADS * (MLA_NOPE + MLA_ROPE)), MLA_Q_RANK ** -0.5),
        'mla_kv_norm': 1.0 + nrm(ks[9], (L, MLA_KV_RANK), 0.02),
        'mla_w_ukv': nrm(ks[10], (L, MLA_KV_RANK, MLA_HEADS * (MLA_NOPE + MLA_V)), MLA_KV_RANK ** -0.5),
        'gla_gate_w2': nrm(ks[11], (L, 2, GLA_GATE_RANK, GLA_HEADS * GLA_DK), GLA_GATE_RANK ** -0.5),
        'gla_gate_b': nrm(ks[12], (L, 2, GLA_HEADS * GLA_DK), 0.1),
        'w_out': nrm(ks[13], (L, MIX_WIDTH, D), MIX_WIDTH ** -0.5),
        'router_w': nrm(ks[14], (L, D, N_EXPERTS), D ** -0.5),
        'exp_w_gate': nrm(ks[15], (L, N_EXPERTS, D, EXPERT_FF), D ** -0.5),
        'exp_w_up': nrm(ks[16], (L, N_EXPERTS, D, EXPERT_FF), D ** -0.5),
        'exp_w_down': nrm(ks[17], (L, N_EXPERTS, EXPERT_FF, D), EXPERT_FF ** -0.5),
        'final_norm': 1.0 + nrm(ks[18], (D,), 0.02),
    }


def reference(x, c, ctx, c_ctx, ada_w, ada_b, w_in, mla_q_norm, mla_w_uq, mla_kv_norm, mla_w_ukv,
              gla_gate_w2, gla_gate_b, w_out, router_w, exp_w_gate, exp_w_up, exp_w_down, final_norm):
    n_lat = x.shape[1]
    rows = n_lat // GRID_W
    cos_a, sin_a = axial_rope_angles(rows)
    cos_r, sin_r = retention_angles(n_lat)
    silu_c = jax.nn.silu(c)
    silu_cc = jax.nn.silu(c_ctx)
    for l in range(DEPTH):
        need_ctx = l < DEPTH - 1
        mod = (silu_c @ ada_w[l] + ada_b[l])[:, None, :]
        mod_c = silu_cc @ ada_w[l] + ada_b[l]
        sh_a, sc_a, g_a, sh_f, sc_f, g_f = jnp.split(mod, 6, axis=-1)
        csh_a, csc_a, cg_a, csh_f, csc_f, cg_f = jnp.split(mod_c, 6, axis=-1)

        h = rms_norm(x) * (1.0 + sc_a) + sh_a
        hc = rms_norm(ctx) * (1.0 + csc_a) + csh_a
        y, yc = token_mixers(h, hc, w_in[l], mla_q_norm[l], mla_w_uq[l], mla_kv_norm[l], mla_w_ukv[l],
                             gla_gate_w2[l], gla_gate_b[l], cos_a, sin_a, cos_r, sin_r, need_ctx)
        x = x + g_a * (y @ w_out[l])
        h = rms_norm(x) * (1.0 + sc_f) + sh_f
        x = x + g_f * expert_choice_ffn(h, router_w[l], exp_w_gate[l], exp_w_up[l], exp_w_down[l])
        if need_ctx:
            ctx = ctx + cg_a * (yc @ w_out[l])
            hc = rms_norm(ctx) * (1.0 + csc_f) + csh_f
            ctx = ctx + cg_f * expert_choice_ffn(hc, router_w[l], exp_w_gate[l], exp_w_up[l], exp_w_down[l])
    return rms_norm(x, final_norm)
```

```cpp
#include <hip/hip_runtime.h>
#include <stdint.h>
#include <stdio.h>

#ifndef MK_ONE_LAUNCH
#define MK_ONE_LAUNCH 1
#endif

#define DEVI __device__ __forceinline__
typedef unsigned short bf16_t;
typedef short bf16x8 __attribute__((ext_vector_type(8)));
typedef short s16x4 __attribute__((ext_vector_type(4)));
typedef float f32x2 __attribute__((ext_vector_type(2)));
typedef float f32x4 __attribute__((ext_vector_type(4)));
typedef float f32x8 __attribute__((ext_vector_type(8)));
typedef float f32x16 __attribute__((ext_vector_type(16)));
typedef unsigned u32x2 __attribute__((ext_vector_type(2)));
typedef unsigned u32x4 __attribute__((ext_vector_type(4)));
typedef int i32x4 __attribute__((ext_vector_type(4)));
typedef __bf16 bf16x2_t __attribute__((ext_vector_type(2)));

constexpr int DM = 2048, NB = 4, SEQ = 2048, CL = 256, NLAT = NB * SEQ, NCTX = NB * CL, NROW = NLAT + NCTX;
constexpr int INC = 4448, INCP = 4608;
constexpr int C_CQ = 0, C_CKV = 512, C_KR = 768, C_GQ = 832, C_GK = 1088, C_GV = 1344, C_GZ = 1856, C_GOG = 1888, C_RQ = 2400, C_RK = 2912, C_RV = 3424, C_RG = 3936;
constexpr int KEYS = SEQ + CL;
constexpr int NCH = 36;
constexpr int MSLOT = 1280;
constexpr float QSCALE = 0.07216878364870322f;
constexpr float EPS = 1e-6f;

constexpr size_t al256(size_t x) { return (x + 255) / 256 * 256; }
constexpr size_t WS_BAR = 0;
constexpr size_t WS_MOD = 16384;
constexpr size_t WS_RAX = WS_MOD + al256((size_t)2 * 5 * 12288 * 4);
constexpr size_t WS_RRET = WS_RAX + al256((size_t)64 * 16 * 2 * 4);
constexpr size_t WS_WIN = WS_RRET + al256((size_t)2048 * 64 * 2 * 4);
constexpr size_t WS_WUQ = WS_WIN + al256((size_t)2 * INCP * 2048 * 2);
constexpr size_t WS_WUKV = WS_WUQ + al256((size_t)2 * 1536 * 512 * 2);
constexpr size_t WS_WOUT = WS_WUKV + al256((size_t)2 * 2048 * 256 * 2);
constexpr size_t WS_WGU = WS_WOUT + al256((size_t)2 * 2048 * 2048 * 2);
constexpr size_t WS_WDN = WS_WGU + al256((size_t)2 * 16 * 4096 * 2048 * 2);
constexpr size_t WS_XRES = WS_WDN + al256((size_t)2 * 16 * 2048 * 2048 * 2);
constexpr size_t WS_H = WS_XRES + al256((size_t)NROW * DM * 4);
constexpr size_t WS_P = WS_H + al256((size_t)NROW * DM * 2);
constexpr size_t WS_Q = WS_P + al256((size_t)NROW * INC * 2);
constexpr size_t WS_K = WS_Q + al256((size_t)NB * 8 * KEYS * 192 * 2);
constexpr size_t WS_V = WS_K + al256((size_t)NB * 8 * KEYS * 192 * 2);
constexpr size_t WS_YMIX = WS_V + al256((size_t)NB * 8 * KEYS * 128 * 2);
constexpr size_t WS_UTG = WS_YMIX + al256((size_t)NROW * DM * 2);
constexpr size_t WS_UTR = WS_UTG + al256((size_t)32 * NCH * 128 * 64 * 4);
constexpr size_t WS_STG = WS_UTR + al256((size_t)32 * NCH * 128 * 128 * 4);
constexpr size_t WS_STR = WS_STG + al256((size_t)32 * NCH * 128 * 64 * 2);
constexpr size_t WS_DECG = WS_STR + al256((size_t)32 * NCH * 128 * 128 * 2);
constexpr size_t WS_AFF = WS_DECG + al256((size_t)32 * NCH * 64 * 4);
constexpr size_t WS_RANK = WS_AFF + al256((size_t)NB * 16 * KEYS * 4);
constexpr size_t WS_SELROW = WS_RANK + al256((size_t)NB * 16 * KEYS * 4);
constexpr size_t WS_SELGATE = WS_SELROW + al256((size_t)16 * MSLOT * 4);
constexpr size_t WS_ACT = WS_SELGATE + al256((size_t)16 * MSLOT * 4);
constexpr size_t WS_YDN = WS_ACT + al256((size_t)16 * MSLOT * 2048 * 2);
constexpr size_t WS_END = WS_YDN + al256((size_t)16 * MSLOT * 2048 * 2);

constexpr int MODCNT_WORD = 3584, P0_N_MOD_ITEMS = 512, PFXCNT_WORD = 3648;
constexpr int LDS_RS = 131072, LDS_XB = 131072 + 8192, LDS_BYTES = 131072 + 8192 + 64;
#ifndef SUBMASK
#define SUBMASK 0xFF
#endif
#define SUB(n) if constexpr ((SUBMASK >> (n)) & 1)

struct Params {
    const float *x, *c, *ctx, *c_ctx, *ada_w, *ada_b, *w_in, *q_norm, *w_uq, *kv_norm, *w_ukv, *gla_w2, *gla_b, *w_out, *router_w, *w_gate, *w_up, *w_down, *final_norm;
    float* out; char* ws; int ph_lo, ph_hi;
};

DEVI unsigned cvt_pk(float lo, float hi) { f32x2 v = {lo, hi}; bf16x2_t b = __builtin_convertvector(v, bf16x2_t); return __builtin_bit_cast(unsigned, b); }
DEVI bf16_t f2bf(float x) { return (bf16_t)(cvt_pk(x, 0.f) & 0xffffu); }
DEVI float bf2f(bf16_t b) { return __uint_as_float(((unsigned)b) << 16); }
DEVI float bflo(unsigned w) { return __uint_as_float(w << 16); }
DEVI float bfhi(unsigned w) { return __uint_as_float(w & 0xffff0000u); }
DEVI int obid() { int b = blockIdx.x; asm volatile("" : "+s"(b)); return b; }
DEVI int opaque_tid() { int t = threadIdx.x; asm volatile("" : "+v"(t)); return t; }
typedef int i32x8 __attribute__((ext_vector_type(8)));
DEVI float clamp8(float x) { return __builtin_amdgcn_fmed3f(x, -448.f, 448.f); }
DEVI unsigned cvt4_fp8(float a, float b, float c, float d) { int w = 0; w = __builtin_amdgcn_cvt_pk_fp8_f32(a, b, w, false); w = __builtin_amdgcn_cvt_pk_fp8_f32(c, d, w, true); return (unsigned)w; }
DEVI unsigned cvt4_fp8c(float a, float b, float c, float d) { return cvt4_fp8(clamp8(a), clamp8(b), clamp8(c), clamp8(d)); }
constexpr float W8_SCALE = 64.f, ACT8_SCALE = 4.f;
DEVI float silu_f(float x) { return x / (1.f + __expf(-x)); }
DEVI float wave_sum(float s) {
#pragma unroll
    for (int off = 32; off >= 1; off >>= 1) s += __shfl_xor(s, off);
    return s;
}
DEVI void unpack8(bf16x8 v, float (&f)[8]) {
    u32x4 w = __builtin_bit_cast(u32x4, v);
#pragma unroll
    for (int i = 0; i < 4; ++i) { f[2 * i] = bflo(w[i]); f[2 * i + 1] = bfhi(w[i]); }
}
DEVI bf16x8 pack8(const float (&f)[8]) {
    u32x4 w = {cvt_pk(f[0], f[1]), cvt_pk(f[2], f[3]), cvt_pk(f[4], f[5]), cvt_pk(f[6], f[7])};
    return __builtin_bit_cast(bf16x8, w);
}

#define XB_TMO      128
#define XB_XCNT(j)  (256  + 64 * (j))
#define XB_XSUB(j)  (1280 + 64 * (j))
#define XB_XGEN(j)  (2304 + 64 * (j))
#define XB_TOP      3328
#define XB_TOPGEN   3392
#define XCD_BAR_WORDS 3456
#define XB_SPIN_CAP (1u << 18)
#define LAS __attribute__((address_space(3)))
DEVI unsigned xb_ld(unsigned* p)              { return __hip_atomic_load(p, __ATOMIC_RELAXED, __HIP_MEMORY_SCOPE_AGENT); }
DEVI unsigned xb_add(unsigned* p, unsigned v) { return __hip_atomic_fetch_add(p, v, __ATOMIC_RELAXED, __HIP_MEMORY_SCOPE_AGENT); }
DEVI unsigned xb_xcc_id() { return (unsigned)__builtin_amdgcn_s_getreg((3 << 11) | 20) & 0xFu; }
#define XB_SPIN(cond, bar) do { unsigned _sp = 0; while (cond) { __builtin_amdgcn_s_sleep(1); \
    if ((++_sp & 255u) == 0u) { if (xb_ld(&(bar)[XB_TMO])) break; if (_sp > XB_SPIN_CAP) { atomicAdd(&(bar)[XB_TMO], 1u); break; } } } } while (0)
struct XcdBarrier { unsigned* bar; unsigned x; volatile LAS unsigned* st; };
DEVI XcdBarrier xcd_barrier_post(unsigned* bar, volatile LAS unsigned* st) {
    XcdBarrier b; b.bar = bar; b.x = xb_xcc_id(); b.st = st;
    if (threadIdx.x == 0) (void)xb_add(&bar[XB_XCNT(b.x)], 1u);
    return b;
}
DEVI void xcd_barrier_complete(unsigned* bar, unsigned x, unsigned& nloc, unsigned& nx) {
    const unsigned G = gridDim.x * gridDim.y * gridDim.z;
    unsigned sum, cnt, mine, sp = 0u;
    for (;;) {
        sum = 0u; cnt = 0u; mine = 0u;
#pragma unroll
        for (unsigned j = 0; j < 16; ++j) { const unsigned c = xb_ld(&bar[XB_XCNT(j)]); sum += c; cnt += (c > 0u) ? 1u : 0u; mine = (j == x) ? c : mine; }
        if (sum == G) break;
        __builtin_amdgcn_s_sleep(1);
        if ((++sp & 255u) == 0u) { if (xb_ld(&bar[XB_TMO])) break; if (sp > XB_SPIN_CAP) { atomicAdd(&bar[XB_TMO], 1u); break; } }
    }
    nloc = mine > 0u ? mine : 1u; nx = cnt > 0u ? cnt : 1u;
}
DEVI void xcd_barrier(const XcdBarrier& b) {
    asm volatile("s_waitcnt vmcnt(0)" ::: "memory");
    __syncthreads();
    if (threadIdx.x == 0) {
        unsigned* bar = b.bar;
        __builtin_amdgcn_s_waitcnt(0);
        unsigned nloc = b.st[0], nx = b.st[1];
        if (nloc == 0u) { xcd_barrier_complete(bar, b.x, nloc, nx); b.st[0] = nloc; b.st[1] = nx; }
        const unsigned old = xb_add(&bar[XB_XSUB(b.x)], 1u);
        const unsigned gen = old / nloc;
        if (old + 1u == (gen + 1u) * nloc) {
            __builtin_amdgcn_fence(__ATOMIC_RELEASE, "agent");
            asm volatile("s_waitcnt vmcnt(0)" ::: "memory");
            const unsigned og = xb_add(&bar[XB_TOP], 1u);
            const unsigned tg = og / nx;
            if (og + 1u == (tg + 1u) * nx) xb_add(&bar[XB_TOPGEN], 1u);
            else XB_SPIN(xb_ld(&bar[XB_TOPGEN]) == tg, bar);
            __builtin_amdgcn_fence(__ATOMIC_ACQUIRE, "agent");
            xb_add(&bar[XB_XGEN(b.x)], 1u);
            asm volatile("s_waitcnt vmcnt(0)" ::: "memory");
        } else {
            XB_SPIN(xb_ld(&bar[XB_XGEN(b.x)]) == gen, bar);
            __builtin_amdgcn_fence(__ATOMIC_ACQUIRE, "agent");
            asm volatile("s_waitcnt vmcnt(0)" ::: "memory");
        }
    }
    __syncthreads();
}

namespace pg8 {
constexpr int BM = 256, BK = 64, HALF = 128, HTB = HALF * BK * 2, STAGE_BYTES = 8 * HTB;
DEVI int lds_byte(int r, int c) { const int st = (r >> 4) * 2 + (c >> 5), rr = r & 15, cc = c & 31, ob = rr * 64 + cc * 2; return st * 1024 + (ob ^ (((ob >> 9) & 1) << 5)); }
DEVI void stage_rc(int b, int& R, int& C) { const int st = b / 1024, sb = b % 1024, swz = sb ^ (((sb >> 9) & 1) << 5); R = (st >> 1) * 16 + swz / 64; C = (st & 1) * 32 + (swz % 64) / 2; }
DEVI int perm32(int rho) { const int n = rho >> 4, i = rho & 15; return 8 * (i >> 2) + 4 * n + (i & 3); }
struct Unit { const char* A; const char* B; int pm, pn, e, ord, half; };

template <class Sched, class Epi, bool FP8 = false>
DEVI void gemm_phase(LAS unsigned char* lds, const int K, const Sched& S, const Epi& E) {
    const int tid = opaque_tid(), wid = __builtin_amdgcn_readfirstlane(tid >> 6), lane = tid & 63, wr = wid >> 2, wc = wid & 3, fr = lane & 15, fq = lane >> 4;
    const int nt = K / BK;
    int R0, C0, R1, C1; stage_rc(tid * 16, R0, C0); stage_rc(tid * 16 + 8192, R1, C1);
    unsigned voffB[2];
    { const int Rb0 = Epi::PERM ? ((R0 & ~31) + perm32(R0 & 31)) : R0, Rb1 = Epi::PERM ? ((R1 & ~31) + perm32(R1 & 31)) : R1;
      voffB[0] = (unsigned)(Rb0 * K + C0) * 2u; voffB[1] = (unsigned)(Rb1 * K + C1) * 2u; }
    const size_t kstep = (size_t)(BK * 2);
    const size_t hstepB = (size_t)HALF * K * 2;
    const unsigned ldsw = (unsigned)wid * 1024u;
    const int aoff = lds_byte(wr * 64 + fr, fq * 8), boff = lds_byte(wc * 32 + fr, fq * 8);
#define PG8_SA(b, h) (((b) * 2 + (h)) * HTB)
#define PG8_SB(b, h) ((4 + (b) * 2 + (h)) * HTB)
#define PG8_STAGE2(bufoff, gbase, v0, v1) do { \
        __builtin_amdgcn_global_load_lds((const unsigned*)((const char*)(gbase) + (v0)), (LAS unsigned*)(lds + (bufoff) + ldsw), 16, 0, 0); \
        __builtin_amdgcn_global_load_lds((const unsigned*)((const char*)(gbase) + (v1)), (LAS unsigned*)(lds + (bufoff) + ldsw + 8192), 16, 0, 0); } while (0)
#define PG8_STAGEB(bufoff, gbase) PG8_STAGE2(bufoff, gbase, voffB[0], voffB[1])
#define PG8_RD8(addr) __builtin_shufflevector(*(const LAS i32x4*)(addr), *(const LAS i32x4*)((addr) + 1024), 0, 1, 2, 3, 4, 5, 6, 7)
#define PG8_LDA(dst, b, h) do { if constexpr (FP8) { _Pragma("unroll") for (int m = 0; m < 4; ++m) dst##8[m] = PG8_RD8(lds + PG8_SA(b, h) + aoff + m * 2048); } \
        else { _Pragma("unroll") for (int m = 0; m < 4; ++m) _Pragma("unroll") for (int k = 0; k < 2; ++k) dst[m][k] = *(const LAS bf16x8*)(lds + PG8_SA(b, h) + aoff + m * 2048 + k * 1024); } } while (0)
#define PG8_LDB(dst, b, h) do { if constexpr (FP8) { _Pragma("unroll") for (int n = 0; n < 2; ++n) dst##8[n] = PG8_RD8(lds + PG8_SB(b, h) + boff + n * 2048); } \
        else { _Pragma("unroll") for (int n = 0; n < 2; ++n) _Pragma("unroll") for (int k = 0; k < 2; ++k) dst[n][k] = *(const LAS bf16x8*)(lds + PG8_SB(b, h) + boff + n * 2048 + k * 1024); } } while (0)
#define PG8_MMA(ai, bj, At, Bt) do { __builtin_amdgcn_s_setprio(1); _Pragma("unroll") for (int m = 0; m < 4; ++m) _Pragma("unroll") for (int n = 0; n < 2; ++n) { \
        if constexpr (FP8) asm volatile("v_mfma_scale_f32_16x16x128_f8f6f4 %0, %1, %2, %0, %3, %3 op_sel_hi:[0,0,0]" : "+v"(acc[ai][bj][m][n]) : "v"(Bt##8[n]), "v"(At##8[m]), "v"(mx_one));   \
        else { _Pragma("unroll") for (int k = 0; k < 2; ++k) acc[ai][bj][m][n] = __builtin_amdgcn_mfma_f32_16x16x32_bf16(Bt[n][k], At[m][k], acc[ai][bj][m][n], 0, 0, 0); } } \
        __builtin_amdgcn_s_setprio(0); } while (0)
#define PG8_WAIT_V(n) asm volatile("s_waitcnt vmcnt(" #n ")" ::: "memory")
#define PG8_WAIT_L(n) asm volatile("s_waitcnt lgkmcnt(" #n ")" ::: "memory")
#define PG8_BAR __builtin_amdgcn_s_barrier()
#define PG8_SCHED __builtin_amdgcn_sched_barrier(0)
    Unit cur, nxt; int ui = 0;
    if (!S.next(0, cur)) return;
    f32x4 acc[2][2][4][2];
#pragma unroll
    for (int a = 0; a < 2; ++a)
#pragma unroll
        for (int b = 0; b < 2; ++b)
#pragma unroll
            for (int m = 0; m < 4; ++m)
#pragma unroll
                for (int n = 0; n < 2; ++n) acc[a][b][m][n] = (f32x4){0.f, 0.f, 0.f, 0.f};
    bf16x8 At[4][2], B0[2][2], B1[2][2];
    i32x8 At8[4], B08[2], B18[2];
    const int mx_one = 0x7f7f7f7f;
    unsigned vc[4], vn[4];
    S.aoff(cur, R0, C0, R1, C1, vc);
    const char* cA = cur.A; const char* cB = cur.B;
    PG8_STAGEB(PG8_SB(0, 0), cB); PG8_STAGEB(PG8_SB(0, 1), cB + hstepB); PG8_STAGE2(PG8_SA(0, 0), cA, vc[0], vc[1]); PG8_STAGE2(PG8_SA(0, 1), cA, vc[2], vc[3]);
    if (wr == 1) PG8_BAR;
    PG8_WAIT_V(2); PG8_BAR;
    PG8_STAGEB(PG8_SB(1, 0), cB + kstep); PG8_STAGE2(PG8_SA(1, 0), cA + kstep, vc[0], vc[1]); PG8_STAGEB(PG8_SB(1, 1), cB + hstepB + kstep);
    PG8_WAIT_V(6); PG8_BAR;
    for (;;) {
        const bool has_next = S.next(ui + 1, nxt);
        if (has_next) S.aoff(nxt, R0, C0, R1, C1, vn);
        else { vn[0] = vc[0]; vn[1] = vc[1]; vn[2] = vc[2]; vn[3] = vc[3]; }
        const char* nA = has_next ? nxt.A : cA; const char* nB = has_next ? nxt.B : cB;
        const bool chalf = cur.half != 0;
#pragma nounroll
        for (int t = 0; t < nt; t += 2) {
            const bool last = (t == nt - 2);
            const char* a1 = cA + (size_t)(t + 1) * kstep;
            const char* a2 = last ? nA : cA + (size_t)(t + 2) * kstep; const char* b2 = last ? nB : cB + (size_t)(t + 2) * kstep;
            const char* a3 = a2 + kstep; const char* b3 = b2 + kstep;
            const unsigned w0 = last ? vn[0] : vc[0], w1 = last ? vn[1] : vc[1], w2 = last ? vn[2] : vc[2], w3 = last ? vn[3] : vc[3];
            PG8_LDB(B0, 0, 0); PG8_LDB(B1, 0, 1); PG8_SCHED; PG8_LDA(At, 0, 0); PG8_STAGE2(PG8_SA(1, 1), a1, vc[2], vc[3]);
            PG8_WAIT_V(8); PG8_WAIT_L(0); PG8_BAR; PG8_MMA(0, 0, At, B0); PG8_MMA(0, 1, At, B1); PG8_BAR; PG8_SCHED;
            PG8_LDA(At, 0, 1); PG8_STAGEB(PG8_SB(0, 0), b2); PG8_STAGEB(PG8_SB(0, 1), b2 + hstepB); PG8_STAGE2(PG8_SA(0, 0), a2, w0, w1);
            PG8_WAIT_V(8); PG8_WAIT_L(0); PG8_BAR; if (!chalf) { PG8_MMA(1, 0, At, B0); PG8_MMA(1, 1, At, B1); } PG8_BAR; PG8_SCHED;
            PG8_LDB(B0, 1, 0); PG8_LDB(B1, 1, 1); PG8_SCHED; PG8_LDA(At, 1, 0); PG8_STAGE2(PG8_SA(0, 1), a2, w2, w3);
            PG8_WAIT_V(8); PG8_WAIT_L(0); PG8_BAR; PG8_MMA(0, 0, At, B0); PG8_MMA(0, 1, At, B1); PG8_BAR; PG8_SCHED;
            PG8_LDA(At, 1, 1); PG8_STAGEB(PG8_SB(1, 0), b3); PG8_STAGEB(PG8_SB(1, 1), b3 + hstepB); PG8_STAGE2(PG8_SA(1, 0), a3, w0, w1);
            PG8_WAIT_V(8); PG8_WAIT_L(0); PG8_BAR; if (!chalf) { PG8_MMA(1, 0, At, B0); PG8_MMA(1, 1, At, B1); } PG8_BAR; PG8_SCHED;
        }
        if (wr == 0) PG8_BAR;
        E(acc, cur, wr, wc, fr, fq);
        if (!has_next) break;
#pragma unroll
        for (int a = 0; a < 2; ++a)
#pragma unroll
            for (int b = 0; b < 2; ++b)
#pragma unroll
                for (int m = 0; m < 4; ++m)
#pragma unroll
                    for (int n = 0; n < 2; ++n) acc[a][b][m][n] = (f32x4){0.f, 0.f, 0.f, 0.f};
        cur = nxt; cA = nA; cB = nB; ++ui; vc[0] = vn[0]; vc[1] = vn[1]; vc[2] = vn[2]; vc[3] = vn[3];
        if (wr == 1) PG8_BAR;
    }
    PG8_WAIT_V(0);
    PG8_BAR;
#undef PG8_SA
#undef PG8_SB
#undef PG8_STAGE2
#undef PG8_STAGEB
#undef PG8_LDA
#undef PG8_LDB
#undef PG8_MMA
#undef PG8_RD8
#undef PG8_WAIT_V
#undef PG8_WAIT_L
#undef PG8_BAR
#undef PG8_SCHED
}
struct PlainSched {
    const bf16_t* A; const bf16_t* Bt; int lda, acol0, K, nM, nN, units;
    DEVI bool next(int i, Unit& u) const {
        const int g = obid() + i * gridDim.x; if (g >= units) return false;
        int wgid = g; { const int q = units / 8, r = units % 8, xcd = wgid % 8, off = wgid / 8; wgid = (xcd < r ? xcd * (q + 1) : r * (q + 1) + (xcd - r) * q) + off; }
        const int nig = 8 * nN, gid = wgid / nig, fm = gid * 8, gsz = (nM - fm) < 8 ? (nM - fm) : 8;
        u.pm = fm + ((wgid % nig) % gsz); u.pn = (wgid % nig) / gsz; u.e = 0; u.ord = i; u.half = 0;
        u.A = (const char*)(A + (size_t)u.pm * 256 * lda + acol0); u.B = (const char*)(Bt + (size_t)u.pn * 256 * K); return true; }
    DEVI void aoff(const Unit&, int R0, int C0, int R1, int C1, unsigned (&o)[4]) const {
        o[0] = (unsigned)(R0 * lda + C0) * 2u; o[1] = (unsigned)(R1 * lda + C1) * 2u; o[2] = (unsigned)((128 + R0) * lda + C0) * 2u; o[3] = (unsigned)((128 + R1) * lda + C1) * 2u; }
};
}

DEVI void p0_mod_item(const Params& p, int item, char* smem) {
    const int l = item / 256, cb = item % 256, n0 = cb * 48;
    float* sv = (float*)smem;
    float* red = (float*)(smem + 65536);
    const int tid = opaque_tid(), wid = tid >> 6, lane = tid & 63;
    for (int idx = tid; idx < 2048; idx += 512) {
#pragma unroll
        for (int b = 0; b < 4; ++b) sv[idx * 8 + b] = silu_f(p.c[b * 2048 + idx]);
        sv[idx * 8 + 4] = silu_f(p.c_ctx[idx]);
    }
    __syncthreads();
    const int ln_c = lane < 48 ? lane : 47;
    const float* W = p.ada_w + (size_t)l * 2048 * 12288 + n0 + ln_c;
    float a0 = 0.f, a1 = 0.f, a2 = 0.f, a3 = 0.f, a4 = 0.f;
#pragma unroll 32
    for (int kk = 0; kk < 256; ++kk) {
        const int k = wid * 256 + kk;
        const float w = W[(size_t)k * 12288];
        const f32x4 s = *(const f32x4*)(sv + k * 8); const float s4 = sv[k * 8 + 4];
        a0 += s[0] * w; a1 += s[1] * w; a2 += s[2] * w; a3 += s[3] * w; a4 += s4 * w;
    }
    red[(wid * 5 + 0) * 64 + lane] = a0; red[(wid * 5 + 1) * 64 + lane] = a1; red[(wid * 5 + 2) * 64 + lane] = a2;
    red[(wid * 5 + 3) * 64 + lane] = a3; red[(wid * 5 + 4) * 64 + lane] = a4;
    __syncthreads();
    if (tid < 320 && (tid & 63) < 48) {
        const int i = tid >> 6, ln = tid & 63; float s = 0.f;
#pragma unroll
        for (int w = 0; w < 8; ++w) s += red[(w * 5 + i) * 64 + ln];
        float* mod = (float*)(p.ws + WS_MOD);
        __hip_atomic_store(&mod[(size_t)(l * 5 + i) * 12288 + n0 + ln], s + p.ada_b[l * 12288 + n0 + ln], __ATOMIC_RELAXED, __HIP_MEMORY_SCOPE_AGENT);
    }
    asm volatile("s_waitcnt vmcnt(0)" ::: "memory");
    __syncthreads();
    if (tid == 0) __hip_atomic_fetch_add((unsigned*)(p.ws + WS_BAR) + MODCNT_WORD, 1u, __ATOMIC_RELAXED, __HIP_MEMORY_SCOPE_AGENT);
}
DEVI void wait_mod(const Params& p) {
    if (threadIdx.x == 0) {
        unsigned* c = (unsigned*)(p.ws + WS_BAR) + MODCNT_WORD; unsigned sp = 0;
        while (__hip_atomic_load(c, __ATOMIC_RELAXED, __HIP_MEMORY_SCOPE_AGENT) < (unsigned)P0_N_MOD_ITEMS) { __builtin_amdgcn_s_sleep(2); if (++sp > (1u << 22)) break; }
        __builtin_amdgcn_fence(__ATOMIC_ACQUIRE, "agent");
        asm volatile("s_waitcnt vmcnt(0)" ::: "memory");
    }
    __syncthreads();
}

struct CvtD { const float* src; const float* scale; bf16_t* dst; int ldn, nvalid, K, k0, n0, d0; };
DEVI CvtD p0_bf16_desc(const Params& p, int j) {
    CvtD d;
    if (j < 1152) { const int l = j / 576, r = j % 576, kt = r / 36, nt = r % 36;
        d = CvtD{p.w_in + (size_t)l * 2048 * INC, nullptr, (bf16_t*)(p.ws + WS_WIN) + (size_t)l * INCP * 2048, INC, INC, 2048, kt * 128, nt * 128, nt * 128}; return d; }
    j -= 1152;
    if (j < 96) { const int l = j / 48, r = j % 48, kt = r / 12, nt = r % 12;
        d = CvtD{p.w_uq + (size_t)l * 512 * 1536, p.q_norm + l * 512, (bf16_t*)(p.ws + WS_WUQ) + (size_t)l * 1536 * 512, 1536, 1536, 512, kt * 128, nt * 128, nt * 128}; return d; }
    j -= 96;
    if (j < 64) { const int l = j / 32, r = j % 32, kt = r / 16, nt = r % 16;
        d = CvtD{p.w_ukv + (size_t)l * 256 * 2048, p.kv_norm + l * 256, (bf16_t*)(p.ws + WS_WUKV) + (size_t)l * 2048 * 256, 2048, 2048, 256, kt * 128, nt * 128, nt * 128}; return d; }
    j -= 64;
    { const int l = j / 256, r = j % 256, kt = r / 16, nt = r % 16;
        d = CvtD{p.w_out + (size_t)l * 2048 * 2048, nullptr, (bf16_t*)(p.ws + WS_WOUT) + (size_t)l * 2048 * 2048, 2048, 2048, 2048, kt * 128, nt * 128, nt * 128}; return d; }
}
struct CvtRegs { f32x4 v[8]; };
DEVI void cvt_tile_load(const CvtD& d, CvtRegs& rg) {
    const int tid = opaque_tid(), nq = tid & 31, kq0 = tid >> 5;
#pragma unroll
    for (int it = 0; it < 2; ++it)
#pragma unroll
        for (int kk = 0; kk < 4; ++kk) { const int k = d.k0 + (kq0 + it * 16) * 4 + kk, n = d.n0 + nq * 4;
            f32x4 v = (n < d.nvalid) ? *(const f32x4*)(d.src + (size_t)k * d.ldn + n) : (f32x4){0.f, 0.f, 0.f, 0.f};
            if (d.scale) v *= d.scale[k];
            rg.v[it * 4 + kk] = v; }
}
DEVI void cvt_tile_finish(const CvtD& d, const CvtRegs& rg, char* smem) {
    bf16_t* T = (bf16_t*)smem;
    const int tid = opaque_tid(), nq = tid & 31, kq0 = tid >> 5;
#pragma unroll
    for (int it = 0; it < 2; ++it) { const int kq = kq0 + it * 16;
#pragma unroll
        for (int j = 0; j < 4; ++j) { u32x2 w = {cvt_pk(rg.v[it * 4][j], rg.v[it * 4 + 1][j]), cvt_pk(rg.v[it * 4 + 2][j], rg.v[it * 4 + 3][j])};
            *(u32x2*)(T + (nq * 4 + j) * 132 + kq * 4) = w; } }
    __syncthreads();
#pragma unroll
    for (int i = 0; i < 8; ++i) { const int nl = (tid >> 5) + 16 * i, kc = (tid & 31) * 4;
        *(u32x2*)(d.dst + (size_t)(d.d0 + nl) * d.K + d.k0 + kc) = *(const u32x2*)(T + nl * 132 + kc); }
    __syncthreads();
}

struct CvtIn { f32x4 v[8]; };
DEVI void cvt8_load(const Params& p, int L, int t, CvtIn& in) {
    const int which = t / 4096, r = t % 4096, le = L * 16 + r / 256, kt = (r % 256) / 16, nt = r % 16;
    const float* src = (which == 2 ? p.w_down : (which == 0 ? p.w_gate : p.w_up)) + (size_t)le * 2048 * 2048;
    const int tid = opaque_tid(), nq = tid & 31, kq0 = tid >> 5;
#pragma unroll
    for (int it = 0; it < 2; ++it)
#pragma unroll
        for (int kk = 0; kk < 4; ++kk) in.v[it * 4 + kk] = __builtin_nontemporal_load((const f32x4*)(src + (size_t)(kt * 128 + (kq0 + it * 16) * 4 + kk) * 2048 + nt * 128 + nq * 4));
}
DEVI void cvt8_finish(const Params& p, int L, int t, const CvtIn& in, char* smem) {
    const int which = t / 4096, r = t % 4096, le = L * 16 + r / 256, kt = (r % 256) / 16, nt = r % 16;
    unsigned char* dst = (which == 2) ? (unsigned char*)(p.ws + WS_WDN) + (size_t)le * 2048 * 2048 + (size_t)(nt * 128) * 2048
                                      : (unsigned char*)(p.ws + WS_WGU) + (size_t)le * 4096 * 2048 + (size_t)(nt * 256 + which * 128) * 2048;
    unsigned char* T = (unsigned char*)smem;
    const int tid = opaque_tid(), nq = tid & 31, kq0 = tid >> 5;
#pragma unroll
    for (int it = 0; it < 2; ++it) { const int kq = kq0 + it * 16;
#pragma unroll
        for (int j = 0; j < 4; ++j) *(unsigned*)(T + (nq * 4 + j) * 144 + kq * 4) =
            cvt4_fp8(in.v[it * 4][j] * W8_SCALE, in.v[it * 4 + 1][j] * W8_SCALE, in.v[it * 4 + 2][j] * W8_SCALE, in.v[it * 4 + 3][j] * W8_SCALE); }
    __syncthreads();
#pragma unroll
    for (int i = 0; i < 2; ++i) { const int nl = (tid >> 3) + 64 * i, kc = (tid & 7) * 16;
        *(u32x4*)(dst + (size_t)nl * 2048 + kt * 128 + kc) = *(const u32x4*)(T + nl * 144 + kc); }
    __syncthreads();
}
DEVI void cvt8_stream(const Params& p, int L, int t0, int step, int count, char* smem) {
    if (count <= 0) return;
    CvtIn cur; cvt8_load(p, L, t0, cur);
    for (int i = 0; i < count; ++i) { const int t = t0 + i * step; CvtIn nxt;
        if (i + 1 < count) cvt8_load(p, L, t + step, nxt);
        cvt8_finish(p, L, t, cur, smem);
        cur = nxt; }
}
DEVI void cvt8_stream3(const Params& p, int L, int t0, int count, char* smem) {
    if (count <= 0) return;
    CvtIn a, b; cvt8_load(p, L, t0, a);
    if (count > 1) cvt8_load(p, L, t0 + 1, b);
#pragma nounroll
    for (int i = 0; i < count; ++i) { CvtIn c;
        if (i + 2 < count) cvt8_load(p, L, t0 + i + 2, c);
        cvt8_finish(p, L, t0 + i, a, smem);
        a = b; b = c; }
}
#ifndef TAILT_WIN
#define TAILT_WIN 18
#endif
#ifndef TAILT_WOUT
#define TAILT_WOUT 14
#endif
#ifndef TAILT_DN
#define TAILT_DN 10
#endif
constexpr int TAIL_WIN_B0 = 648 - 2 * 256, TAIL_WOUT_B0 = 288 - 256, TAIL_DN_B0 = 640 - 2 * 256;
constexpr int T0A = (256 - TAIL_WIN_B0) * TAILT_WIN, T0B = T0A + (256 - TAIL_WOUT_B0) * TAILT_WOUT, T1A = (256 - TAIL_DN_B0) * TAILT_DN, T1B = T1A + (256 - TAIL_WIN_B0) * TAILT_WIN;
static_assert(T0B <= 12288 && T1B <= 12288, "tail tiles");
DEVI void tail_convert(const Params& p, int L, int first_block, int base, int ntile, char* smem) {
    if (gridDim.x != 256 || obid() < first_block) return;
    const int t0 = base + (obid() - first_block) * ntile;
    cvt8_stream3(p, L, t0, ntile, smem);
}
#ifndef RANKT0
#define RANKT0 18
#endif
#ifndef RANKT1
#define RANKT1 18
#endif
constexpr int T0C = T0B + 192 * RANKT0, T1C = T1B + 192 * RANKT1;
static_assert(T0C <= 12288 && T1C <= 12288, "tail tiles");
constexpr int SCAN_A_UNITS = 2 * 16 * NCH, SCAN_C0_UNITS = 2 * 16 * NCH, SCAN_C1_UNITS = 2 * 16 * 32;
constexpr int TS0A = 12288 - SCAN_A_UNITS - SCAN_C0_UNITS, TS0C = 12288 - SCAN_C0_UNITS;
constexpr int TS1A = 12288 - SCAN_A_UNITS - SCAN_C1_UNITS, TS1C = 12288 - SCAN_C1_UNITS;
static_assert(T0C <= TS0A && T1C <= TS1A, "scan tiles");
constexpr int P0_N_MOD = 512, P0_N_WIN = 2 * 16 * 36, P0_N_WUQ = 2 * 4 * 12, P0_N_WUKV = 2 * 2 * 16, P0_N_WOUT = 2 * 16 * 16, P0_N_EXP0 = TS0A - T0C, P0_N_EXP = (TS0A - T0C) + (TS1A - T1C), P0_N_TAB = (1024 + 2048 * 64) / 512;
constexpr int P0_ITEMS = P0_N_MOD + P0_N_WIN + P0_N_WUQ + P0_N_WUKV + P0_N_WOUT + P0_N_EXP + P0_N_TAB;

DEVI void phase_p0(const Params& p, char* smem) {
    if (gridDim.x != 256) {
        { const int b0 = obid(), G = gridDim.x; if (b0 < T0C) cvt8_stream(p, 0, b0, G, (T0C - b0 + G - 1) / G, smem); if (b0 < T1C) cvt8_stream(p, 1, b0, G, (T1C - b0 + G - 1) / G, smem); }
    }
    for (int item = obid(); item < P0_ITEMS; item += gridDim.x) {
        int j = item;
        if (j < P0_N_MOD) { p0_mod_item(p, j, smem); continue; }
        j -= P0_N_MOD;
        if (j < P0_N_WIN + P0_N_WUQ + P0_N_WUKV + P0_N_WOUT) continue;
        j -= P0_N_WIN + P0_N_WUQ + P0_N_WUKV + P0_N_WOUT;
        if (j < P0_N_EXP) continue;
        j -= P0_N_EXP;
        {
            const int idx = j * 512 + threadIdx.x;
            if (idx < 1024) { const int pos = idx >> 4, f = idx & 15;
                const float inv = (float)pow(10000.0, -(double)f / 16.0); const float ang = (float)pos * inv;
                float* t = (float*)(p.ws + WS_RAX); t[idx * 2] = (float)cos((double)ang); t[idx * 2 + 1] = (float)sin((double)ang);
            } else { const int q = idx - 1024, tt = q >> 6, pp = q & 63;
                const float inv = (float)(1.0 / pow(10000.0, (double)pp / 63.0)); const float ang = (float)tt * inv;
                float* t = (float*)(p.ws + WS_RRET); t[q * 2] = (float)cos((double)ang); t[q * 2 + 1] = (float)sin((double)ang);
            }
        }
    }
    {
        const int G = gridDim.x, NB16 = P0_N_WIN + P0_N_WUQ + P0_N_WUKV + P0_N_WOUT;
        int first = obid() - P0_N_MOD % G; if (first < 0) first += G;
        if (first < NB16) { CvtD dc = p0_bf16_desc(p, first); CvtRegs rc; cvt_tile_load(dc, rc);
            for (int jj = first; jj < NB16; jj += G) { CvtD dn = dc; CvtRegs rn;
                if (jj + G < NB16) { dn = p0_bf16_desc(p, jj + G); cvt_tile_load(dn, rn); }
                cvt_tile_finish(dc, rc, smem);
                dc = dn; rc = rn; } }
    }
    {
        const int G = gridDim.x, EXP_BASE = P0_N_MOD + P0_N_WIN + P0_N_WUQ + P0_N_WUKV + P0_N_WOUT;
        int first = obid() - EXP_BASE % G; if (first < 0) first += G;
        if (first < P0_N_EXP0) cvt8_stream(p, 0, T0C + first, G, (P0_N_EXP0 - first + G - 1) / G, smem);
        int f1 = first; if (f1 < P0_N_EXP0) f1 += ((P0_N_EXP0 - f1 + G - 1) / G) * G;
        if (f1 < P0_N_EXP) cvt8_stream(p, 1, T1C + (f1 - P0_N_EXP0), G, (P0_N_EXP - f1 + G - 1) / G, smem);
    }
}

template <int MODE>
DEVI void phase_rows(const Params& p, int l, char* smem) {
    const int tid = opaque_tid(), wid = tid >> 6, lane = tid & 63;
    float* xres = (float*)(p.ws + WS_XRES);
    bf16_t* hbuf = (bf16_t*)(p.ws + WS_H);
    const float* mod = (const float*)(p.ws + WS_MOD);
    float* wT = (float*)smem;
    if (MODE == 1) {
        const float* rw = p.router_w + (size_t)l * 2048 * 16;
        f32x4 rwv[16];
#pragma unroll
        for (int it = 0; it < 16; ++it) { const int i = tid + it * 512; rwv[it] = *(const f32x4*)(rw + (i >> 2) * 16 + (i & 3) * 4); }
#pragma unroll
        for (int it = 0; it < 16; ++it) { const int i = tid + it * 512, k = i >> 2, e4 = (i & 3) * 4; const f32x4 v = rwv[it];
            wT[(e4 + 0) * 2048 + k] = v[0]; wT[(e4 + 1) * 2048 + k] = v[1]; wT[(e4 + 2) * 2048 + k] = v[2]; wT[(e4 + 3) * 2048 + k] = v[3]; }
        __syncthreads();
    }
    const int nrows = (MODE == 3 || (MODE == 1 && l == 1)) ? NLAT : NROW;
    for (int row = obid() * 8 + wid; row < nrows; row += gridDim.x * 8) {
        const bool lat = row < NLAT;
        const int b = lat ? (row >> 11) : ((row - NLAT) >> 8);
        const int tok = lat ? (row & 2047) : (SEQ + ((row - NLAT) & 255));
        const float* src = (MODE == 0) ? (lat ? p.x + (size_t)row * DM : p.ctx + (size_t)(row - NLAT) * DM) : xres + (size_t)row * DM;
        float v[32];
#pragma unroll
        for (int i = 0; i < 8; ++i) { const f32x4 t = *(const f32x4*)(src + i * 256 + lane * 4); v[i * 4] = t[0]; v[i * 4 + 1] = t[1]; v[i * 4 + 2] = t[2]; v[i * 4 + 3] = t[3]; }
        const float* mrow = mod + (size_t)(((MODE == 2) ? l : l) * 5 + (lat ? b : 4)) * 12288;
        if (MODE == 2 || MODE == 3) {
            float cacc[32];
#pragma unroll
            for (int i = 0; i < 32; ++i) cacc[i] = 0.f;
            const int* rk = (const int*)(p.ws + WS_RANK) + (size_t)b * 16 * KEYS + tok;
            const bf16_t* ydn = (const bf16_t*)(p.ws + WS_YDN);
            const int cap = lat ? 256 : 32;
            int rke[16];
#pragma unroll
            for (int e = 0; e < 16; ++e) rke[e] = rk[e * KEYS];
#pragma unroll
            for (int e = 0; e < 16; ++e) {
                const int r = rke[e];
                if (r < cap) {
                    const int slot = lat ? (b * 256 + r) : (1024 + b * 32 + r);
                    const bf16_t* yr = ydn + ((size_t)e * MSLOT + slot) * DM;
#pragma unroll
                    for (int i = 0; i < 8; ++i) { const u32x2 w = *(const u32x2*)(yr + i * 256 + lane * 4);
                        cacc[i * 4] += bflo(w[0]); cacc[i * 4 + 1] += bfhi(w[0]); cacc[i * 4 + 2] += bflo(w[1]); cacc[i * 4 + 3] += bfhi(w[1]); }
                }
            }
            const float* gf = mrow + 10240;
#pragma unroll
            for (int i = 0; i < 8; ++i) { const f32x4 g = *(const f32x4*)(gf + i * 256 + lane * 4);
                v[i * 4] += g[0] * cacc[i * 4]; v[i * 4 + 1] += g[1] * cacc[i * 4 + 1]; v[i * 4 + 2] += g[2] * cacc[i * 4 + 2]; v[i * 4 + 3] += g[3] * cacc[i * 4 + 3]; }
            if (MODE == 2) {
#pragma unroll
                for (int i = 0; i < 8; ++i) *(f32x4*)(xres + (size_t)row * DM + i * 256 + lane * 4) = (f32x4){v[i * 4], v[i * 4 + 1], v[i * 4 + 2], v[i * 4 + 3]};
            }
        }
        float ss = 0.f;
#pragma unroll
        for (int i = 0; i < 32; ++i) ss += v[i] * v[i];
        ss = wave_sum(ss);
        const float rstd = rsqrtf(ss * (1.f / DM) + EPS);
        if (MODE == 3) {
#pragma unroll
            for (int i = 0; i < 8; ++i) { const f32x4 g = *(const f32x4*)(p.final_norm + i * 256 + lane * 4);
                __builtin_nontemporal_store((f32x4){v[i * 4] * rstd * g[0], v[i * 4 + 1] * rstd * g[1], v[i * 4 + 2] * rstd * g[2], v[i * 4 + 3] * rstd * g[3]}, (f32x4*)(p.out + (size_t)row * DM + i * 256 + lane * 4)); }
            continue;
        }
        const float* mr2 = (MODE == 2) ? mrow + (size_t)5 * 12288 : mrow;
        const float* sh = mr2 + ((MODE == 1) ? 6144 : 0);
        const float* sc = mr2 + ((MODE == 1) ? 8192 : 2048);
#pragma unroll
        for (int i = 0; i < 8; ++i) { const f32x4 a = *(const f32x4*)(sh + i * 256 + lane * 4); const f32x4 s = *(const f32x4*)(sc + i * 256 + lane * 4);
#pragma unroll
            for (int j = 0; j < 4; ++j) v[i * 4 + j] = v[i * 4 + j] * rstd * (1.f + s[j]) + a[j];
            if (MODE == 1) *(unsigned*)((unsigned char*)hbuf + (size_t)row * DM + i * 256 + lane * 4) = cvt4_fp8c(v[i * 4], v[i * 4 + 1], v[i * 4 + 2], v[i * 4 + 3]);
            else *(u32x2*)(hbuf + (size_t)row * DM + i * 256 + lane * 4) = (u32x2){cvt_pk(v[i * 4], v[i * 4 + 1]), cvt_pk(v[i * 4 + 2], v[i * 4 + 3])}; }
        if (MODE == 1) {
            float a[16];
#pragma unroll
            for (int e = 0; e < 16; ++e) { float t = 0.f;
#pragma unroll
                for (int i = 0; i < 8; ++i) { const f32x4 w = *(const f32x4*)(wT + e * 2048 + i * 256 + lane * 4);
                    t += v[i * 4] * w[0] + v[i * 4 + 1] * w[1] + v[i * 4 + 2] * w[2] + v[i * 4 + 3] * w[3]; }
                a[e] = t; if ((e & 3) == 3) __builtin_amdgcn_sched_barrier(0); }
            const bool b5 = (lane & 32) != 0, b4 = (lane & 16) != 0, b3 = (lane & 8) != 0, b2 = (lane & 4) != 0;
            float s8[8], s4[4], s2[2], s1;
#pragma unroll
            for (int i = 0; i < 8; ++i) { const float keep = b5 ? a[8 + i] : a[i], give = b5 ? a[i] : a[8 + i]; s8[i] = keep + __shfl_xor(give, 32); }
#pragma unroll
            for (int i = 0; i < 4; ++i) { const float keep = b4 ? s8[4 + i] : s8[i], give = b4 ? s8[i] : s8[4 + i]; s4[i] = keep + __shfl_xor(give, 16); }
#pragma unroll
            for (int i = 0; i < 2; ++i) { const float keep = b3 ? s4[2 + i] : s4[i], give = b3 ? s4[i] : s4[2 + i]; s2[i] = keep + __shfl_xor(give, 8); }
            { const float keep = b2 ? s2[1] : s2[0], give = b2 ? s2[0] : s2[1]; s1 = keep + __shfl_xor(give, 4); }
            s1 += __shfl_xor(s1, 2); s1 += __shfl_xor(s1, 1);
            float mx = s1;
#pragma unroll
            for (int off = 32; off >= 4; off >>= 1) mx = fmaxf(mx, __shfl_xor(mx, off));
            const float ex = expf(s1 - mx); float den = ex;
#pragma unroll
            for (int off = 32; off >= 4; off >>= 1) den += __shfl_xor(den, off);
            const int eidx = (b5 ? 8 : 0) + (b4 ? 4 : 0) + (b3 ? 2 : 0) + (b2 ? 1 : 0);
            if ((lane & 3) == 0) ((float*)(p.ws + WS_AFF))[((size_t)b * 16 + eidx) * KEYS + tok] = ex / den;
        }
    }
    if (MODE == 1) __syncthreads();
}

struct EpiWin { static constexpr bool PERM = true; bf16_t* P;
    DEVI void operator()(const f32x4 (&acc)[2][2][4][2], const pg8::Unit& u, int wr, int wc, int fr, int fq) const {
#pragma unroll
        for (int ai = 0; ai < 2; ++ai)
#pragma unroll
            for (int m = 0; m < 4; ++m) { const int row = u.pm * 256 + ai * 128 + wr * 64 + m * 16 + fr;
#pragma unroll
                for (int bj = 0; bj < 2; ++bj) { const int col = u.pn * 256 + bj * 128 + wc * 32 + 8 * fq;
                    if (col < INC) { const f32x4 a = acc[ai][bj][m][0], b = acc[ai][bj][m][1];
                        *(u32x4*)(P + (size_t)row * INC + col) = (u32x4){cvt_pk(a[0], a[1]), cvt_pk(a[2], a[3]), cvt_pk(b[0], b[1]), cvt_pk(b[2], b[3])}; } } }
    } };
DEVI void phase_win(const Params& p, int l, char* smem) {
    pg8::PlainSched S{(const bf16_t*)(p.ws + WS_H), (const bf16_t*)(p.ws + WS_WIN) + (size_t)l * INCP * 2048, DM, 0, 2048, 36, 18, 36 * 18};
    pg8::gemm_phase((LAS unsigned char*)smem, 2048, S, EpiWin{(bf16_t*)(p.ws + WS_P)});
    if (l == 0) tail_convert(p, 0, TAIL_WIN_B0, 0, TAILT_WIN, smem); else tail_convert(p, 1, TAIL_WIN_B0, T1A, TAILT_WIN, smem);
}

DEVI float log_sigmoid_f(float x) { return fminf(x, 0.f) - __logf(1.f + __expf(-fabsf(x))); }
DEVI bf16x8 ldfrag(const bf16_t* base, int ld, int row0, int k0, int fr, int fq) { return *(const bf16x8*)(base + (row0 + fr) * ld + k0 + fq * 8); }
DEVI int chunk_row0(int b, int c) { return (c < 4) ? (NLAT + b * CL + c * 64) : (b * SEQ + (c - 4) * 64); }
DEVI int order_idx(int dir, int c) { return dir == 0 ? c : ((c < 4) ? (3 - c) : (4 + 35 - c)); }

struct GlaIn { bf16x8 q, k, v0, v1, g0, g1, z0, z1, z2, z3, bw; float bias; };
DEVI void gla_load(const Params& p, int l, int b, int h, int c, bool need_qg, GlaIn& in) {
    const bf16_t* P = (const bf16_t*)(p.ws + WS_P);
    const int tid = opaque_tid(), wid = tid >> 6, lane = tid & 63, fr = lane & 15, fq = lane >> 4, d = wid >> 2, kf = wid & 3, kk = kf * 16 + fr;
    const int row0 = chunk_row0(b, c), tk = tid >> 3, c8 = (tid & 7) * 8;
    in.k = *(const bf16x8*)(P + (size_t)(row0 + tk) * INC + C_GK + h * 64 + c8);
    in.v0 = *(const bf16x8*)(P + (size_t)(row0 + tk) * INC + C_GV + h * 128 + c8);
    in.v1 = *(const bf16x8*)(P + (size_t)(row0 + tk) * INC + C_GV + h * 128 + 64 + c8);
    if (need_qg) {
        in.q = *(const bf16x8*)(P + (size_t)(row0 + tk) * INC + C_GQ + h * 64 + c8);
        in.g0 = *(const bf16x8*)(P + (size_t)(row0 + tk) * INC + C_GOG + h * 128 + (tid & 7) * 16);
        in.g1 = *(const bf16x8*)(P + (size_t)(row0 + tk) * INC + C_GOG + h * 128 + (tid & 7) * 16 + 8);
    }
    const bf16x8 zero = {0, 0, 0, 0, 0, 0, 0, 0};
    in.z0 = zero; in.z1 = zero; in.z2 = zero; in.z3 = zero; in.bw = zero;
    if (fq < 2) {
        const bf16_t* zp = P + (size_t)(row0 + fr) * INC + C_GZ + d * 16 + fq * 8;
        in.z0 = *(const bf16x8*)(zp); in.z1 = *(const bf16x8*)(zp + (size_t)16 * INC); in.z2 = *(const bf16x8*)(zp + (size_t)32 * INC); in.z3 = *(const bf16x8*)(zp + (size_t)48 * INC);
        float wv[8];
#pragma unroll
        for (int j = 0; j < 8; ++j) wv[j] = p.gla_w2[((size_t)(l * 2 + d) * 16 + fq * 8 + j) * 256 + h * 64 + kk];
        in.bw = pack8(wv);
    }
    in.bias = p.gla_b[(size_t)(l * 2 + d) * 256 + h * 64 + kk];
}
DEVI void gla_cum(const GlaIn& in, float* cum) {
    const int tid = opaque_tid(), wid = tid >> 6, lane = tid & 63, fr = lane & 15, fq = lane >> 4, d = wid >> 2, kf = wid & 3;
    const int kk = kf * 16 + fr;
    float la[4][4];
#pragma unroll
    for (int f = 0; f < 4; ++f) {
        const bf16x8 az = (f == 0) ? in.z0 : (f == 1) ? in.z1 : (f == 2) ? in.z2 : in.z3;
        f32x4 acc = {0.f, 0.f, 0.f, 0.f};
        acc = __builtin_amdgcn_mfma_f32_16x16x32_bf16(az, in.bw, acc, 0, 0, 0);
#pragma unroll
        for (int r = 0; r < 4; ++r) la[f][r] = log_sigmoid_f(acc[r] + in.bias) * (1.f / 16.f);
    }
    if (d == 0) {
        float carry = 0.f;
#pragma unroll
        for (int f = 0; f < 4; ++f) {
            la[f][1] += la[f][0]; la[f][2] += la[f][1]; la[f][3] += la[f][2];
            float x = la[f][3]; const float own = x;
            float y = __shfl_up(x, 16); if (fq >= 1) x += y;
            y = __shfl_up(x, 32); if (fq >= 2) x += y;
            const float excl = x - own + carry;
            carry += __shfl(x, 48 + fr);
#pragma unroll
            for (int r = 0; r < 4; ++r) la[f][r] += excl;
        }
    } else {
        float carry = 0.f;
#pragma unroll
        for (int f = 3; f >= 0; --f) {
            la[f][2] += la[f][3]; la[f][1] += la[f][2]; la[f][0] += la[f][1];
            float x = la[f][0]; const float own = x;
            float y = __shfl_down(x, 16); if (fq <= 2) x += y;
            y = __shfl_down(x, 32); if (fq <= 1) x += y;
            const float excl = x - own + carry;
            carry += __shfl(x, fr);
#pragma unroll
            for (int r = 0; r < 4; ++r) la[f][r] += excl;
        }
    }
#pragma unroll
    for (int f = 0; f < 4; ++f)
#pragma unroll
        for (int r = 0; r < 4; ++r) cum[(d * 64 + f * 16 + fq * 4 + r) * 64 + kk] = la[f][r];
    __syncthreads();
}

DEVI void scan_a_gla(const Params& p, int l, int b, int h, int c, const GlaIn& in, char* smem) {
    float* cum = (float*)(smem + 18432);
    bf16_t* kTf = (bf16_t*)(smem + 51200); bf16_t* kTb = kTf + 64 * 72; bf16_t* vT = kTb + 64 * 72;
    const int tid = opaque_tid(), wid = tid >> 6, lane = tid & 63, fr = lane & 15, fq = lane >> 4;
    const int tk = tid >> 3, c8 = (tid & 7) * 8;
    const bf16x8 kreg = in.k, v0 = in.v0, v1 = in.v1;
    gla_cum(in, cum);
    {   float kf[8]; unpack8(kreg, kf);
#pragma unroll
        for (int e = 0; e < 8; ++e) { const int kk = c8 + e;
            kTf[kk * 72 + tk] = f2bf(kf[e] * __expf(cum[(0 * 64 + 63) * 64 + kk] - cum[(0 * 64 + tk) * 64 + kk]));
            kTb[kk * 72 + tk] = f2bf(kf[e] * __expf(cum[(1 * 64 + 0) * 64 + kk] - cum[(1 * 64 + tk) * 64 + kk])); }
#pragma unroll
        for (int e = 0; e < 8; ++e) { vT[(c8 + e) * 72 + tk] = (bf16_t)v0[e]; vT[(64 + c8 + e) * 72 + tk] = (bf16_t)v1[e]; }
    }
    if (tid < 128) { const int d = tid >> 6, kk = tid & 63;
        ((float*)(p.ws + WS_DECG))[((size_t)((b * 4 + h) * 2 + d) * NCH + order_idx(d, c)) * 64 + kk] = __expf(d == 0 ? cum[(0 * 64 + 63) * 64 + kk] : cum[(1 * 64 + 0) * 64 + kk]); }
    __syncthreads();
    {   const int dir = wid >> 2, kkf = wid & 3;
        const bf16_t* kT = dir ? kTb : kTf;
        const bf16x8 a0 = ldfrag(kT, 72, kkf * 16, 0, fr, fq), a1 = ldfrag(kT, 72, kkf * 16, 32, fr, fq);
        bf16_t* UT = (bf16_t*)(p.ws + WS_UTG) + ((size_t)((b * 4 + h) * 2 + dir) * NCH + order_idx(dir, c)) * (128 * 64);
#pragma unroll
        for (int vf = 0; vf < 8; ++vf) {
            f32x4 acc = {0.f, 0.f, 0.f, 0.f};
            acc = __builtin_amdgcn_mfma_f32_16x16x32_bf16(a0, ldfrag(vT, 72, vf * 16, 0, fr, fq), acc, 0, 0, 0);
            acc = __builtin_amdgcn_mfma_f32_16x16x32_bf16(a1, ldfrag(vT, 72, vf * 16, 32, fr, fq), acc, 0, 0, 0);
            *(u32x2*)(UT + (vf * 16 + fr) * 64 + kkf * 16 + fq * 4) = (u32x2){cvt_pk(acc[0], acc[1]), cvt_pk(acc[2], acc[3])};
        }
    }
    __syncthreads();
}

DEVI void ret_decays(int h, float& ldf, float& ldb) { ldf = log1pf(-exp2f(-(5.f + 2.f * h))); ldb = log1pf(-exp2f(-(6.f + 2.f * h))); }

struct RetIn { bf16x8 q0, q1, k0, k1, v0, v1, g0, g1; f32x4 cs0, cs1, cs2, cs3; };
DEVI void ret_load(const Params& p, int b, int h, int c, bool need_qg, RetIn& in) {
    const bf16_t* P = (const bf16_t*)(p.ws + WS_P);
    const float* rret = (const float*)(p.ws + WS_RRET);
    const int tid = opaque_tid(), tk = tid >> 3, kk16 = (tid & 7) * 16;
    const size_t rb = (size_t)(chunk_row0(b, c) + tk) * INC;
    in.k0 = *(const bf16x8*)(P + rb + C_RK + h * 128 + kk16); in.k1 = *(const bf16x8*)(P + rb + C_RK + h * 128 + kk16 + 8);
    in.v0 = *(const bf16x8*)(P + rb + C_RV + h * 128 + kk16); in.v1 = *(const bf16x8*)(P + rb + C_RV + h * 128 + kk16 + 8);
    if (need_qg) {
        in.q0 = *(const bf16x8*)(P + rb + C_RQ + h * 128 + kk16); in.q1 = *(const bf16x8*)(P + rb + C_RQ + h * 128 + kk16 + 8);
        in.g0 = *(const bf16x8*)(P + rb + C_RG + h * 128 + kk16); in.g1 = *(const bf16x8*)(P + rb + C_RG + h * 128 + kk16 + 8);
    }
    if (c >= 4) { const float* tb = rret + ((size_t)((c - 4) * 64 + tk) * 64 + (kk16 >> 1)) * 2;
        in.cs0 = *(const f32x4*)(tb); in.cs1 = *(const f32x4*)(tb + 4); in.cs2 = *(const f32x4*)(tb + 8); in.cs3 = *(const f32x4*)(tb + 12); }
}
DEVI void ret_rot(const bf16x8 r0, const bf16x8 r1, const RetIn& in, bool lat, float scale, float (&o)[16]) {
    float a[8], c[8]; unpack8(r0, a); unpack8(r1, c);
#pragma unroll
    for (int i = 0; i < 8; ++i) { o[i] = a[i]; o[8 + i] = c[i]; }
    if (lat) {
#pragma unroll
        for (int q = 0; q < 4; ++q) { const f32x4 cs = (q == 0) ? in.cs0 : (q == 1) ? in.cs1 : (q == 2) ? in.cs2 : in.cs3;
            const float x1 = o[4 * q], x2 = o[4 * q + 1], y1 = o[4 * q + 2], y2 = o[4 * q + 3];
            o[4 * q] = x1 * cs[0] - x2 * cs[1]; o[4 * q + 1] = x1 * cs[1] + x2 * cs[0];
            o[4 * q + 2] = y1 * cs[2] - y2 * cs[3]; o[4 * q + 3] = y1 * cs[3] + y2 * cs[2]; }
    }
#pragma unroll
    for (int i = 0; i < 16; ++i) o[i] *= scale;
}

DEVI void scan_a_ret(const Params& p, int l, int b, int h, int c, const RetIn& in, char* smem) {
    bf16_t* kTf = (bf16_t*)smem; bf16_t* kTb = kTf + 128 * 72; bf16_t* vT = kTb + 128 * 72;
    const int tid = opaque_tid(), wid = tid >> 6, lane = tid & 63, fr = lane & 15, fq = lane >> 4;
    const bool lat = c >= 4;
    const int tk = tid >> 3, kk16 = (tid & 7) * 16;
    float ldf, ldb; ret_decays(h, ldf, ldb);
    float kf[16];
    ret_rot(in.k0, in.k1, in, lat, 0.08838834764831845f, kf);
    const float ef = __expf(ldf * (float)(63 - tk)), eb = __expf(ldb * (float)tk);
#pragma unroll
    for (int e = 0; e < 16; ++e) { kTf[(kk16 + e) * 72 + tk] = f2bf(kf[e] * ef); kTb[(kk16 + e) * 72 + tk] = f2bf(kf[e] * eb); }
    {   const bf16x8 v0 = in.v0, v1 = in.v1;
#pragma unroll
        for (int e = 0; e < 8; ++e) { vT[(kk16 + e) * 72 + tk] = (bf16_t)v0[e]; vT[(kk16 + 8 + e) * 72 + tk] = (bf16_t)v1[e]; } }
    __syncthreads();
    {   const int dir = wid >> 2;
        const bf16_t* kT = dir ? kTb : kTf;
        bf16_t* UT = (bf16_t*)(p.ws + WS_UTR) + ((size_t)((b * 4 + h) * 2 + dir) * NCH + order_idx(dir, c)) * (128 * 128);
#pragma unroll
        for (int q = 0; q < 2; ++q) { const int kkf = (wid & 3) * 2 + q;
            const bf16x8 a0 = ldfrag(kT, 72, kkf * 16, 0, fr, fq), a1 = ldfrag(kT, 72, kkf * 16, 32, fr, fq);
#pragma unroll
            for (int vf = 0; vf < 8; ++vf) {
                f32x4 acc = {0.f, 0.f, 0.f, 0.f};
                acc = __builtin_amdgcn_mfma_f32_16x16x32_bf16(a0, ldfrag(vT, 72, vf * 16, 0, fr, fq), acc, 0, 0, 0);
                acc = __builtin_amdgcn_mfma_f32_16x16x32_bf16(a1, ldfrag(vT, 72, vf * 16, 32, fr, fq), acc, 0, 0, 0);
                *(u32x2*)(UT + (vf * 16 + fr) * 128 + kkf * 16 + fq * 4) = (u32x2){cvt_pk(acc[0], acc[1]), cvt_pk(acc[2], acc[3])};
            } }
    }
    __syncthreads();
}

DEVI void phase_prefix(const Params& p, char* smem) {
    const int NT_G = 32 * 2048, NT_R = 32 * 4096;
    for (int g = obid() * 512 + threadIdx.x; g < NT_G + NT_R; g += gridDim.x * 512) {
        if (g < NT_G) {
            const int seq = g >> 11, e4 = (g & 2047) * 4, kk = e4 & 63;
            const bf16_t* U = (const bf16_t*)(p.ws + WS_UTG) + (size_t)seq * NCH * 8192 + e4;
            bf16_t* S = (bf16_t*)(p.ws + WS_STG) + (size_t)seq * NCH * 8192 + e4;
            const float* dec = (const float*)(p.ws + WS_DECG) + (size_t)seq * NCH * 64 + kk;
            f32x4 st = {0.f, 0.f, 0.f, 0.f};
#pragma unroll 12
            for (int o = 0; o < NCH; ++o) {
                const u32x2 uw = *(const u32x2*)(U + (size_t)o * 8192); const f32x4 u = {bflo(uw[0]), bfhi(uw[0]), bflo(uw[1]), bfhi(uw[1])}; const f32x4 dd = *(const f32x4*)(dec + o * 64);
                *(u32x2*)(S + (size_t)o * 8192) = (u32x2){cvt_pk(st[0], st[1]), cvt_pk(st[2], st[3])};
                st = dd * st + u;
            }
        } else {
            const int g2 = g - NT_G, seq = g2 >> 12, e4 = (g2 & 4095) * 4;
            const int h = (seq >> 1) & 3, dir = seq & 1;
            float ldf, ldb; ret_decays(h, ldf, ldb);
            const float dd = __expf(64.f * (dir ? ldb : ldf));
            const bf16_t* U = (const bf16_t*)(p.ws + WS_UTR) + (size_t)seq * NCH * 16384 + e4;
            bf16_t* S = (bf16_t*)(p.ws + WS_STR) + (size_t)seq * NCH * 16384 + e4;
            f32x4 st = {0.f, 0.f, 0.f, 0.f};
#pragma unroll 12
            for (int o = 0; o < NCH; ++o) {
                const u32x2 uw = *(const u32x2*)(U + (size_t)o * 16384); const f32x4 u = {bflo(uw[0]), bfhi(uw[0]), bflo(uw[1]), bfhi(uw[1])};
                *(u32x2*)(S + (size_t)o * 16384) = (u32x2){cvt_pk(st[0], st[1]), cvt_pk(st[2], st[3])};
                st = dd * st + u;
            }
        }
    }
}

DEVI void scan_c_tail(const float* o, int tid, const bf16x8 g0, const bf16x8 g1, int row0, bf16_t* ymix, int ycol) {
    const int tk = tid >> 3, v16 = (tid & 7) * 16;
    float ov[16]; float ss = 0.f;
#pragma unroll
    for (int q = 0; q < 4; ++q) { const f32x4 t = *(const f32x4*)(o + tk * 128 + v16 + q * 4); ov[q * 4] = t[0]; ov[q * 4 + 1] = t[1]; ov[q * 4 + 2] = t[2]; ov[q * 4 + 3] = t[3]; }
#pragma unroll
    for (int i = 0; i < 16; ++i) ss += ov[i] * ov[i];
    ss += __shfl_xor(ss, 1); ss += __shfl_xor(ss, 2); ss += __shfl_xor(ss, 4);
    const float rstd = rsqrtf(ss * (1.f / 128.f) + EPS);
    float ga[8], gb[8]; unpack8(g0, ga); unpack8(g1, gb);
    float y0[8], y1[8];
#pragma unroll
    for (int i = 0; i < 8; ++i) { y0[i] = ov[i] * rstd * silu_f(ga[i]); y1[i] = ov[8 + i] * rstd * silu_f(gb[i]); }
    *(bf16x8*)(ymix + (size_t)(row0 + tk) * DM + ycol + v16) = pack8(y0);
    *(bf16x8*)(ymix + (size_t)(row0 + tk) * DM + ycol + v16 + 8) = pack8(y1);
}

DEVI void scan_c_gla(const Params& p, int l, int b, int h, int c, const GlaIn& in, char* smem) {
    float* cum = (float*)(smem + 18432);
    float* obuf = cum;
    bf16_t* qdf = (bf16_t*)(smem + 51200); bf16_t* qdb = qdf + 64 * 72; bf16_t* kif = qdb + 64 * 72; bf16_t* kib = kif + 64 * 72;
    bf16_t* vT = kib + 64 * 72; bf16_t* att = vT + 128 * 72;
    const int tid = opaque_tid(), wid = tid >> 6, lane = tid & 63, fr = lane & 15, fq = lane >> 4;
    const int row0 = chunk_row0(b, c);
    const int tk = tid >> 3, c8 = (tid & 7) * 8;
    const bf16x8 qreg = in.q, kreg = in.k, v0 = in.v0, v1 = in.v1, gt0 = in.g0, gt1 = in.g1;
    const bf16_t* SF = (const bf16_t*)(p.ws + WS_STG) + ((size_t)((b * 4 + h) * 2 + 0) * NCH + order_idx(0, c)) * 8192;
    const bf16_t* SB = (const bf16_t*)(p.ws + WS_STG) + ((size_t)((b * 4 + h) * 2 + 1) * NCH + order_idx(1, c)) * 8192;
    const bf16x8 sf0 = *(const bf16x8*)(SF + (wid * 16 + fr) * 64 + fq * 8), sf1 = *(const bf16x8*)(SF + (wid * 16 + fr) * 64 + 32 + fq * 8);
    const bf16x8 sb0 = *(const bf16x8*)(SB + (wid * 16 + fr) * 64 + fq * 8), sb1 = *(const bf16x8*)(SB + (wid * 16 + fr) * 64 + 32 + fq * 8);
    gla_cum(in, cum);
    {   float qf[8], kf[8]; unpack8(qreg, qf); unpack8(kreg, kf);
        float a[8], bq[8], cc[8], dq[8];
#pragma unroll
        for (int e = 0; e < 8; ++e) { const float cf = cum[(0 * 64 + tk) * 64 + c8 + e], cb = cum[(1 * 64 + tk) * 64 + c8 + e];
            a[e] = qf[e] * 0.125f * __expf(cf); bq[e] = qf[e] * 0.125f * __expf(cb); cc[e] = kf[e] * __expf(-cf); dq[e] = kf[e] * __expf(-cb); }
        *(bf16x8*)(qdf + tk * 72 + c8) = pack8(a); *(bf16x8*)(qdb + tk * 72 + c8) = pack8(bq);
        *(bf16x8*)(kif + tk * 72 + c8) = pack8(cc); *(bf16x8*)(kib + tk * 72 + c8) = pack8(dq);
#pragma unroll
        for (int e = 0; e < 8; ++e) { vT[(c8 + e) * 72 + tk] = (bf16_t)v0[e]; vT[(64 + c8 + e) * 72 + tk] = (bf16_t)v1[e]; }
    }
    __syncthreads();
    {
        const int jf = wid & 3;
#pragma unroll
        for (int q = 0; q < 2; ++q) { const int iff = (wid >> 2) * 2 + q;
            f32x4 af = {0.f, 0.f, 0.f, 0.f}, ab = {0.f, 0.f, 0.f, 0.f};
            if (iff >= jf) {
                af = __builtin_amdgcn_mfma_f32_16x16x32_bf16(ldfrag(kif, 72, jf * 16, 0, fr, fq), ldfrag(qdf, 72, iff * 16, 0, fr, fq), af, 0, 0, 0);
                af = __builtin_amdgcn_mfma_f32_16x16x32_bf16(ldfrag(kif, 72, jf * 16, 32, fr, fq), ldfrag(qdf, 72, iff * 16, 32, fr, fq), af, 0, 0, 0); }
            if (iff <= jf) {
                ab = __builtin_amdgcn_mfma_f32_16x16x32_bf16(ldfrag(kib, 72, jf * 16, 0, fr, fq), ldfrag(qdb, 72, iff * 16, 0, fr, fq), ab, 0, 0, 0);
                ab = __builtin_amdgcn_mfma_f32_16x16x32_bf16(ldfrag(kib, 72, jf * 16, 32, fr, fq), ldfrag(qdb, 72, iff * 16, 32, fr, fq), ab, 0, 0, 0); }
            const int i = iff * 16 + fr, j0 = jf * 16 + fq * 4;
            float r[4];
#pragma unroll
            for (int e = 0; e < 4; ++e) r[e] = (j0 + e <= i) ? af[e] : ab[e];
            *(u32x2*)(att + i * 72 + j0) = (u32x2){cvt_pk(r[0], r[1]), cvt_pk(r[2], r[3])};
        }
    }
    __syncthreads();
    {   const int vf = wid;
        const bf16x8 vt0 = ldfrag(vT, 72, vf * 16, 0, fr, fq), vt1 = ldfrag(vT, 72, vf * 16, 32, fr, fq);
#pragma unroll
        for (int iff = 0; iff < 4; ++iff) {
            f32x4 acc = {0.f, 0.f, 0.f, 0.f};
            acc = __builtin_amdgcn_mfma_f32_16x16x32_bf16(vt0, ldfrag(att, 72, iff * 16, 0, fr, fq), acc, 0, 0, 0);
            acc = __builtin_amdgcn_mfma_f32_16x16x32_bf16(vt1, ldfrag(att, 72, iff * 16, 32, fr, fq), acc, 0, 0, 0);
            acc = __builtin_amdgcn_mfma_f32_16x16x32_bf16(sf0, ldfrag(qdf, 72, iff * 16, 0, fr, fq), acc, 0, 0, 0);
            acc = __builtin_amdgcn_mfma_f32_16x16x32_bf16(sf1, ldfrag(qdf, 72, iff * 16, 32, fr, fq), acc, 0, 0, 0);
            acc = __builtin_amdgcn_mfma_f32_16x16x32_bf16(sb0, ldfrag(qdb, 72, iff * 16, 0, fr, fq), acc, 0, 0, 0);
            acc = __builtin_amdgcn_mfma_f32_16x16x32_bf16(sb1, ldfrag(qdb, 72, iff * 16, 32, fr, fq), acc, 0, 0, 0);
            *(f32x4*)(obuf + (iff * 16 + fr) * 128 + vf * 16 + fq * 4) = acc;
        }
    }
    __syncthreads();
    scan_c_tail(obuf, tid, gt0, gt1, row0, (bf16_t*)(p.ws + WS_YMIX), 1024 + h * 128);
    __syncthreads();
}

DEVI void scan_c_ret(const Params& p, int l, int b, int h, int c, const RetIn& in, char* smem) {
    float* obuf = (float*)smem;
    bf16_t* qs = (bf16_t*)(smem + 32768); bf16_t* ks = qs + 64 * 136; bf16_t* vT = ks + 64 * 136; bf16_t* att = vT + 128 * 72;
    const int tid = opaque_tid(), wid = tid >> 6, lane = tid & 63, fr = lane & 15, fq = lane >> 4;
    const int row0 = chunk_row0(b, c); const bool lat = c >= 4;
    const int tk = tid >> 3, kk16 = (tid & 7) * 16;
    float ldf, ldb; ret_decays(h, ldf, ldb);
    const bf16x8 gt0 = in.g0, gt1 = in.g1;
    const bf16_t* SF = (const bf16_t*)(p.ws + WS_STR) + ((size_t)((b * 4 + h) * 2 + 0) * NCH + order_idx(0, c)) * 16384;
    const bf16_t* SB = (const bf16_t*)(p.ws + WS_STR) + ((size_t)((b * 4 + h) * 2 + 1) * NCH + order_idx(1, c)) * 16384;
    bf16x8 sff[4], sbf[4];
#pragma unroll
    for (int ksx = 0; ksx < 4; ++ksx) { sff[ksx] = *(const bf16x8*)(SF + (wid * 16 + fr) * 128 + ksx * 32 + fq * 8); sbf[ksx] = *(const bf16x8*)(SB + (wid * 16 + fr) * 128 + ksx * 32 + fq * 8); }
    {   float qf[16], kf[16];
        ret_rot(in.q0, in.q1, in, lat, 1.f, qf);
        ret_rot(in.k0, in.k1, in, lat, 0.08838834764831845f, kf);
        float t0[8], t1[8];
#pragma unroll
        for (int e = 0; e < 8; ++e) { t0[e] = qf[e]; t1[e] = qf[8 + e]; }
        *(bf16x8*)(qs + tk * 136 + kk16) = pack8(t0); *(bf16x8*)(qs + tk * 136 + kk16 + 8) = pack8(t1);
#pragma unroll
        for (int e = 0; e < 8; ++e) { t0[e] = kf[e]; t1[e] = kf[8 + e]; }
        *(bf16x8*)(ks + tk * 136 + kk16) = pack8(t0); *(bf16x8*)(ks + tk * 136 + kk16 + 8) = pack8(t1);
        const bf16x8 v0 = in.v0, v1 = in.v1;
#pragma unroll
        for (int e = 0; e < 8; ++e) { vT[(kk16 + e) * 72 + tk] = (bf16_t)v0[e]; vT[(kk16 + 8 + e) * 72 + tk] = (bf16_t)v1[e]; }
    }
    __syncthreads();
    {   const int jf = wid & 3;
#pragma unroll
        for (int q = 0; q < 2; ++q) { const int iff = (wid >> 2) * 2 + q;
            f32x4 a = {0.f, 0.f, 0.f, 0.f};
#pragma unroll
            for (int ksx = 0; ksx < 4; ++ksx) a = __builtin_amdgcn_mfma_f32_16x16x32_bf16(ldfrag(ks, 136, jf * 16, ksx * 32, fr, fq), ldfrag(qs, 136, iff * 16, ksx * 32, fr, fq), a, 0, 0, 0);
            const int i = iff * 16 + fr, j0 = jf * 16 + fq * 4;
            float r[4];
#pragma unroll
            for (int e = 0; e < 4; ++e) { const int j = j0 + e; r[e] = a[e] * ((j <= i) ? __expf(ldf * (float)(i - j)) : __expf(ldb * (float)(j - i))); }
            *(u32x2*)(att + i * 72 + j0) = (u32x2){cvt_pk(r[0], r[1]), cvt_pk(r[2], r[3])};
        }
    }
    __syncthreads();
    {   const int vf = wid;
        const bf16x8 vt0 = ldfrag(vT, 72, vf * 16, 0, fr, fq), vt1 = ldfrag(vT, 72, vf * 16, 32, fr, fq);
#pragma unroll
        for (int iff = 0; iff < 4; ++iff) {
            const int i = iff * 16 + fr;
            const float sf = __expf(ldf * (float)(i + 1)), sb = __expf(ldb * (float)(64 - i));
            f32x4 acc = {0.f, 0.f, 0.f, 0.f}, accf = {0.f, 0.f, 0.f, 0.f}, accb = {0.f, 0.f, 0.f, 0.f};
            acc = __builtin_amdgcn_mfma_f32_16x16x32_bf16(vt0, ldfrag(att, 72, iff * 16, 0, fr, fq), acc, 0, 0, 0);
            acc = __builtin_amdgcn_mfma_f32_16x16x32_bf16(vt1, ldfrag(att, 72, iff * 16, 32, fr, fq), acc, 0, 0, 0);
#pragma unroll
            for (int ksx = 0; ksx < 4; ++ksx) { const bf16x8 qv = ldfrag(qs, 136, iff * 16, ksx * 32, fr, fq);
                accf = __builtin_amdgcn_mfma_f32_16x16x32_bf16(sff[ksx], qv, accf, 0, 0, 0);
                accb = __builtin_amdgcn_mfma_f32_16x16x32_bf16(sbf[ksx], qv, accb, 0, 0, 0); }
            *(f32x4*)(obuf + i * 128 + vf * 16 + fq * 4) = acc + sf * accf + sb * accb;
        }
    }
    __syncthreads();
    scan_c_tail(obuf, tid, gt0, gt1, row0, (bf16_t*)(p.ws + WS_YMIX), 1536 + h * 128);
    __syncthreads();
}

namespace att {
constexpr int DQ = 192, DV = 128, NW = 8, QBLK = 32, KVBLK = 64;
constexpr int SHM_V = KVBLK * DV * 2, SHM_K = KVBLK * 400;
constexpr float THR = 8.f;
#define KSWZ(row, colB) ((row) * 400 + (colB))
#define SBAR() __builtin_amdgcn_sched_barrier(0)
DEVI int crow(int r, int hi) { return (r & 3) + 8 * (r >> 2) + 4 * hi; }
DEVI unsigned cvtpk(float lo, float hi) { unsigned r; asm volatile("v_cvt_pk_bf16_f32 %0, %1, %2" : "=v"(r) : "v"(lo), "v"(hi)); return r; }
DEVI void partialSM(f32x16& p0, f32x16& p1, float& m_reg, float& mn, float& alpha) {
    constexpr float C = 1.4426950408889634f;
    float pmax = p0[0];
#pragma unroll
    for (int r = 1; r < 16; ++r) pmax = fmaxf(pmax, p0[r]);
#pragma unroll
    for (int r = 0; r < 16; ++r) pmax = fmaxf(pmax, p1[r]);
    { auto rr = __builtin_amdgcn_permlane32_swap(__float_as_uint(pmax), __float_as_uint(pmax), false, false);
      pmax = fmaxf(__uint_as_float(rr[0]), __uint_as_float(rr[1])); }
    if (__builtin_expect(__all(pmax - m_reg <= THR), 1)) { mn = m_reg; alpha = 1.f; }
    else { mn = fmaxf(m_reg, pmax); alpha = __builtin_amdgcn_exp2f((m_reg - mn) * C); m_reg = mn; }
    const float mnC = -mn * C;
#pragma unroll
    for (int r = 0; r < 16; ++r) p0[r] = fmaf(p0[r], C, mnC);
#pragma unroll
    for (int r = 0; r < 16; ++r) p1[r] = fmaf(p1[r], C, mnC);
#pragma unroll
    for (int r = 0; r < 16; ++r) p0[r] = __builtin_amdgcn_exp2f(p0[r]);
}
DEVI void finishSM(f32x16& p0, f32x16& p1, float alpha, float& l_reg, bf16x8& pa0, bf16x8& pa1, bf16x8& pa2, bf16x8& pa3) {
#pragma unroll
    for (int r = 0; r < 16; ++r) p1[r] = __builtin_amdgcn_exp2f(p1[r]);
    float ps = 0;
#pragma unroll
    for (int r = 0; r < 16; ++r) ps += p0[r];
#pragma unroll
    for (int r = 0; r < 16; ++r) ps += p1[r];
    { auto rr = __builtin_amdgcn_permlane32_swap(__float_as_uint(ps), __float_as_uint(ps), false, false);
      ps = __uint_as_float(rr[0]) + __uint_as_float(rr[1]); }
    l_reg = l_reg * alpha + ps;
#define PK4(P, BASE, OUT) do { unsigned a0 = cvtpk(P[BASE + 0], P[BASE + 1]), a1 = cvtpk(P[BASE + 2], P[BASE + 3]);   \
    unsigned b0 = cvtpk(P[BASE + 4], P[BASE + 5]), b1 = cvtpk(P[BASE + 6], P[BASE + 7]);                              \
    auto r0 = __builtin_amdgcn_permlane32_swap(a0, b0, false, false); auto r1 = __builtin_amdgcn_permlane32_swap(a1, b1, false, false); \
    u32x4 w = {r0[0], r1[0], r0[1], r1[1]}; OUT = __builtin_bit_cast(bf16x8, w); } while (0)
    PK4(p0, 0, pa0); PK4(p0, 8, pa1); PK4(p1, 0, pa2); PK4(p1, 8, pa3);
#undef PK4
}
DEVI void qkt(f32x16& p0, f32x16& p1, const char* Ks, const bf16x8* qr, const char* qL, int r32, int hi) {
    p0 = (f32x16){0.f, 0.f, 0.f, 0.f, 0.f, 0.f, 0.f, 0.f, 0.f, 0.f, 0.f, 0.f, 0.f, 0.f, 0.f, 0.f}; p1 = p0;
#pragma unroll
    for (int d0 = 0; d0 < 12; ++d0) { const int cb = (d0 * 16 + hi * 8) * 2;
        const bf16x8 b0 = *(const bf16x8*)(Ks + KSWZ(r32, cb));
        const bf16x8 b1 = *(const bf16x8*)(Ks + KSWZ(32 + r32, cb));
        const bf16x8 qv = (d0 < 8) ? qr[d0 < 8 ? d0 : 0] : *(const bf16x8*)(qL + (d0 - 8) * 1024);
        p0 = __builtin_amdgcn_mfma_f32_32x32x16_bf16(b0, qv, p0, 0, 0, 0);
        p1 = __builtin_amdgcn_mfma_f32_32x32x16_bf16(b1, qv, p1, 0, 0, 0); }
}
DEVI int v_st(int k, int c) { const int kk = (k & ~0xC) | ((k & 4) << 1) | ((k & 8) >> 1); return ((kk >> 3) * 4 + (c >> 5)) * 512 + ((kk & 7) * 32 + (c & 31)) * 2; }
DEVI int v_rd_base(int lane) { return ((lane & 3) << 3) | (((lane >> 2) & 3) << 6) | (((lane >> 4) & 1) << 5) | (((lane >> 5) & 1) << 8); }
constexpr int v_rd_off(int d0, int ks, int half) { return d0 * 512 + ks * 4096 + half * 2048; }
template <int OFF> DEVI s16x4 tr_read(int vb) { s16x4 r; asm volatile("ds_read_b64_tr_b16 %0, %1 offset:%2" : "=&v"(r) : "v"(vb), "i"(OFF) : "memory"); return r; }
template <int D0> DEVI void pv_one(f32x16& od, int vb, bf16x8 pa0, bf16x8 pa1, bf16x8 pa2, bf16x8 pa3) {
    const s16x4 l0 = tr_read<v_rd_off(D0, 0, 0)>(vb), h0 = tr_read<v_rd_off(D0, 0, 1)>(vb), l1 = tr_read<v_rd_off(D0, 1, 0)>(vb), h1 = tr_read<v_rd_off(D0, 1, 1)>(vb);
    const s16x4 l2 = tr_read<v_rd_off(D0, 2, 0)>(vb), h2 = tr_read<v_rd_off(D0, 2, 1)>(vb), l3 = tr_read<v_rd_off(D0, 3, 0)>(vb), h3 = tr_read<v_rd_off(D0, 3, 1)>(vb);
    asm volatile("s_waitcnt lgkmcnt(0)" ::: "memory"); SBAR();
#define PKV(L, H) (bf16x8){L[0], L[1], L[2], L[3], H[0], H[1], H[2], H[3]}
    od = __builtin_amdgcn_mfma_f32_32x32x16_bf16(pa0, PKV(l0, h0), od, 0, 0, 0);
    od = __builtin_amdgcn_mfma_f32_32x32x16_bf16(pa1, PKV(l1, h1), od, 0, 0, 0);
    od = __builtin_amdgcn_mfma_f32_32x32x16_bf16(pa2, PKV(l2, h2), od, 0, 0, 0);
    od = __builtin_amdgcn_mfma_f32_32x32x16_bf16(pa3, PKV(l3, h3), od, 0, 0, 0);
#undef PKV
}
DEVI void pv_d0(f32x16* o, int vb, bf16x8 pa0, bf16x8 pa1, bf16x8 pa2, bf16x8 pa3) {
    pv_one<0>(o[0], vb, pa0, pa1, pa2, pa3); pv_one<1>(o[1], vb, pa0, pa1, pa2, pa3); pv_one<2>(o[2], vb, pa0, pa1, pa2, pa3); pv_one<3>(o[3], vb, pa0, pa1, pa2, pa3);
}
DEVI void attn_body(const bf16_t* __restrict__ Qb, const bf16_t* __restrict__ Kh, const bf16_t* __restrict__ Vh, bf16_t* __restrict__ Ob, int seq, char* lds) {
    const int tid = opaque_tid(), wid = tid >> 6, lane = tid & 63, r32 = lane & 31, hi = lane >> 5;
    char* V_lds = lds; char* K_lds = lds + 2 * SHM_V;
    float* wsf = (float*)(lds + 2 * SHM_V + 2 * SHM_K) + wid * 64; float* li_l = wsf; float* al_l = wsf + 32;
    float m_reg = -1e30f, l_reg = 0;
    f32x16 o[4];
#pragma unroll
    for (int d = 0; d < 4; ++d) o[d] = (f32x16){0.f, 0.f, 0.f, 0.f, 0.f, 0.f, 0.f, 0.f, 0.f, 0.f, 0.f, 0.f, 0.f, 0.f, 0.f, 0.f};
    bf16x8 qr[8];
    const bf16_t* Qw = Qb + (size_t)(wid * QBLK + r32) * DQ + hi * 8;
    char* qL = lds + 2 * SHM_V + 2 * SHM_K + NW * 64 * 4 + wid * 4096 + lane * 16;
#pragma unroll
    for (int d0 = 0; d0 < 8; ++d0) qr[d0] = *(const bf16x8*)(Qw + d0 * 16);
#pragma unroll
    for (int d0 = 8; d0 < 12; ++d0) *(bf16x8*)(qL + (d0 - 8) * 1024) = *(const bf16x8*)(Qw + d0 * 16);
    const int sr = tid >> 4, sc = (tid & 15) * 8, vst0 = v_st(sr, sc), vst1 = v_st(32 + sr, sc);
    const int kr0 = tid / 24, kc0 = (tid % 24) * 8, kr1 = (tid + 512) / 24, kc1 = ((tid + 512) % 24) * 8, kr2 = (tid + 1024) / 24, kc2 = ((tid + 1024) % 24) * 8;
    const int kst0 = KSWZ(kr0, kc0 * 2), kst1 = KSWZ(kr1, kc1 * 2), kst2 = KSWZ(kr2, kc2 * 2);
    const int vb0 = (int)(uintptr_t)V_lds + v_rd_base(lane);
    bf16x8 sv0, sv1, sk0, sk1, sk2;
#define SLOAD(k0) do { sv0 = *(const bf16x8*)(Vh + (size_t)((k0) + sr) * DV + sc); sv1 = *(const bf16x8*)(Vh + (size_t)((k0) + 32 + sr) * DV + sc); \
    sk0 = *(const bf16x8*)(Kh + (size_t)((k0) + kr0) * DQ + kc0); sk1 = *(const bf16x8*)(Kh + (size_t)((k0) + kr1) * DQ + kc1); sk2 = *(const bf16x8*)(Kh + (size_t)((k0) + kr2) * DQ + kc2); } while (0)
#define SWRITE(b) do { *(bf16x8*)(V_lds + (b) * SHM_V + vst0) = sv0; *(bf16x8*)(V_lds + (b) * SHM_V + vst1) = sv1; \
    *(bf16x8*)(K_lds + (b) * SHM_K + kst0) = sk0; *(bf16x8*)(K_lds + (b) * SHM_K + kst1) = sk1; *(bf16x8*)(K_lds + (b) * SHM_K + kst2) = sk2; } while (0)
#define RESC(a) do { if (__any((a) < 1.f)) { if (hi == 0) al_l[r32] = (a); asm volatile("s_waitcnt lgkmcnt(0)" ::: "memory"); \
    _Pragma("unroll") for (int d = 0; d < 4; ++d) _Pragma("unroll") for (int r = 0; r < 16; ++r) o[d][r] *= al_l[crow(r, hi)]; } } while (0)
    f32x16 pA0, pA1, pB0, pB1; float mnA, mnB, alA, alB; bf16x8 pa0, pa1, pa2, pa3; const int NT = seq / KVBLK;
    SLOAD(0); SWRITE(0); __syncthreads();
    qkt(pA0, pA1, K_lds, qr, qL, r32, hi); partialSM(pA0, pA1, m_reg, mnA, alA);
    SLOAD(KVBLK); SWRITE(1); __syncthreads();
    for (int j = 1; j + 1 < NT; j += 2) {
        SBAR(); qkt(pB0, pB1, K_lds + SHM_K, qr, qL, r32, hi);
        finishSM(pA0, pA1, alA, l_reg, pa0, pa1, pa2, pa3); SBAR();
        SLOAD((j + 1) * KVBLK); SBAR();
        pv_d0(o, vb0, pa0, pa1, pa2, pa3); partialSM(pB0, pB1, m_reg, mnB, alB);
        __syncthreads(); SWRITE(0);
        RESC(alB); __syncthreads();
        SBAR(); qkt(pA0, pA1, K_lds, qr, qL, r32, hi);
        finishSM(pB0, pB1, alB, l_reg, pa0, pa1, pa2, pa3); SBAR();
        SLOAD((j + 2) * KVBLK); SBAR();
        pv_d0(o, vb0 + SHM_V, pa0, pa1, pa2, pa3); partialSM(pA0, pA1, m_reg, mnA, alA);
        __syncthreads(); SWRITE(1);
        RESC(alA); __syncthreads();
    }
    SBAR(); qkt(pB0, pB1, K_lds + SHM_K, qr, qL, r32, hi);
    finishSM(pA0, pA1, alA, l_reg, pa0, pa1, pa2, pa3); SBAR();
    pv_d0(o, vb0, pa0, pa1, pa2, pa3); partialSM(pB0, pB1, m_reg, mnB, alB);
    __syncthreads(); RESC(alB);
    finishSM(pB0, pB1, alB, l_reg, pa0, pa1, pa2, pa3); SBAR();
    pv_d0(o, vb0 + SHM_V, pa0, pa1, pa2, pa3);
    if (hi == 0) li_l[r32] = l_reg; asm volatile("s_waitcnt lgkmcnt(0)" ::: "memory");
    float rli[16];
#pragma unroll
    for (int r = 0; r < 16; ++r) rli[r] = __builtin_amdgcn_rcpf(li_l[crow(r, hi)]);
    bf16_t* Ow = Ob + (size_t)(wid * QBLK) * DM;
#pragma unroll
    for (int r = 0; r < 16; ++r) { const int orow = crow(r, hi);
#pragma unroll
        for (int d0 = 0; d0 < 4; ++d0) Ow[(size_t)orow * DM + d0 * 32 + r32] = f2bf(o[d0][r] * rli[r]); }
    __syncthreads();
#undef SLOAD
#undef SWRITE
#undef RESC
}
}

template <int WIDTH>
DEVI void rstd_table(const bf16_t* P, int row0, int col0, float* rs) {
    constexpr int hw = WIDTH >> 1;
    const int tid = opaque_tid(), r = tid >> 1, half = tid & 1;
    const bf16_t* src = P + (size_t)(row0 + r) * INC + col0 + half * hw;
    float ss = 0.f;
#pragma unroll
    for (int i0 = 0; i0 < hw; i0 += 128) {
        bf16x8 t[16];
#pragma unroll
        for (int i = 0; i < 16; ++i) t[i] = *(const bf16x8*)(src + i0 + i * 8);
#pragma unroll
        for (int i = 0; i < 16; ++i) { float f[8]; unpack8(t[i], f);
#pragma unroll
            for (int e = 0; e < 8; ++e) ss += f[e] * f[e]; }
    }
    ss += __shfl_xor(ss, 1);
    if (half == 0) rs[r] = rsqrtf(ss / (float)WIDTH + EPS);
    __syncthreads();
}
struct EpiQ { static constexpr bool PERM = true; bf16_t* Q; const float* rs; const float* rax;
    DEVI void operator()(const f32x4 (&acc)[2][2][4][2], const pg8::Unit& u, int wr, int wc, int fr, int fq) const {
#pragma unroll
        for (int ai = 0; ai < 2; ++ai)
#pragma unroll
            for (int m = 0; m < 4; ++m) { const int rl = ai * 128 + wr * 64 + m * 16 + fr, row = u.pm * 256 + rl; const float sc = rs[u.ord * 256 + rl] * QSCALE;
                const bool lat = row < NLAT; const int b = lat ? (row >> 11) : ((row - NLAT) >> 8); const int t = lat ? (row & 2047) : ((row - NLAT) & 255);
                const int qpos = lat ? (CL + t) : t;
#pragma unroll
                for (int bj = 0; bj < 2; ++bj) { const int col = u.pn * 256 + bj * 128 + wc * 32 + 8 * fq; const int head = col / 192, d = col - head * 192;
                    f32x4 v0 = acc[ai][bj][m][0] * sc, v1 = acc[ai][bj][m][1] * sc;
                    if (lat && d >= 128) { const int pi = (d - 128) >> 1; const int pos = (pi < 16) ? (t >> 6) : (t & 63);
                        const f32x4 c0 = *(const f32x4*)(rax + (pos * 16 + (pi & 15)) * 2), c1 = *(const f32x4*)(rax + (pos * 16 + (pi & 15)) * 2 + 4);
                        v0 = (f32x4){v0[0] * c0[0] - v0[1] * c0[1], v0[0] * c0[1] + v0[1] * c0[0], v0[2] * c0[2] - v0[3] * c0[3], v0[2] * c0[3] + v0[3] * c0[2]};
                        v1 = (f32x4){v1[0] * c1[0] - v1[1] * c1[1], v1[0] * c1[1] + v1[1] * c1[0], v1[2] * c1[2] - v1[3] * c1[3], v1[2] * c1[3] + v1[3] * c1[2]}; }
                    *(u32x4*)(Q + ((size_t)(b * 8 + head) * KEYS + qpos) * 192 + d) = (u32x4){cvt_pk(v0[0], v0[1]), cvt_pk(v0[2], v0[3]), cvt_pk(v1[0], v1[1]), cvt_pk(v1[2], v1[3])}; }
                __builtin_amdgcn_sched_barrier(0); }
    } };
struct EpiKV { static constexpr bool PERM = true; bf16_t* Kb; bf16_t* Vb; const float* rs;
    DEVI void operator()(const f32x4 (&acc)[2][2][4][2], const pg8::Unit& u, int wr, int wc, int fr, int fq) const {
#pragma unroll
        for (int ai = 0; ai < 2; ++ai)
#pragma unroll
            for (int m = 0; m < 4; ++m) { const int rl = ai * 128 + wr * 64 + m * 16 + fr, row = u.pm * 256 + rl; const float sc = rs[u.ord * 256 + rl];
                const bool lat = row < NLAT; const int b = lat ? (row >> 11) : ((row - NLAT) >> 8); const int t = lat ? (row & 2047) : ((row - NLAT) & 255);
                const int kpos = lat ? (CL + t) : t; const int d = wc * 32 + 8 * fq;
                { const f32x4 v0 = acc[ai][0][m][0] * sc, v1 = acc[ai][0][m][1] * sc;
                  *(u32x4*)(Kb + ((size_t)(b * 8 + u.pn) * KEYS + kpos) * 192 + d) = (u32x4){cvt_pk(v0[0], v0[1]), cvt_pk(v0[2], v0[3]), cvt_pk(v1[0], v1[1]), cvt_pk(v1[2], v1[3])}; }
                { const f32x4 v0 = acc[ai][1][m][0] * sc, v1 = acc[ai][1][m][1] * sc;
                  *(u32x4*)(Vb + ((size_t)(b * 8 + u.pn) * KEYS + kpos) * 128 + d) = (u32x4){cvt_pk(v0[0], v0[1]), cvt_pk(v0[2], v0[3]), cvt_pk(v1[0], v1[1]), cvt_pk(v1[2], v1[3])}; } }
    } };

DEVI void phase_l2(const Params& p, int l, char* smem) {
    const bf16_t* P = (const bf16_t*)(p.ws + WS_P);
    float* rsq = (float*)(smem + 131072); float* rskv = rsq + 4 * 256;
    const float* rax = (const float*)(p.ws + WS_RAX);
    const int nqm = (l == 0) ? 36 : 32, nq = nqm * 6, nkv = 36 * 8, nsc = 2 * 16 * NCH;
    const pg8::PlainSched Sq{P, (const bf16_t*)(p.ws + WS_WUQ) + (size_t)l * 1536 * 512, INC, C_CQ, 512, nqm, 6, nq};
    const pg8::PlainSched Skv{P, (const bf16_t*)(p.ws + WS_WUKV) + (size_t)l * 2048 * 256, INC, C_CKV, 256, 36, 8, nkv};
    for (int i = 0; i < 4; ++i) { pg8::Unit u; if (Sq.next(i, u)) rstd_table<512>(P, u.pm * 256, C_CQ, rsq + i * 256); }
    for (int i = 0; i < 4; ++i) { pg8::Unit u; if (Skv.next(i, u)) rstd_table<256>(P, u.pm * 256, C_CKV, rskv + i * 256); }
#ifndef L2_GEMM_REP
#define L2_GEMM_REP 1
#endif
#ifndef L2_SCAN_REP
#define L2_SCAN_REP 1
#endif
#pragma nounroll
    for (int rep = 0; rep < L2_GEMM_REP; ++rep) {
    SUB(0) { pg8::gemm_phase((LAS unsigned char*)smem, 512, Sq, EpiQ{(bf16_t*)(p.ws + WS_Q), rsq, rax}); }
    SUB(1) { pg8::gemm_phase((LAS unsigned char*)smem, 256, Skv, EpiKV{(bf16_t*)(p.ws + WS_K), (bf16_t*)(p.ws + WS_V), rskv}); }
    }
    for (int i = 0; i < 4; ++i) {
        pg8::Unit uk; if (!Skv.next(i, uk)) break;
        const int pm = uk.pm, pn = uk.pn;
        bf16_t* Kb = (bf16_t*)(p.ws + WS_K);
        const int tid = opaque_tid(), rl = tid >> 1, half = tid & 1, row = pm * 256 + rl;
        const bool lat = row < NLAT; const int b = lat ? (row >> 11) : ((row - NLAT) >> 8); const int t = lat ? (row & 2047) : ((row - NLAT) & 255);
        const int kpos = lat ? (CL + t) : t;
        bf16_t* dst = Kb + ((size_t)(b * 8 + pn) * KEYS + kpos) * 192 + 128 + half * 32;
#pragma unroll
        for (int q = 0; q < 4; ++q) {
            float f[8]; unpack8(*(const bf16x8*)(P + (size_t)row * INC + C_KR + half * 32 + q * 8), f);
            if (lat) {
#pragma unroll
                for (int e = 0; e < 4; ++e) { const int pi = half * 16 + q * 4 + e; const int pos = (pi < 16) ? (t >> 6) : (t & 63);
                    const f32x2 cs = *(const f32x2*)(rax + (pos * 16 + (pi & 15)) * 2);
                    const float x1 = f[2 * e], x2 = f[2 * e + 1]; f[2 * e] = x1 * cs[0] - x2 * cs[1]; f[2 * e + 1] = x1 * cs[1] + x2 * cs[0]; }
            }
            *(bf16x8*)(dst + q * 8) = pack8(f);
        }
    }
    __syncthreads();
    {
        const int G = gridDim.x, nG = 16 * NCH;
        int u = (obid() + (G >> 1)) % G;
        {   GlaIn cur; bool have = u < nG;
            if (have) gla_load(p, l, (u / NCH) >> 2, (u / NCH) & 3, u % NCH, false, cur);
            while (have) { const int un = u + G; const bool hn = un < nG; GlaIn nxt;
                if (hn) gla_load(p, l, (un / NCH) >> 2, (un / NCH) & 3, un % NCH, false, nxt);
                CvtIn ci; cvt8_load(p, l, (l == 0 ? TS0A : TS1A) + u, ci);
                SUB(2) scan_a_gla(p, l, (u / NCH) >> 2, (u / NCH) & 3, u % NCH, cur, smem);
                cvt8_finish(p, l, (l == 0 ? TS0A : TS1A) + u, ci, smem);
                cur = nxt; u = un; have = hn; } }
        {   RetIn cur; bool have = u < nsc;
            if (have) { const int r = u - nG; ret_load(p, (r / NCH) >> 2, (r / NCH) & 3, r % NCH, false, cur); }
            while (have) { const int un = u + G; const bool hn = un < nsc; RetIn nxt; const int r = u - nG, rn = un - nG;
                if (hn) ret_load(p, (rn / NCH) >> 2, (rn / NCH) & 3, rn % NCH, false, nxt);
                CvtIn ci; cvt8_load(p, l, (l == 0 ? TS0A : TS1A) + u, ci);
                SUB(3) scan_a_ret(p, l, (r / NCH) >> 2, (r / NCH) & 3, r % NCH, cur, smem);
                cvt8_finish(p, l, (l == 0 ? TS0A : TS1A) + u, ci, smem);
                cur = nxt; u = un; have = hn; } }
    }
}

DEVI void phase_l4(const Params& p, int l, char* smem) {
    const bf16_t* Q = (const bf16_t*)(p.ws + WS_Q); const bf16_t* Kb = (const bf16_t*)(p.ws + WS_K); const bf16_t* Vb = (const bf16_t*)(p.ws + WS_V);
    bf16_t* ymix = (bf16_t*)(p.ws + WS_YMIX);
    const int nal = 256, nac = (l == 0) ? 32 : 0, ncs = (l == 0) ? NCH : 32, nsc = 2 * 16 * ncs;
#ifndef L4_ATT_REP
#define L4_ATT_REP 1
#endif
#ifndef L4_SCAN_REP
#define L4_SCAN_REP 1
#endif
    phase_prefix(p, smem);
    asm volatile("s_waitcnt vmcnt(0)" ::: "memory");
    __syncthreads();
    if (threadIdx.x == 0) { __builtin_amdgcn_fence(__ATOMIC_RELEASE, "agent"); asm volatile("s_waitcnt vmcnt(0)" ::: "memory");
        __hip_atomic_fetch_add((unsigned*)(p.ws + WS_BAR) + PFXCNT_WORD + 64 * l, 1u, __ATOMIC_RELAXED, __HIP_MEMORY_SCOPE_AGENT); }
#pragma nounroll
    for (int rep = 0; rep < L4_ATT_REP; ++rep)
    for (int u = obid(); u < nal + nac; u += gridDim.x) {
        if (u < nal) { SUB(4) {
            const int bh = u >> 3, qb = u & 7, b = bh >> 3, h = bh & 7;
            att::attn_body(Q + ((size_t)bh * KEYS + CL + qb * 256) * 192, Kb + (size_t)bh * KEYS * 192, Vb + (size_t)bh * KEYS * 128,
                           ymix + (size_t)(b * SEQ + qb * 256) * DM + h * 128, KEYS, smem);
        } } else { SUB(4) {
            const int bh = u - nal, b = bh >> 3, h = bh & 7;
            att::attn_body(Q + (size_t)bh * KEYS * 192, Kb + (size_t)bh * KEYS * 192, Vb + (size_t)bh * KEYS * 128,
                           ymix + (size_t)(NLAT + b * CL) * DM + h * 128, CL, smem);
        } }
    }
    if (threadIdx.x == 0) {
        unsigned* c = (unsigned*)(p.ws + WS_BAR) + PFXCNT_WORD + 64 * l; unsigned sp = 0;
        while (__hip_atomic_load(c, __ATOMIC_RELAXED, __HIP_MEMORY_SCOPE_AGENT) < gridDim.x) { __builtin_amdgcn_s_sleep(2); if (++sp > (1u << 22)) break; }
        __builtin_amdgcn_fence(__ATOMIC_ACQUIRE, "agent");
        asm volatile("s_waitcnt vmcnt(0)" ::: "memory");
    }
    __syncthreads();
    {
        const int G = gridDim.x, nG = 16 * ncs, c0 = NCH - ncs;
        int u = (obid() + G - (nal + nac) % G) % G;
        {   GlaIn cur; bool have = u < nG;
            if (have) gla_load(p, l, (u / ncs) >> 2, (u / ncs) & 3, u % ncs + c0, true, cur);
            while (have) { const int un = u + G; const bool hn = un < nG; GlaIn nxt;
                if (hn) gla_load(p, l, (un / ncs) >> 2, (un / ncs) & 3, un % ncs + c0, true, nxt);
                CvtIn ci; cvt8_load(p, l, (l == 0 ? TS0C : TS1C) + u, ci);
                SUB(5) scan_c_gla(p, l, (u / ncs) >> 2, (u / ncs) & 3, u % ncs + c0, cur, smem);
                cvt8_finish(p, l, (l == 0 ? TS0C : TS1C) + u, ci, smem);
                cur = nxt; u = un; have = hn; } }
        {   RetIn cur; bool have = u < nsc;
            if (have) { const int r = u - nG; ret_load(p, (r / ncs) >> 2, (r / ncs) & 3, r % ncs + c0, true, cur); }
            while (have) { const int un = u + G; const bool hn = un < nsc; RetIn nxt; const int r = u - nG, rn = un - nG;
                if (hn) ret_load(p, (rn / ncs) >> 2, (rn / ncs) & 3, rn % ncs + c0, true, nxt);
                CvtIn ci; cvt8_load(p, l, (l == 0 ? TS0C : TS1C) + u, ci);
                SUB(6) scan_c_ret(p, l, (r / ncs) >> 2, (r / ncs) & 3, r % ncs + c0, cur, smem);
                cvt8_finish(p, l, (l == 0 ? TS0C : TS1C) + u, ci, smem);
                cur = nxt; u = un; have = hn; } }
    }
}

struct EpiOut { static constexpr bool PERM = false; const Params* pp; int l;
    DEVI void operator()(const f32x4 (&acc)[2][2][4][2], const pg8::Unit& u, int wr, int wc, int fr, int fq) const {
        const Params& p = *pp; float* xres = (float*)(p.ws + WS_XRES);
        const float* mod = (const float*)(p.ws + WS_MOD) + (size_t)l * 5 * 12288;
#pragma unroll
        for (int ai = 0; ai < 2; ++ai)
#pragma unroll
            for (int m = 0; m < 4; ++m) { const int row = u.pm * 256 + ai * 128 + wr * 64 + m * 16 + fr;
                const bool lat = row < NLAT; const int b = lat ? (row >> 11) : 4;
                const float* xin = (l == 0) ? (lat ? p.x + (size_t)row * DM : p.ctx + (size_t)(row - NLAT) * DM) : xres + (size_t)row * DM;
                const float* ga = mod + (size_t)b * 12288 + 4096;
#pragma unroll
                for (int bj = 0; bj < 2; ++bj)
#pragma unroll
                    for (int n = 0; n < 2; ++n) { const int col = u.pn * 256 + bj * 128 + wc * 32 + n * 16 + 4 * fq;
                        const f32x4 xo = *(const f32x4*)(xin + col); const f32x4 g = *(const f32x4*)(ga + col);
                        *(f32x4*)(xres + (size_t)row * DM + col) = xo + g * acc[ai][bj][m][n]; }
                __builtin_amdgcn_sched_barrier(0); }
    } };
DEVI void phase_wout(const Params& p, int l, char* smem) {
    const int nm = (l == 0) ? 36 : 32;
    pg8::PlainSched S{(const bf16_t*)(p.ws + WS_YMIX), (const bf16_t*)(p.ws + WS_WOUT) + (size_t)l * 2048 * 2048, DM, 0, 2048, nm, 8, nm * 8};
    pg8::gemm_phase((LAS unsigned char*)smem, 2048, S, EpiOut{&p, l});
    if (l == 0) tail_convert(p, 0, TAIL_WOUT_B0, T0A, TAILT_WOUT, smem);
}

template <int N>
DEVI void bitonic_desc(unsigned long long* key, int tid) {
    for (int k = 2; k <= N; k <<= 1)
        for (int j = k >> 1; j > 0; j >>= 1) {
            for (int t = tid; t < N / 2; t += 512) {
                const int i = ((t & ~(j - 1)) << 1) | (t & (j - 1)), q = i | j;
                const unsigned long long a = key[i], b = key[q];
                const bool desc = (i & k) == 0;
                if (desc ? (a < b) : (a > b)) { key[i] = b; key[q] = a; }
            }
            __syncthreads();
        }
}
DEVI void phase_rank(const Params& p, int l, char* smem) {
    unsigned long long* key = (unsigned long long*)smem;
    const float* aff = (const float*)(p.ws + WS_AFF);
    int* rank = (int*)(p.ws + WS_RANK); int* selrow = (int*)(p.ws + WS_SELROW); float* selgate = (float*)(p.ws + WS_SELGATE);
    const int tid = opaque_tid();
    const int nl = 64, nc = (l == 0) ? 64 : 0;
#ifndef RANK_REP
#define RANK_REP 1
#endif
#pragma nounroll
    for (int rep = 0; rep < RANK_REP; ++rep)
    for (int u = obid(); u < nl + nc; u += (gridDim.x == 256 ? 64 : gridDim.x)) {
        if (gridDim.x == 256 && obid() >= 64) break;
        if (u < nl) {
            const int be = u, b = be >> 4, e = be & 15;
            const float* a = aff + (size_t)be * KEYS;
            for (int i = tid; i < 2048; i += 512) key[i] = ((unsigned long long)__float_as_uint(a[i]) << 32) | (unsigned)(2047 - i);
            __syncthreads();
            bitonic_desc<2048>(key, tid);
            for (int pos = tid; pos < 2048; pos += 512) { const unsigned long long kv = key[pos]; const int i = 2047 - (int)(unsigned)(kv & 0xffffffffull);
                rank[(size_t)be * KEYS + i] = pos;
                if (pos < 256) { selrow[e * MSLOT + b * 256 + pos] = b * SEQ + i; selgate[e * MSLOT + b * 256 + pos] = __uint_as_float((unsigned)(kv >> 32)); } }
            __syncthreads();
        } else {
            const int be = u - nl, b = be >> 4, e = be & 15;
            const float* a = aff + (size_t)be * KEYS + SEQ;
            if (tid < 256) key[tid] = ((unsigned long long)__float_as_uint(a[tid]) << 32) | (unsigned)(255 - tid);
            __syncthreads();
            bitonic_desc<256>(key, tid);
            if (tid < 256) { const int pos = tid; const unsigned long long kv = key[pos]; const int i = 255 - (int)(unsigned)(kv & 0xffffffffull);
                rank[(size_t)be * KEYS + SEQ + i] = pos;
                if (pos < 32) { selrow[e * MSLOT + 1024 + b * 32 + pos] = NLAT + b * CL + i; selgate[e * MSLOT + 1024 + b * 32 + pos] = __uint_as_float((unsigned)(kv >> 32)); } }
            __syncthreads();
        }
    }
    if (gridDim.x == 256) {
        const int first = 64, bid = obid();
        const int nt = (l == 0) ? RANKT0 : RANKT1;
        if (bid >= first) { const int t0 = ((l == 0) ? T0B : T1B) + (bid - first) * nt;
            cvt8_stream3(p, l, t0, nt, smem); }
    }
}

struct MoeGuSched { const bf16_t* hbuf; const bf16_t* Wgu; const int* selrow; int mvalid, nmt, units;
    DEVI bool next(int i, pg8::Unit& u) const {
        const int g = obid() + i * gridDim.x; if (g >= units) return false;
        int e, pm, pn;
        if (gridDim.x == 256) {
            const int c = g & 255, q = (g >> 8) * 32 + (c >> 3), per = nmt * 16, r = q % per, rr = r % (nmt * 4);
            e = 2 * (c & 7) + q / per; pm = rr % nmt; pn = (r / (nmt * 4)) * 4 + rr / nmt;
        } else { e = g / (nmt * 16); const int r = g % (nmt * 16); pm = r / 16; pn = r % 16; }
        u.e = e; u.pm = pm; u.pn = pn; u.ord = i; u.half = (nmt == 5 && pm == 4) ? 1 : 0;
        u.A = (const char*)hbuf; u.B = (const char*)Wgu + ((size_t)e * 4096 + u.pn * 256) * 2048; return true; }
    DEVI unsigned one(const pg8::Unit& u, int R, int C) const { const int slot = u.pm * 256 + R; const int row = (slot < mvalid) ? selrow[u.e * MSLOT + slot] : 0; return (unsigned)(row * (DM / 2) + C) * 2u; }
    DEVI void aoff(const pg8::Unit& u, int R0, int C0, int R1, int C1, unsigned (&o)[4]) const { o[0] = one(u, R0, C0); o[1] = one(u, R1, C1); o[2] = one(u, 128 + R0, C0); o[3] = one(u, 128 + R1, C1); }
};
struct EpiGU { static constexpr bool PERM = true; bf16_t* actb; int mvalid;
    DEVI void operator()(const f32x4 (&acc)[2][2][4][2], const pg8::Unit& u, int wr, int wc, int fr, int fq) const {
#pragma unroll
        for (int ai = 0; ai < 2; ++ai)
#pragma unroll
            for (int m = 0; m < 4; ++m) { const int slot = u.pm * 256 + ai * 128 + wr * 64 + m * 16 + fr;
                if (slot < mvalid) { const int col = u.pn * 128 + wc * 32 + 8 * fq;
                    constexpr float is = 1.f / W8_SCALE, us = ACT8_SCALE / W8_SCALE;
                    const f32x4 g0 = acc[ai][0][m][0] * is, g1 = acc[ai][0][m][1] * is, u0 = acc[ai][1][m][0] * us, u1 = acc[ai][1][m][1] * us;
                    *(u32x2*)((unsigned char*)actb + ((size_t)u.e * MSLOT + slot) * DM + col) = (u32x2){cvt4_fp8c(silu_f(g0[0]) * u0[0], silu_f(g0[1]) * u0[1], silu_f(g0[2]) * u0[2], silu_f(g0[3]) * u0[3]),
                                                                                                    cvt4_fp8c(silu_f(g1[0]) * u1[0], silu_f(g1[1]) * u1[1], silu_f(g1[2]) * u1[2], silu_f(g1[3]) * u1[3])}; } }
    } };
DEVI void phase_moe_gu(const Params& p, int l, char* smem) {
    const int mvalid = (l == 0) ? 1152 : 1024, nmt = (l == 0) ? 5 : 4;
    MoeGuSched S{(const bf16_t*)(p.ws + WS_H), (const bf16_t*)((const char*)(p.ws + WS_WGU) + (size_t)l * 16 * 4096 * 2048), (const int*)(p.ws + WS_SELROW), mvalid, nmt, 16 * nmt * 16};
    pg8::gemm_phase<MoeGuSched, EpiGU, true>((LAS unsigned char*)smem, 1024, S, EpiGU{(bf16_t*)(p.ws + WS_ACT), mvalid});
}
struct MoeDnSched { const bf16_t* actb; const bf16_t* Wdn; int nmt, units;
    DEVI bool next(int i, pg8::Unit& u) const {
        const int g = obid() + i * gridDim.x; if (g >= units) return false;
        int e, pm, pn;
        if (gridDim.x == 256 && nmt == 4) {
            const int c = g & 255, q = (g >> 8) * 32 + (c >> 3), per = nmt * 8, r = q % per, rr = r % (nmt * 4);
            e = 2 * (c & 7) + q / per; pm = rr % nmt; pn = (r / (nmt * 4)) * 4 + rr / nmt;
        } else { e = g / (nmt * 8); const int r = g % (nmt * 8); pm = r / 8; pn = r % 8; }
        u.e = e; u.pm = pm; u.pn = pn; u.ord = i; u.half = (nmt == 5 && pm == 4) ? 1 : 0;
        u.A = (const char*)actb + ((size_t)e * MSLOT + u.pm * 256) * DM; u.B = (const char*)Wdn + ((size_t)e * 2048 + u.pn * 256) * 2048; return true; }
    DEVI void aoff(const pg8::Unit&, int R0, int C0, int R1, int C1, unsigned (&o)[4]) const {
        o[0] = (unsigned)(R0 * (DM / 2) + C0) * 2u; o[1] = (unsigned)(R1 * (DM / 2) + C1) * 2u; o[2] = (unsigned)((128 + R0) * (DM / 2) + C0) * 2u; o[3] = (unsigned)((128 + R1) * (DM / 2) + C1) * 2u; }
};
struct EpiDN { static constexpr bool PERM = true; bf16_t* ydn; const float* selgate; int mvalid;
    DEVI void operator()(const f32x4 (&acc)[2][2][4][2], const pg8::Unit& u, int wr, int wc, int fr, int fq) const {
#pragma unroll
        for (int ai = 0; ai < 2; ++ai)
#pragma unroll
            for (int m = 0; m < 4; ++m) { const int slot = u.pm * 256 + ai * 128 + wr * 64 + m * 16 + fr;
                if (slot < mvalid) { const float gt = selgate[u.e * MSLOT + slot] * (1.f / (W8_SCALE * ACT8_SCALE));
#pragma unroll
                    for (int bj = 0; bj < 2; ++bj) { const int col = u.pn * 256 + bj * 128 + wc * 32 + 8 * fq; const f32x4 v0 = acc[ai][bj][m][0] * gt, v1 = acc[ai][bj][m][1] * gt;
                        *(u32x4*)(ydn + ((size_t)u.e * MSLOT + slot) * DM + col) = (u32x4){cvt_pk(v0[0], v0[1]), cvt_pk(v0[2], v0[3]), cvt_pk(v1[0], v1[1]), cvt_pk(v1[2], v1[3])}; } } }
    } };
DEVI void phase_moe_dn(const Params& p, int l, char* smem) {
    const int mvalid = (l == 0) ? 1152 : 1024, nmt = (l == 0) ? 5 : 4;
    MoeDnSched S{(const bf16_t*)(p.ws + WS_ACT), (const bf16_t*)((const char*)(p.ws + WS_WDN) + (size_t)l * 16 * 2048 * 2048), nmt, 16 * nmt * 8};
    pg8::gemm_phase<MoeDnSched, EpiDN, true>((LAS unsigned char*)smem, 1024, S, EpiDN{(bf16_t*)(p.ws + WS_YDN), (const float*)(p.ws + WS_SELGATE), mvalid});
    if (l == 0) tail_convert(p, 1, TAIL_DN_B0, 0, TAILT_DN, smem);
}

constexpr int NPHASE = 2 + 2 * 10;
__global__ void __launch_bounds__(512, 2) mega(Params p) {
    extern __shared__ __attribute__((aligned(1024))) char smem[];
    if (threadIdx.x == 0) *(uint4*)(smem + LDS_XB) = make_uint4(0u, 0u, 0u, 0u);
    __syncthreads();
    XcdBarrier bar = xcd_barrier_post((unsigned*)(p.ws + WS_BAR), (volatile LAS unsigned*)(smem + LDS_XB));
#ifndef PHMASK
#define PHMASK 0xFFFF
#endif
#ifndef PROBE_DUP
#define PROBE_DUP 0
#endif
#define RUN(bit, k, call) do { if constexpr ((PHMASK >> (bit)) & 1) { if ((k) >= p.ph_lo && (k) < p.ph_hi) { call; \
    if constexpr ((PROBE_DUP >> (bit)) & 1) { if ((bit) != 6 || l_probe == 0) { xcd_barrier(bar); call; } } \
    if ((k) + 1 < p.ph_hi) xcd_barrier(bar); } } } while (0)
    int l_probe = 0;
    RUN(0, 0, (phase_p0(p, smem), wait_mod(p), phase_rows<0>(p, 0, smem)));
#ifdef PROBE_XBAR
    for (int i = 0; i < PROBE_XBAR; ++i) xcd_barrier(bar);
#endif
    for (int l = 0; l < 2; ++l) {
        const int k0 = 2 + l * 10; l_probe = l;
        RUN(2, k0 + 0, phase_win(p, l, smem));
        RUN(3, k0 + 1, phase_l2(p, l, smem));
        RUN(5, k0 + 3, phase_l4(p, l, smem));
        RUN(6, k0 + 4, phase_wout(p, l, smem));
        RUN(7, k0 + 5, phase_rows<1>(p, l, smem));
        RUN(8, k0 + 6, phase_rank(p, l, smem));
        RUN(9, k0 + 7, phase_moe_gu(p, l, smem));
        RUN(10, k0 + 8, phase_moe_dn(p, l, smem));
        if (l == 0) RUN(11, k0 + 9, phase_rows<2>(p, 0, smem)); else RUN(12, k0 + 9, phase_rows<3>(p, 1, smem));
    }
#undef RUN
}

extern "C" void kernel_launch(void* const* d_in, const int* in_sizes, int n_in, void* d_out, int out_size, void* d_ws, size_t ws_size, hipStream_t stream) {
    static int grid = 0;
    if (!grid) {
        if (ws_size < WS_END) { fprintf(stderr, "kernel_launch: workspace too small: %zu < %zu\n", ws_size, (size_t)WS_END); return; }
        if (hipFuncSetAttribute((const void*)mega, hipFuncAttributeMaxDynamicSharedMemorySize, LDS_BYTES) != hipSuccess) { fprintf(stderr, "kernel_launch: LDS attribute failed\n"); return; }
        int dev = 0, cus = 0, per_cu = 0;
        hipGetDevice(&dev);
        hipDeviceGetAttribute(&cus, hipDeviceAttributeMultiprocessorCount, dev);
        hipOccupancyMaxActiveBlocksPerMultiprocessor(&per_cu, (const void*)mega, 512, LDS_BYTES);
        if (per_cu < 1) { fprintf(stderr, "kernel_launch: occupancy query says 0\n"); return; }
        grid = cus;
    }
    Params p{};
    p.x = (const float*)d_in[0]; p.c = (const float*)d_in[1]; p.ctx = (const float*)d_in[2]; p.c_ctx = (const float*)d_in[3];
    p.ada_w = (const float*)d_in[4]; p.ada_b = (const float*)d_in[5]; p.w_in = (const float*)d_in[6]; p.q_norm = (const float*)d_in[7];
    p.w_uq = (const float*)d_in[8]; p.kv_norm = (const float*)d_in[9]; p.w_ukv = (const float*)d_in[10]; p.gla_w2 = (const float*)d_in[11];
    p.gla_b = (const float*)d_in[12]; p.w_out = (const float*)d_in[13]; p.router_w = (const float*)d_in[14]; p.w_gate = (const float*)d_in[15];
    p.w_up = (const float*)d_in[16]; p.w_down = (const float*)d_in[17]; p.final_norm = (const float*)d_in[18];
    p.out = (float*)d_out; p.ws = (char*)d_ws;
    hipMemsetAsync((char*)d_ws + WS_BAR, 0, 16384, stream);
#if MK_ONE_LAUNCH
    p.ph_lo = 0; p.ph_hi = NPHASE;
    hipLaunchKernelGGL(mega, dim3(grid), dim3(512), LDS_BYTES, stream, p);
#else
    for (int k = 0; k < NPHASE; ++k) { p.ph_lo = k; p.ph_hi = k + 1; hipLaunchKernelGGL(mega, dim3(grid), dim3(512), LDS_BYTES, stream, p); }
#endif
    const hipError_t le = hipPeekAtLastError();
    if (le != hipSuccess) fprintf(stderr, "kernel_launch: launch failed: %s\n", hipGetErrorName(le));
}
```

```cpp
#include <hip/hip_runtime.h>
#include <stdint.h>
#include <stdio.h>

#ifndef MK_ONE_LAUNCH
#define MK_ONE_LAUNCH 1
#endif

#define DEVI __device__ __forceinline__
typedef unsigned short bf16_t;
typedef short bf16x8 __attribute__((ext_vector_type(8)));
typedef short s16x4 __attribute__((ext_vector_type(4)));
typedef float f32x2 __attribute__((ext_vector_type(2)));
typedef float f32x4 __attribute__((ext_vector_type(4)));
typedef float f32x8 __attribute__((ext_vector_type(8)));
typedef float f32x16 __attribute__((ext_vector_type(16)));
typedef unsigned u32x2 __attribute__((ext_vector_type(2)));
typedef unsigned u32x4 __attribute__((ext_vector_type(4)));
typedef int i32x4 __attribute__((ext_vector_type(4)));
typedef __bf16 bf16x2_t __attribute__((ext_vector_type(2)));

constexpr int DM = 2048, NB = 4, SEQ = 2048, CL = 256, NLAT = NB * SEQ, NCTX = NB * CL, NROW = NLAT + NCTX;
constexpr int INC = 4448, INCP = 4608;
constexpr int C_CQ = 0, C_CKV = 512, C_KR = 768, C_GQ = 832, C_GK = 1088, C_GV = 1344, C_GZ = 1856, C_GOG = 1888, C_RQ = 2400, C_RK = 2912, C_RV = 3424, C_RG = 3936;
constexpr int KEYS = SEQ + CL;
constexpr int NCH = 36;
constexpr int MSLOT = 1280;
constexpr float QSCALE = 0.07216878364870322f;
constexpr float EPS = 1e-6f;

constexpr size_t al256(size_t x) { return (x + 255) / 256 * 256; }
constexpr size_t WS_BAR = 0;
constexpr size_t WS_MOD = 16384;
constexpr size_t WS_RAX = WS_MOD + al256((size_t)2 * 5 * 12288 * 4);
constexpr size_t WS_RRET = WS_RAX + al256((size_t)64 * 16 * 2 * 4);
constexpr size_t WS_WIN = WS_RRET + al256((size_t)2048 * 64 * 2 * 4);
constexpr size_t WS_WUQ = WS_WIN + al256((size_t)2 * INCP * 2048 * 2);
constexpr size_t WS_WUKV = WS_WUQ + al256((size_t)2 * 1536 * 512 * 2);
constexpr size_t WS_WOUT = WS_WUKV + al256((size_t)2 * 2048 * 256 * 2);
constexpr size_t WS_WGU = WS_WOUT + al256((size_t)2 * 2048 * 2048 * 2);
constexpr size_t WS_WDN = WS_WGU + al256((size_t)2 * 16 * 4096 * 2048 * 2);
constexpr size_t WS_XRES = WS_WDN + al256((size_t)2 * 16 * 2048 * 2048 * 2);
constexpr size_t WS_H = WS_XRES + al256((size_t)NROW * DM * 4);
constexpr size_t WS_P = WS_H + al256((size_t)NROW * DM * 2);
constexpr size_t WS_Q = WS_P + al256((size_t)NROW * INC * 2);
constexpr size_t WS_K = WS_Q + al256((size_t)NB * 8 * KEYS * 192 * 2);
constexpr size_t WS_V = WS_K + al256((size_t)NB * 8 * KEYS * 192 * 2);
constexpr size_t WS_YMIX = WS_V + al256((size_t)NB * 8 * KEYS * 128 * 2);
constexpr size_t WS_UTG = WS_YMIX + al256((size_t)NROW * DM * 2);
constexpr size_t WS_UTR = WS_UTG + al256((size_t)32 * NCH * 128 * 64 * 4);
constexpr size_t WS_STG = WS_UTR + al256((size_t)32 * NCH * 128 * 128 * 4);
constexpr size_t WS_STR = WS_STG + al256((size_t)32 * NCH * 128 * 64 * 2);
constexpr size_t WS_DECG = WS_STR + al256((size_t)32 * NCH * 128 * 128 * 2);
constexpr size_t WS_AFF = WS_DECG + al256((size_t)32 * NCH * 64 * 4);
constexpr size_t WS_RANK = WS_AFF + al256((size_t)NB * 16 * KEYS * 4);
constexpr size_t WS_SELROW = WS_RANK + al256((size_t)NB * 16 * KEYS * 4);
constexpr size_t WS_SELGATE = WS_SELROW + al256((size_t)16 * MSLOT * 4);
constexpr size_t WS_ACT = WS_SELGATE + al256((size_t)16 * MSLOT * 4);
constexpr size_t WS_YDN = WS_ACT + al256((size_t)16 * MSLOT * 2048 * 2);
constexpr size_t WS_END = WS_YDN + al256((size_t)16 * MSLOT * 2048 * 2);

constexpr int MODCNT_WORD = 3584, P0_N_MOD_ITEMS = 512, PFXCNT_WORD = 3648;
constexpr int LDS_RS = 131072, LDS_XB = 131072 + 8192, LDS_BYTES = 131072 + 8192 + 64;
#ifndef SUBMASK
#define SUBMASK 0xFF
#endif
#define SUB(n) if constexpr ((SUBMASK >> (n)) & 1)

struct Params {
    const float *x, *c, *ctx, *c_ctx, *ada_w, *ada_b, *w_in, *q_norm, *w_uq, *kv_norm, *w_ukv, *gla_w2, *gla_b, *w_out, *router_w, *w_gate, *w_up, *w_down, *final_norm;
    float* out; char* ws; int ph_lo, ph_hi;
};

DEVI unsigned cvt_pk(float lo, float hi) { f32x2 v = {lo, hi}; bf16x2_t b = __builtin_convertvector(v, bf16x2_t); return __builtin_bit_cast(unsigned, b); }
DEVI bf16_t f2bf(float x) { return (bf16_t)(cvt_pk(x, 0.f) & 0xffffu); }
DEVI float bf2f(bf16_t b) { return __uint_as_float(((unsigned)b) << 16); }
DEVI float bflo(unsigned w) { return __uint_as_float(w << 16); }
DEVI float bfhi(unsigned w) { return __uint_as_float(w & 0xffff0000u); }
DEVI int obid() { int b = blockIdx.x; asm volatile("" : "+s"(b)); return b; }
DEVI int opaque_tid() { int t = threadIdx.x; asm volatile("" : "+v"(t)); return t; }
typedef int i32x8 __attribute__((ext_vector_type(8)));
DEVI float clamp8(float x) { return __builtin_amdgcn_fmed3f(x, -448.f, 448.f); }
DEVI unsigned cvt4_fp8(float a, float b, float c, float d) { int w = 0; w = __builtin_amdgcn_cvt_pk_fp8_f32(a, b, w, false); w = __builtin_amdgcn_cvt_pk_fp8_f32(c, d, w, true); return (unsigned)w; }
DEVI unsigned cvt4_fp8c(float a, float b, float c, float d) { return cvt4_fp8(clamp8(a), clamp8(b), clamp8(c), clamp8(d)); }
constexpr float W8_SCALE = 64.f, ACT8_SCALE = 4.f;
DEVI float silu_f(float x) { return x / (1.f + __expf(-x)); }
DEVI float wave_sum(float s) {
#pragma unroll
    for (int off = 32; off >= 1; off >>= 1) s += __shfl_xor(s, off);
    return s;
}
DEVI void unpack8(bf16x8 v, float (&f)[8]) {
    u32x4 w = __builtin_bit_cast(u32x4, v);
#pragma unroll
    for (int i = 0; i < 4; ++i) { f[2 * i] = bflo(w[i]); f[2 * i + 1] = bfhi(w[i]); }
}
DEVI bf16x8 pack8(const float (&f)[8]) {
    u32x4 w = {cvt_pk(f[0], f[1]), cvt_pk(f[2], f[3]), cvt_pk(f[4], f[5]), cvt_pk(f[6], f[7])};
    return __builtin_bit_cast(bf16x8, w);
}

#define XB_TMO      128
#define XB_XCNT(j)  (256  + 64 * (j))
#define XB_XSUB(j)  (1280 + 64 * (j))
#define XB_XGEN(j)  (2304 + 64 * (j))
#define XB_TOP      3328
#define XB_TOPGEN   3392
#define XCD_BAR_WORDS 3456
#define XB_SPIN_CAP (1u << 18)
#define LAS __attribute__((address_space(3)))
DEVI unsigned xb_ld(unsigned* p)              { return __hip_atomic_load(p, __ATOMIC_RELAXED, __HIP_MEMORY_SCOPE_AGENT); }
DEVI unsigned xb_add(unsigned* p, unsigned v) { return __hip_atomic_fetch_add(p, v, __ATOMIC_RELAXED, __HIP_MEMORY_SCOPE_AGENT); }
DEVI unsigned xb_xcc_id() { return (unsigned)__builtin_amdgcn_s_getreg((3 << 11) | 20) & 0xFu; }
#define XB_SPIN(cond, bar) do { unsigned _sp = 0; while (cond) { __builtin_amdgcn_s_sleep(1); \
    if ((++_sp & 255u) == 0u) { if (xb_ld(&(bar)[XB_TMO])) break; if (_sp > XB_SPIN_CAP) { atomicAdd(&(bar)[XB_TMO], 1u); break; } } } } while (0)
struct XcdBarrier { unsigned* bar; unsigned x; volatile LAS unsigned* st; };
DEVI XcdBarrier xcd_barrier_post(unsigned* bar, volatile LAS unsigned* st) {
    XcdBarrier b; b.bar = bar; b.x = xb_xcc_id(); b.st = st;
    if (threadIdx.x == 0) (void)xb_add(&bar[XB_XCNT(b.x)], 1u);
    return b;
}
DEVI void xcd_barrier_complete(unsigned* bar, unsigned x, unsigned& nloc, unsigned& nx) {
    const unsigned G = gridDim.x * gridDim.y * gridDim.z;
    unsigned sum, cnt, mine, sp = 0u;
    for (;;) {
        sum = 0u; cnt = 0u; mine = 0u;
#pragma unroll
        for (unsigned j = 0; j < 16; ++j) { const unsigned c = xb_ld(&bar[XB_XCNT(j)]); sum += c; cnt += (c > 0u) ? 1u : 0u; mine = (j == x) ? c : mine; }
        if (sum == G) break;
        __builtin_amdgcn_s_sleep(1);
        if ((++sp & 255u) == 0u) { if (xb_ld(&bar[XB_TMO])) break; if (sp > XB_SPIN_CAP) { atomicAdd(&bar[XB_TMO], 1u); break; } }
    }
    nloc = mine > 0u ? mine : 1u; nx = cnt > 0u ? cnt : 1u;
}
DEVI void xcd_barrier(const XcdBarrier& b) {
    asm volatile("s_waitcnt vmcnt(0)" ::: "memory");
    __syncthreads();
    if (threadIdx.x == 0) {
        unsigned* bar = b.bar;
        __builtin_amdgcn_s_waitcnt(0);
        unsigned nloc = b.st[0], nx = b.st[1];
        if (nloc == 0u) { xcd_barrier_complete(bar, b.x, nloc, nx); b.st[0] = nloc; b.st[1] = nx; }
        const unsigned old = xb_add(&bar[XB_XSUB(b.x)], 1u);
        const unsigned gen = old / nloc;
        if (old + 1u == (gen + 1u) * nloc) {
            __builtin_amdgcn_fence(__ATOMIC_RELEASE, "agent");
            asm volatile("s_waitcnt vmcnt(0)" ::: "memory");
            const unsigned og = xb_add(&bar[XB_TOP], 1u);
            const unsigned tg = og / nx;
            if (og + 1u == (tg + 1u) * nx) xb_add(&bar[XB_TOPGEN], 1u);
            else XB_SPIN(xb_ld(&bar[XB_TOPGEN]) == tg, bar);
            __builtin_amdgcn_fence(__ATOMIC_ACQUIRE, "agent");
            xb_add(&bar[XB_XGEN(b.x)], 1u);
            asm volatile("s_waitcnt vmcnt(0)" ::: "memory");
        } else {
            XB_SPIN(xb_ld(&bar[XB_XGEN(b.x)]) == gen, bar);
            __builtin_amdgcn_fence(__ATOMIC_ACQUIRE, "agent");
            asm volatile("s_waitcnt vmcnt(0)" ::: "memory");
        }
    }
    __syncthreads();
}

namespace pg8 {
constexpr int BM = 256, BK = 64, HALF = 128, HTB = HALF * BK * 2, STAGE_BYTES = 8 * HTB;
DEVI int lds_byte(int r, int c) { const int st = (r >> 4) * 2 + (c >> 5), rr = r & 15, cc = c & 31, ob = rr * 64 + cc * 2; return st * 1024 + (ob ^ (((ob >> 9) & 1) << 5)); }
DEVI void stage_rc(int b, int& R, int& C) { const int st = b / 1024, sb = b % 1024, swz = sb ^ (((sb >> 9) & 1) << 5); R = (st >> 1) * 16 + swz / 64; C = (st & 1) * 32 + (swz % 64) / 2; }
DEVI int perm32(int rho) { const int n = rho >> 4, i = rho & 15; return 8 * (i >> 2) + 4 * n + (i & 3); }
struct Unit { const char* A; const char* B; int pm, pn, e, ord, half; };

template <class Sched, class Epi, bool FP8 = false>
DEVI void gemm_phase(LAS unsigned char* lds, const int K, const Sched& S, const Epi& E) {
    const int tid = opaque_tid(), wid = __builtin_amdgcn_readfirstlane(tid >> 6), lane = tid & 63, wr = wid >> 2, wc = wid & 3, fr = lane & 15, fq = lane >> 4;
    const int nt = K / BK;
    int R0, C0, R1, C1; stage_rc(tid * 16, R0, C0); stage_rc(tid * 16 + 8192, R1, C1);
    unsigned voffB[2];
    { const int Rb0 = Epi::PERM ? ((R0 & ~31) + perm32(R0 & 31)) : R0, Rb1 = Epi::PERM ? ((R1 & ~31) + perm32(R1 & 31)) : R1;
      voffB[0] = (unsigned)(Rb0 * K + C0) * 2u; voffB[1] = (unsigned)(Rb1 * K + C1) * 2u; }
    const size_t kstep = (size_t)(BK * 2);
    const size_t hstepB = (size_t)HALF * K * 2;
    const unsigned ldsw = (unsigned)wid * 1024u;
    const int aoff = lds_byte(wr * 64 + fr, fq * 8), boff = lds_byte(wc * 32 + fr, fq * 8);
#define PG8_SA(b, h) (((b) * 2 + (h)) * HTB)
#define PG8_SB(b, h) ((4 + (b) * 2 + (h)) * HTB)
#define PG8_STAGE2(bufoff, gbase, v0, v1) do { \
        __builtin_amdgcn_global_load_lds((const unsigned*)((const char*)(gbase) + (v0)), (LAS unsigned*)(lds + (bufoff) + ldsw), 16, 0, 0); \
        __builtin_amdgcn_global_load_lds((const unsigned*)((const char*)(gbase) + (v1)), (LAS unsigned*)(lds + (bufoff) + ldsw + 8192), 16, 0, 0); } while (0)
#define PG8_STAGEB(bufoff, gbase) PG8_STAGE2(bufoff, gbase, voffB[0], voffB[1])
#define PG8_RD8(addr) __builtin_shufflevector(*(const LAS i32x4*)(addr), *(const LAS i32x4*)((addr) + 1024), 0, 1, 2, 3, 4, 5, 6, 7)
#define PG8_LDA(dst, b, h) do { if constexpr (FP8) { _Pragma("unroll") for (int m = 0; m < 4; ++m) dst##8[m] = PG8_RD8(lds + PG8_SA(b, h) + aoff + m * 2048); } \
        else { _Pragma("unroll") for (int m = 0; m < 4; ++m) _Pragma("unroll") for (int k = 0; k < 2; ++k) dst[m][k] = *(const LAS bf16x8*)(lds + PG8_SA(b, h) + aoff + m * 2048 + k * 1024); } } while (0)
#define PG8_LDB(dst, b, h) do { if constexpr (FP8) { _Pragma("unroll") for (int n = 0; n < 2; ++n) dst##8[n] = PG8_RD8(lds + PG8_SB(b, h) + boff + n * 2048); } \
        else { _Pragma("unroll") for (int n = 0; n < 2; ++n) _Pragma("unroll") for (int k = 0; k < 2; ++k) dst[n][k] = *(const LAS bf16x8*)(lds + PG8_SB(b, h) + boff + n * 2048 + k * 1024); } } while (0)
#define PG8_MMA(ai, bj, At, Bt) do { __builtin_amdgcn_s_setprio(1); _Pragma("unroll") for (int m = 0; m < 4; ++m) _Pragma("unroll") for (int n = 0; n < 2; ++n) { \
        if constexpr (FP8) asm volatile("v_mfma_scale_f32_16x16x128_f8f6f4 %0, %1, %2, %0, %3, %3 op_sel_hi:[0,0,0]" : "+v"(acc[ai][bj][m][n]) : "v"(Bt##8[n]), "v"(At##8[m]), "v"(mx_one));   \
        else { _Pragma("unroll") for (int k = 0; k < 2; ++k) acc[ai][bj][m][n] = __builtin_amdgcn_mfma_f32_16x16x32_bf16(Bt[n][k], At[m][k], acc[ai][bj][m][n], 0, 0, 0); } } \
        __builtin_amdgcn_s_setprio(0); } while (0)
#define PG8_WAIT_V(n) asm volatile("s_waitcnt vmcnt(" #n ")" ::: "memory")
#define PG8_WAIT_L(n) asm volatile("s_waitcnt lgkmcnt(" #n ")" ::: "memory")
#define PG8_BAR __builtin_amdgcn_s_barrier()
#define PG8_SCHED __builtin_amdgcn_sched_barrier(0)
    Unit cur, nxt; int ui = 0;
    if (!S.next(0, cur)) return;
    f32x4 acc[2][2][4][2];
#pragma unroll
    for (int a = 0; a < 2; ++a)
#pragma unroll
        for (int b = 0; b < 2; ++b)
#pragma unroll
            for (int m = 0; m < 4; ++m)
#pragma unroll
                for (int n = 0; n < 2; ++n) acc[a][b][m][n] = (f32x4){0.f, 0.f, 0.f, 0.f};
    bf16x8 At[4][2], B0[2][2], B1[2][2];
    i32x8 At8[4], B08[2], B18[2];
    const int mx_one = 0x7f7f7f7f;
    unsigned vc[4], vn[4];
    S.aoff(cur, R0, C0, R1, C1, vc);
    const char* cA = cur.A; const char* cB = cur.B;
    PG8_STAGEB(PG8_SB(0, 0), cB); PG8_STAGEB(PG8_SB(0, 1), cB + hstepB); PG8_STAGE2(PG8_SA(0, 0), cA, vc[0], vc[1]); PG8_STAGE2(PG8_SA(0, 1), cA, vc[2], vc[3]);
    if (wr == 1) PG8_BAR;
    PG8_WAIT_V(2); PG8_BAR;
    PG8_STAGEB(PG8_SB(1, 0), cB + kstep); PG8_STAGE2(PG8_SA(1, 0), cA + kstep, vc[0], vc[1]); PG8_STAGEB(PG8_SB(1, 1), cB + hstepB + kstep);
    PG8_WAIT_V(6); PG8_BAR;
    for (;;) {
        const bool has_next = S.next(ui + 1, nxt);
        if (has_next) S.aoff(nxt, R0, C0, R1, C1, vn);
        else { vn[0] = vc[0]; vn[1] = vc[1]; vn[2] = vc[2]; vn[3] = vc[3]; }
        const char* nA = has_next ? nxt.A : cA; const char* nB = has_next ? nxt.B : cB;
        const bool chalf = cur.half != 0;
#pragma nounroll
        for (int t = 0; t < nt; t += 2) {
            const bool last = (t == nt - 2);
            const char* a1 = cA + (size_t)(t + 1) * kstep;
            const char* a2 = last ? nA : cA + (size_t)(t + 2) * kstep; const char* b2 = last ? nB : cB + (size_t)(t + 2) * kstep;
            const char* a3 = a2 + kstep; const char* b3 = b2 + kstep;
            const unsigned w0 = last ? vn[0] : vc[0], w1 = last ? vn[1] : vc[1], w2 = last ? vn[2] : vc[2], w3 = last ? vn[3] : vc[3];
            PG8_LDB(B0, 0, 0); PG8_LDB(B1, 0, 1); PG8_SCHED; PG8_LDA(At, 0, 0); PG8_STAGE2(PG8_SA(1, 1), a1, vc[2], vc[3]);
            PG8_WAIT_V(8); PG8_WAIT_L(0); PG8_BAR; PG8_MMA(0, 0, At, B0); PG8_MMA(0, 1, At, B1); PG8_BAR; PG8_SCHED;
            PG8_LDA(At, 0, 1); PG8_STAGEB(PG8_SB(0, 0), b2); PG8_STAGEB(PG8_SB(0, 1), b2 + hstepB); PG8_STAGE2(PG8_SA(0, 0), a2, w0, w1);
            PG8_WAIT_V(8); PG8_WAIT_L(0); PG8_BAR; if (!chalf) { PG8_MMA(1, 0, At, B0); PG8_MMA(1, 1, At, B1); } PG8_BAR; PG8_SCHED;
            PG8_LDB(B0, 1, 0); PG8_LDB(B1, 1, 1); PG8_SCHED; PG8_LDA(At, 1, 0); PG8_STAGE2(PG8_SA(0, 1), a2, w2, w3);
            PG8_WAIT_V(8); PG8_WAIT_L(0); PG8_BAR; PG8_MMA(0, 0, At, B0); PG8_MMA(0, 1, At, B1); PG8_BAR; PG8_SCHED;
            PG8_LDA(At, 1, 1); PG8_STAGEB(PG8_SB(1, 0), b3); PG8_STAGEB(PG8_SB(1, 1), b3 + hstepB); PG8_STAGE2(PG8_SA(1, 0), a3, w0, w1);
            PG8_WAIT_V(8); PG8_WAIT_L(0); PG8_BAR; if (!chalf) { PG8_MMA(1, 0, At, B0); PG8_MMA(1, 1, At, B1); } PG8_BAR; PG8_SCHED;
        }
        if (wr == 0) PG8_BAR;
        E(acc, cur, wr, wc, fr, fq);
        if (!has_next) break;
#pragma unroll
        for (int a = 0; a < 2; ++a)
#pragma unroll
            for (int b = 0; b < 2; ++b)
#pragma unroll
                for (int m = 0; m < 4; ++m)
#pragma unroll
                    for (int n = 0; n < 2; ++n) acc[a][b][m][n] = (f32x4){0.f, 0.f, 0.f, 0.f};
        cur = nxt; cA = nA; cB = nB; ++ui; vc[0] = vn[0]; vc[1] = vn[1]; vc[2] = vn[2]; vc[3] = vn[3];
        if (wr == 1) PG8_BAR;
    }
    PG8_WAIT_V(0);
    PG8_BAR;
#undef PG8_SA
#undef PG8_SB
#undef PG8_STAGE2
#undef PG8_STAGEB
#undef PG8_LDA
#undef PG8_LDB
#undef PG8_MMA
#undef PG8_RD8
#undef PG8_WAIT_V
#undef PG8_WAIT_L
#undef PG8_BAR
#undef PG8_SCHED
}
struct PlainSched {
    const bf16_t* A; const bf16_t* Bt; int lda, acol0, K, nM, nN, units;
    DEVI bool next(int i, Unit& u) const {
        const int g = obid() + i * gridDim.x; if (g >= units) return false;
        int wgid = g; { const int q = units / 8, r = units % 8, xcd = wgid % 8, off = wgid / 8; wgid = (xcd < r ? xcd * (q + 1) : r * (q + 1) + (xcd - r) * q) + off; }
        const int nig = 8 * nN, gid = wgid / nig, fm = gid * 8, gsz = (nM - fm) < 8 ? (nM - fm) : 8;
        u.pm = fm + ((wgid % nig) % gsz); u.pn = (wgid % nig) / gsz; u.e = 0; u.ord = i; u.half = 0;
        u.A = (const char*)(A + (size_t)u.pm * 256 * lda + acol0); u.B = (const char*)(Bt + (size_t)u.pn * 256 * K); return true; }
    DEVI void aoff(const Unit&, int R0, int C0, int R1, int C1, unsigned (&o)[4]) const {
        o[0] = (unsigned)(R0 * lda + C0) * 2u; o[1] = (unsigned)(R1 * lda + C1) * 2u; o[2] = (unsigned)((128 + R0) * lda + C0) * 2u; o[3] = (unsigned)((128 + R1) * lda + C1) * 2u; }
};
}

DEVI void p0_mod_item(const Params& p, int item, char* smem) {
    const int l = item / 256, cb = item % 256, n0 = cb * 48;
    float* sv = (float*)smem;
    float* red = (float*)(smem + 65536);
    const int tid = opaque_tid(), wid = tid >> 6, lane = tid & 63;
    for (int idx = tid; idx < 2048; idx += 512) {
#pragma unroll
        for (int b = 0; b < 4; ++b) sv[idx * 8 + b] = silu_f(p.c[b * 2048 + idx]);
        sv[idx * 8 + 4] = silu_f(p.c_ctx[idx]);
    }
    __syncthreads();
    const int ln_c = lane < 48 ? lane : 47;
    const float* W = p.ada_w + (size_t)l * 2048 * 12288 + n0 + ln_c;
    float a0 = 0.f, a1 = 0.f, a2 = 0.f, a3 = 0.f, a4 = 0.f;
#pragma unroll 32
    for (int kk = 0; kk < 256; ++kk) {
        const int k = wid * 256 + kk;
        const float w = W[(size_t)k * 12288];
        const f32x4 s = *(const f32x4*)(sv + k * 8); const float s4 = sv[k * 8 + 4];
        a0 += s[0] * w; a1 += s[1] * w; a2 += s[2] * w; a3 += s[3] * w; a4 += s4 * w;
    }
    red[(wid * 5 + 0) * 64 + lane] = a0; red[(wid * 5 + 1) * 64 + lane] = a1; red[(wid * 5 + 2) * 64 + lane] = a2;
    red[(wid * 5 + 3) * 64 + lane] = a3; red[(wid * 5 + 4) * 64 + lane] = a4;
    __syncthreads();
    if (tid < 320 && (tid & 63) < 48) {
        const int i = tid >> 6, ln = tid & 63; float s = 0.f;
#pragma unroll
        for (int w = 0; w < 8; ++w) s += red[(w * 5 + i) * 64 + ln];
        float* mod = (float*)(p.ws + WS_MOD);
        __hip_atomic_store(&mod[(size_t)(l * 5 + i) * 12288 + n0 + ln], s + p.ada_b[l * 12288 + n0 + ln], __ATOMIC_RELAXED, __HIP_MEMORY_SCOPE_AGENT);
    }
    asm volatile("s_waitcnt vmcnt(0)" ::: "memory");
    __syncthreads();
    if (tid == 0) __hip_atomic_fetch_add((unsigned*)(p.ws + WS_BAR) + MODCNT_WORD, 1u, __ATOMIC_RELAXED, __HIP_MEMORY_SCOPE_AGENT);
}
DEVI void wait_mod(const Params& p) {
    if (threadIdx.x == 0) {
        unsigned* c = (unsigned*)(p.ws + WS_BAR) + MODCNT_WORD; unsigned sp = 0;
        while (__hip_atomic_load(c, __ATOMIC_RELAXED, __HIP_MEMORY_SCOPE_AGENT) < (unsigned)P0_N_MOD_ITEMS) { __builtin_amdgcn_s_sleep(2); if (++sp > (1u << 22)) break; }
        __builtin_amdgcn_fence(__ATOMIC_ACQUIRE, "agent");
        asm volatile("s_waitcnt vmcnt(0)" ::: "memory");
    }
    __syncthreads();
}

struct CvtD { const float* src; const float* scale; bf16_t* dst; int ldn, nvalid, K, k0, n0, d0; };
DEVI CvtD p0_bf16_desc(const Params& p, int j) {
    CvtD d;
    if (j < 1152) { const int l = j / 576, r = j % 576, kt = r / 36, nt = r % 36;
        d = CvtD{p.w_in + (size_t)l * 2048 * INC, nullptr, (bf16_t*)(p.ws + WS_WIN) + (size_t)l * INCP * 2048, INC, INC, 2048, kt * 128, nt * 128, nt * 128}; return d; }
    j -= 1152;
    if (j < 96) { const int l = j / 48, r = j % 48, kt = r / 12, nt = r % 12;
        d = CvtD{p.w_uq + (size_t)l * 512 * 1536, p.q_norm + l * 512, (bf16_t*)(p.ws + WS_WUQ) + (size_t)l * 1536 * 512, 1536, 1536, 512, kt * 128, nt * 128, nt * 128}; return d; }
    j -= 96;
    if (j < 64) { const int l = j / 32, r = j % 32, kt = r / 16, nt = r % 16;
        d = CvtD{p.w_ukv + (size_t)l * 256 * 2048, p.kv_norm + l * 256, (bf16_t*)(p.ws + WS_WUKV) + (size_t)l * 2048 * 256, 2048, 2048, 256, kt * 128, nt * 128, nt * 128}; return d; }
    j -= 64;
    { const int l = j / 256, r = j % 256, kt = r / 16, nt = r % 16;
        d = CvtD{p.w_out + (size_t)l * 2048 * 2048, nullptr, (bf16_t*)(p.ws + WS_WOUT) + (size_t)l * 2048 * 2048, 2048, 2048, 2048, kt * 128, nt * 128, nt * 128}; return d; }
}
struct CvtRegs { f32x4 v[8]; };
DEVI void cvt_tile_load(const CvtD& d, CvtRegs& rg) {
    const int tid = opaque_tid(), nq = tid & 31, kq0 = tid >> 5;
#pragma unroll
    for (int it = 0; it < 2; ++it)
#pragma unroll
        for (int kk = 0; kk < 4; ++kk) { const int k = d.k0 + (kq0 + it * 16) * 4 + kk, n = d.n0 + nq * 4;
            f32x4 v = (n < d.nvalid) ? *(const f32x4*)(d.src + (size_t)k * d.ldn + n) : (f32x4){0.f, 0.f, 0.f, 0.f};
            if (d.scale) v *= d.scale[k];
            rg.v[it * 4 + kk] = v; }
}
DEVI void cvt_tile_finish(const CvtD& d, const CvtRegs& rg, char* smem) {
    bf16_t* T = (bf16_t*)smem;
    const int tid = opaque_tid(), nq = tid & 31, kq0 = tid >> 5;
#pragma unroll
    for (int it = 0; it < 2; ++it) { const int kq = kq0 + it * 16;
#pragma unroll
        for (int j = 0; j < 4; ++j) { u32x2 w = {cvt_pk(rg.v[it * 4][j], rg.v[it * 4 + 1][j]), cvt_pk(rg.v[it * 4 + 2][j], rg.v[it * 4 + 3][j])};
            *(u32x2*)(T + (nq * 4 + j) * 132 + kq * 4) = w; } }
    __syncthreads();
#pragma unroll
    for (int i = 0; i < 8; ++i) { const int nl = (tid >> 5) + 16 * i, kc = (tid & 31) * 4;
        *(u32x2*)(d.dst + (size_t)(d.d0 + nl) * d.K + d.k0 + kc) = *(const u32x2*)(T + nl * 132 + kc); }
    __syncthreads();
}

struct CvtIn { f32x4 v[8]; };
DEVI void cvt8_load(const Params& p, int L, int t, CvtIn& in) {
    const int which = t / 4096, r = t % 4096, le = L * 16 + r / 256, kt = (r % 256) / 16, nt = r % 16;
    const float* src = (which == 2 ? p.w_down : (which == 0 ? p.w_gate : p.w_up)) + (size_t)le * 2048 * 2048;
    const int tid = opaque_tid(), nq = tid & 31, kq0 = tid >> 5;
#pragma unroll
    for (int it = 0; it < 2; ++it)
#pragma unroll
        for (int kk = 0; kk < 4; ++kk) in.v[it * 4 + kk] = __builtin_nontemporal_load((const f32x4*)(src + (size_t)(kt * 128 + (kq0 + it * 16) * 4 + kk) * 2048 + nt * 128 + nq * 4));
}
DEVI void cvt8_finish(const Params& p, int L, int t, const CvtIn& in, char* smem) {
    const int which = t / 4096, r = t % 4096, le = L * 16 + r / 256, kt = (r % 256) / 16, nt = r % 16;
    unsigned char* dst = (which == 2) ? (unsigned char*)(p.ws + WS_WDN) + (size_t)le * 2048 * 2048 + (size_t)(nt * 128) * 2048
                                      : (unsigned char*)(p.ws + WS_WGU) + (size_t)le * 4096 * 2048 + (size_t)(nt * 256 + which * 128) * 2048;
    unsigned char* T = (unsigned char*)smem;
    const int tid = opaque_tid(), nq = tid & 31, kq0 = tid >> 5;
#pragma unroll
    for (int it = 0; it < 2; ++it) { const int kq = kq0 + it * 16;
#pragma unroll
        for (int j = 0; j < 4; ++j) *(unsigned*)(T + (nq * 4 + j) * 144 + kq * 4) =
            cvt4_fp8(in.v[it * 4][j] * W8_SCALE, in.v[it * 4 + 1][j] * W8_SCALE, in.v[it * 4 + 2][j] * W8_SCALE, in.v[it * 4 + 3][j] * W8_SCALE); }
    __syncthreads();
#pragma unroll
    for (int i = 0; i < 2; ++i) { const int nl = (tid >> 3) + 64 * i, kc = (tid & 7) * 16;
        *(u32x4*)(dst + (size_t)nl * 2048 + kt * 128 + kc) = *(const u32x4*)(T + nl * 144 + kc); }
    __syncthreads();
}
DEVI void cvt8_stream(const Params& p, int L, int t0, int step, int count, char* smem) {
    if (count <= 0) return;
    CvtIn cur; cvt8_load(p, L, t0, cur);
    for (int i = 0; i < count; ++i) { const int t = t0 + i * step; CvtIn nxt;
        if (i + 1 < count) cvt8_load(p, L, t + step, nxt);
        cvt8_finish(p, L, t, cur, smem);
        cur = nxt; }
}
DEVI void cvt8_stream3(const Params& p, int L, int t0, int step, int count, char* smem) {
    if (count <= 0) return;
    CvtIn a, b; cvt8_load(p, L, t0, a);
    if (count > 1) cvt8_load(p, L, t0 + step, b);
#pragma nounroll
    for (int i = 0; i < count; ++i) { CvtIn c;
        if (i + 2 < count) cvt8_load(p, L, t0 + (i + 2) * step, c);
        cvt8_finish(p, L, t0 + i * step, a, smem);
        a = b; b = c; }
}
#ifndef TAILT_WIN
#define TAILT_WIN 18
#endif
#ifndef TAILT_WOUT
#define TAILT_WOUT 14
#endif
#ifndef TAILT_DN
#define TAILT_DN 10
#endif
constexpr int TAIL_WIN_B0 = 648 - 2 * 256, TAIL_WOUT_B0 = 288 - 256, TAIL_DN_B0 = 640 - 2 * 256;
constexpr int T0A = (256 - TAIL_WIN_B0) * TAILT_WIN, T0B = T0A + (256 - TAIL_WOUT_B0) * TAILT_WOUT, T1A = (256 - TAIL_DN_B0) * TAILT_DN, T1B = T1A + (256 - TAIL_WIN_B0) * TAILT_WIN;
static_assert(T0B <= 12288 && T1B <= 12288, "tail tiles");
DEVI void tail_convert(const Params& p, int L, int first_block, int base, int ntile, char* smem) {
    if (gridDim.x != 256 || obid() < first_block) return;
    cvt8_stream3(p, L, base + (obid() - first_block), 256 - first_block, ntile, smem);
}
#ifndef RANKT0
#define RANKT0 14
#endif
#ifndef RANKT1
#define RANKT1 14
#endif
constexpr int T0C = T0B + 192 * RANKT0, T1C = T1B + 192 * RANKT1;
static_assert(T0C <= 12288 && T1C <= 12288, "tail tiles");
constexpr int SCAN_A_UNITS = 2 * 16 * NCH, SCAN_C0_UNITS = 2 * 16 * NCH, SCAN_C1_UNITS = 2 * 16 * 32;
constexpr int TS0A = 12288 - SCAN_A_UNITS - SCAN_C0_UNITS, TS0C = 12288 - SCAN_C0_UNITS;
constexpr int TS1A = 12288 - SCAN_A_UNITS - SCAN_C1_UNITS, TS1C = 12288 - SCAN_C1_UNITS;
static_assert(T0C <= TS0A && T1C <= TS1A, "scan tiles");
constexpr int P0_N_MOD = 512, P0_N_WIN = 2 * 16 * 36, P0_N_WUQ = 2 * 4 * 12, P0_N_WUKV = 2 * 2 * 16, P0_N_WOUT = 2 * 16 * 16, P0_N_EXP0 = TS0A - T0C, P0_N_EXP = (TS0A - T0C) + (TS1A - T1C), P0_N_TAB = (1024 + 2048 * 64) / 512;
constexpr int P0_ITEMS = P0_N_MOD + P0_N_WIN + P0_N_WUQ + P0_N_WUKV + P0_N_WOUT + P0_N_EXP + P0_N_TAB;

DEVI void phase_p0(const Params& p, char* smem) {
    if (gridDim.x != 256) {
        { const int b0 = obid(), G = gridDim.x; if (b0 < T0C) cvt8_stream(p, 0, b0, G, (T0C - b0 + G - 1) / G, smem); if (b0 < T1C) cvt8_stream(p, 1, b0, G, (T1C - b0 + G - 1) / G, smem); }
    }
    for (int item = obid(); item < P0_ITEMS; item += gridDim.x) {
        int j = item;
        if (j < P0_N_MOD) { p0_mod_item(p, j, smem); continue; }
        j -= P0_N_MOD;
        if (j < P0_N_WIN + P0_N_WUQ + P0_N_WUKV + P0_N_WOUT) continue;
        j -= P0_N_WIN + P0_N_WUQ + P0_N_WUKV + P0_N_WOUT;
        if (j < P0_N_EXP) continue;
        j -= P0_N_EXP;
        {
            const int idx = j * 512 + threadIdx.x;
            if (idx < 1024) { const int pos = idx >> 4, f = idx & 15;
                const float inv = (float)pow(10000.0, -(double)f / 16.0); const float ang = (float)pos * inv;
                float* t = (float*)(p.ws + WS_RAX); t[idx * 2] = (float)cos((double)ang); t[idx * 2 + 1] = (float)sin((double)ang);
            } else { const int q = idx - 1024, tt = q >> 6, pp = q & 63;
                const float inv = (float)(1.0 / pow(10000.0, (double)pp / 63.0)); const float ang = (float)tt * inv;
                float* t = (float*)(p.ws + WS_RRET); t[q * 2] = (float)cos((double)ang); t[q * 2 + 1] = (float)sin((double)ang);
            }
        }
    }
    {
        const int G = gridDim.x, NB16 = P0_N_WIN + P0_N_WUQ + P0_N_WUKV + P0_N_WOUT;
        int first = obid() - P0_N_MOD % G; if (first < 0) first += G;
        if (first < NB16) { CvtD dc = p0_bf16_desc(p, first); CvtRegs rc; cvt_tile_load(dc, rc);
            for (int jj = first; jj < NB16; jj += G) { CvtD dn = dc; CvtRegs rn;
                if (jj + G < NB16) { dn = p0_bf16_desc(p, jj + G); cvt_tile_load(dn, rn); }
                cvt_tile_finish(dc, rc, smem);
                dc = dn; rc = rn; } }
    }
    {
        const int G = gridDim.x, EXP_BASE = P0_N_MOD + P0_N_WIN + P0_N_WUQ + P0_N_WUKV + P0_N_WOUT;
        int first = obid() - EXP_BASE % G; if (first < 0) first += G;
        if (first < P0_N_EXP0) cvt8_stream(p, 0, T0C + first, G, (P0_N_EXP0 - first + G - 1) / G, smem);
        int f1 = first; if (f1 < P0_N_EXP0) f1 += ((P0_N_EXP0 - f1 + G - 1) / G) * G;
        if (f1 < P0_N_EXP) cvt8_stream(p, 1, T1C + (f1 - P0_N_EXP0), G, (P0_N_EXP - f1 + G - 1) / G, smem);
    }
}

template <int MODE>
DEVI void phase_rows(const Params& p, int l, char* smem) {
    const int tid = opaque_tid(), wid = tid >> 6, lane = tid & 63;
    float* xres = (float*)(p.ws + WS_XRES);
    bf16_t* hbuf = (bf16_t*)(p.ws + WS_H);
    const float* mod = (const float*)(p.ws + WS_MOD);
    float* wT = (float*)smem;
    if (MODE == 1) {
        const float* rw = p.router_w + (size_t)l * 2048 * 16;
        f32x4 rwv[16];
#pragma unroll
        for (int it = 0; it < 16; ++it) { const int i = tid + it * 512; rwv[it] = *(const f32x4*)(rw + (i >> 2) * 16 + (i & 3) * 4); }
#pragma unroll
        for (int it = 0; it < 16; ++it) { const int i = tid + it * 512, k = i >> 2, e4 = (i & 3) * 4; const f32x4 v = rwv[it];
            wT[(e4 + 0) * 2048 + k] = v[0]; wT[(e4 + 1) * 2048 + k] = v[1]; wT[(e4 + 2) * 2048 + k] = v[2]; wT[(e4 + 3) * 2048 + k] = v[3]; }
        __syncthreads();
    }
    const int nrows = (MODE == 3 || (MODE == 1 && l == 1)) ? NLAT : NROW;
    for (int row = obid() * 8 + wid; row < nrows; row += gridDim.x * 8) {
        const bool lat = row < NLAT;
        const int b = lat ? (row >> 11) : ((row - NLAT) >> 8);
        const int tok = lat ? (row & 2047) : (SEQ + ((row - NLAT) & 255));
        const float* src = (MODE == 0) ? (lat ? p.x + (size_t)row * DM : p.ctx + (size_t)(row - NLAT) * DM) : xres + (size_t)row * DM;
        float v[32];
#pragma unroll
        for (int i = 0; i < 8; ++i) { const f32x4 t = *(const f32x4*)(src + i * 256 + lane * 4); v[i * 4] = t[0]; v[i * 4 + 1] = t[1]; v[i * 4 + 2] = t[2]; v[i * 4 + 3] = t[3]; }
        const float* mrow = mod + (size_t)(((MODE == 2) ? l : l) * 5 + (lat ? b : 4)) * 12288;
        if (MODE == 2 || MODE == 3) {
            float cacc[32];
#pragma unroll
            for (int i = 0; i < 32; ++i) cacc[i] = 0.f;
            const int* rk = (const int*)(p.ws + WS_RANK) + (size_t)b * 16 * KEYS + tok;
            const bf16_t* ydn = (const bf16_t*)(p.ws + WS_YDN);
            const int cap = lat ? 256 : 32;
            int rke[16];
#pragma unroll
            for (int e = 0; e < 16; ++e) rke[e] = rk[e * KEYS];
#pragma unroll
            for (int e = 0; e < 16; ++e) {
                const int r = rke[e];
                if (r < cap) {
                    const int slot = lat ? (b * 256 + r) : (1024 + b * 32 + r);
                    const bf16_t* yr = ydn + ((size_t)e * MSLOT + slot) * DM;
#pragma unroll
                    for (int i = 0; i < 8; ++i) { const u32x2 w = *(const u32x2*)(yr + i * 256 + lane * 4);
                        cacc[i * 4] += bflo(w[0]); cacc[i * 4 + 1] += bfhi(w[0]); cacc[i * 4 + 2] += bflo(w[1]); cacc[i * 4 + 3] += bfhi(w[1]); }
                }
            }
            const float* gf = mrow + 10240;
#pragma unroll
            for (int i = 0; i < 8; ++i) { const f32x4 g = *(const f32x4*)(gf + i * 256 + lane * 4);
                v[i * 4] += g[0] * cacc[i * 4]; v[i * 4 + 1] += g[1] * cacc[i * 4 + 1]; v[i * 4 + 2] += g[2] * cacc[i * 4 + 2]; v[i * 4 + 3] += g[3] * cacc[i * 4 + 3]; }
            if (MODE == 2) {
#pragma unroll
                for (int i = 0; i < 8; ++i) *(f32x4*)(xres + (size_t)row * DM + i * 256 + lane * 4) = (f32x4){v[i * 4], v[i * 4 + 1], v[i * 4 + 2], v[i * 4 + 3]};
            }
        }
        float ss = 0.f;
#pragma unroll
        for (int i = 0; i < 32; ++i) ss += v[i] * v[i];
        ss = wave_sum(ss);
        const float rstd = rsqrtf(ss * (1.f / DM) + EPS);
        if (MODE == 3) {
#pragma unroll
            for (int i = 0; i < 8; ++i) { const f32x4 g = *(const f32x4*)(p.final_norm + i * 256 + lane * 4);
                __builtin_nontemporal_store((f32x4){v[i * 4] * rstd * g[0], v[i * 4 + 1] * rstd * g[1], v[i * 4 + 2] * rstd * g[2], v[i * 4 + 3] * rstd * g[3]}, (f32x4*)(p.out + (size_t)row * DM + i * 256 + lane * 4)); }
            continue;
        }
        const float* mr2 = (MODE == 2) ? mrow + (size_t)5 * 12288 : mrow;
        const float* sh = mr2 + ((MODE == 1) ? 6144 : 0);
        const float* sc = mr2 + ((MODE == 1) ? 8192 : 2048);
#pragma unroll
        for (int i = 0; i < 8; ++i) { const f32x4 a = *(const f32x4*)(sh + i * 256 + lane * 4); const f32x4 s = *(const f32x4*)(sc + i * 256 + lane * 4);
#pragma unroll
            for (int j = 0; j < 4; ++j) v[i * 4 + j] = v[i * 4 + j] * rstd * (1.f + s[j]) + a[j];
            if (MODE == 1) *(unsigned*)((unsigned char*)hbuf + (size_t)row * DM + i * 256 + lane * 4) = cvt4_fp8c(v[i * 4], v[i * 4 + 1], v[i * 4 + 2], v[i * 4 + 3]);
            else *(u32x2*)(hbuf + (size_t)row * DM + i * 256 + lane * 4) = (u32x2){cvt_pk(v[i * 4], v[i * 4 + 1]), cvt_pk(v[i * 4 + 2], v[i * 4 + 3])}; }
        if (MODE == 1) {
            float a[16];
#pragma unroll
            for (int e = 0; e < 16; ++e) { float t = 0.f;
#pragma unroll
                for (int i = 0; i < 8; ++i) { const f32x4 w = *(const f32x4*)(wT + e * 2048 + i * 256 + lane * 4);
                    t += v[i * 4] * w[0] + v[i * 4 + 1] * w[1] + v[i * 4 + 2] * w[2] + v[i * 4 + 3] * w[3]; }
                a[e] = t; if ((e & 3) == 3) __builtin_amdgcn_sched_barrier(0); }
            const bool b5 = (lane & 32) != 0, b4 = (lane & 16) != 0, b3 = (lane & 8) != 0, b2 = (lane & 4) != 0;
            float s8[8], s4[4], s2[2], s1;
#pragma unroll
            for (int i = 0; i < 8; ++i) { const float keep = b5 ? a[8 + i] : a[i], give = b5 ? a[i] : a[8 + i]; s8[i] = keep + __shfl_xor(give, 32); }
#pragma unroll
            for (int i = 0; i < 4; ++i) { const float keep = b4 ? s8[4 + i] : s8[i], give = b4 ? s8[i] : s8[4 + i]; s4[i] = keep + __shfl_xor(give, 16); }
#pragma unroll
            for (int i = 0; i < 2; ++i) { const float keep = b3 ? s4[2 + i] : s4[i], give = b3 ? s4[i] : s4[2 + i]; s2[i] = keep + __shfl_xor(give, 8); }
            { const float keep = b2 ? s2[1] : s2[0], give = b2 ? s2[0] : s2[1]; s1 = keep + __shfl_xor(give, 4); }
            s1 += __shfl_xor(s1, 2); s1 += __shfl_xor(s1, 1);
            float mx = s1;
#pragma unroll
            for (int off = 32; off >= 4; off >>= 1) mx = fmaxf(mx, __shfl_xor(mx, off));
            const float ex = expf(s1 - mx); float den = ex;
#pragma unroll
            for (int off = 32; off >= 4; off >>= 1) den += __shfl_xor(den, off);
            const int eidx = (b5 ? 8 : 0) + (b4 ? 4 : 0) + (b3 ? 2 : 0) + (b2 ? 1 : 0);
            if ((lane & 3) == 0) ((float*)(p.ws + WS_AFF))[((size_t)b * 16 + eidx) * KEYS + tok] = ex / den;
        }
    }
    if (MODE == 1) __syncthreads();
}

struct EpiWin { static constexpr bool PERM = true; bf16_t* P;
    DEVI void operator()(const f32x4 (&acc)[2][2][4][2], const pg8::Unit& u, int wr, int wc, int fr, int fq) const {
#pragma unroll
        for (int ai = 0; ai < 2; ++ai)
#pragma unroll
            for (int m = 0; m < 4; ++m) { const int row = u.pm * 256 + ai * 128 + wr * 64 + m * 16 + fr;
#pragma unroll
                for (int bj = 0; bj < 2; ++bj) { const int col = u.pn * 256 + bj * 128 + wc * 32 + 8 * fq;
                    if (col < INC) { const f32x4 a = acc[ai][bj][m][0], b = acc[ai][bj][m][1];
                        *(u32x4*)(P + (size_t)row * INC + col) = (u32x4){cvt_pk(a[0], a[1]), cvt_pk(a[2], a[3]), cvt_pk(b[0], b[1]), cvt_pk(b[2], b[3])}; } } }
    } };
DEVI void phase_win(const Params& p, int l, char* smem) {
    pg8::PlainSched S{(const bf16_t*)(p.ws + WS_H), (const bf16_t*)(p.ws + WS_WIN) + (size_t)l * INCP * 2048, DM, 0, 2048, 36, 18, 36 * 18};
    pg8::gemm_phase((LAS unsigned char*)smem, 2048, S, EpiWin{(bf16_t*)(p.ws + WS_P)});
    if (l == 0) tail_convert(p, 0, TAIL_WIN_B0, 0, TAILT_WIN, smem); else tail_convert(p, 1, TAIL_WIN_B0, T1A, TAILT_WIN, smem);
}

DEVI float log_sigmoid_f(float x) { return fminf(x, 0.f) - __logf(1.f + __expf(-fabsf(x))); }
DEVI bf16x8 ldfrag(const bf16_t* base, int ld, int row0, int k0, int fr, int fq) { return *(const bf16x8*)(base + (row0 + fr) * ld + k0 + fq * 8); }
DEVI int chunk_row0(int b, int c) { return (c < 4) ? (NLAT + b * CL + c * 64) : (b * SEQ + (c - 4) * 64); }
DEVI int order_idx(int dir, int c) { return dir == 0 ? c : ((c < 4) ? (3 - c) : (4 + 35 - c)); }

struct GlaIn { bf16x8 q, k, v0, v1, g0, g1, z0, z1, z2, z3, bw; float bias; };
DEVI void gla_load(const Params& p, int l, int b, int h, int c, bool need_qg, GlaIn& in) {
    const bf16_t* P = (const bf16_t*)(p.ws + WS_P);
    const int tid = opaque_tid(), wid = tid >> 6, lane = tid & 63, fr = lane & 15, fq = lane >> 4, d = wid >> 2, kf = wid & 3, kk = kf * 16 + fr;
    const int row0 = chunk_row0(b, c), tk = tid >> 3, c8 = (tid & 7) * 8;
    in.k = *(const bf16x8*)(P + (size_t)(row0 + tk) * INC + C_GK + h * 64 + c8);
    in.v0 = *(const bf16x8*)(P + (size_t)(row0 + tk) * INC + C_GV + h * 128 + c8);
    in.v1 = *(const bf16x8*)(P + (size_t)(row0 + tk) * INC + C_GV + h * 128 + 64 + c8);
    if (need_qg) {
        in.q = *(const bf16x8*)(P + (size_t)(row0 + tk) * INC + C_GQ + h * 64 + c8);
        in.g0 = *(const bf16x8*)(P + (size_t)(row0 + tk) * INC + C_GOG + h * 128 + (tid & 7) * 16);
        in.g1 = *(const bf16x8*)(P + (size_t)(row0 + tk) * INC + C_GOG + h * 128 + (tid & 7) * 16 + 8);
    }
    const bf16x8 zero = {0, 0, 0, 0, 0, 0, 0, 0};
    in.z0 = zero; in.z1 = zero; in.z2 = zero; in.z3 = zero; in.bw = zero;
    if (fq < 2) {
        const bf16_t* zp = P + (size_t)(row0 + fr) * INC + C_GZ + d * 16 + fq * 8;
        in.z0 = *(const bf16x8*)(zp); in.z1 = *(const bf16x8*)(zp + (size_t)16 * INC); in.z2 = *(const bf16x8*)(zp + (size_t)32 * INC); in.z3 = *(const bf16x8*)(zp + (size_t)48 * INC);
        float wv[8];
#pragma unroll
        for (int j = 0; j < 8; ++j) wv[j] = p.gla_w2[((size_t)(l * 2 + d) * 16 + fq * 8 + j) * 256 + h * 64 + kk];
        in.bw = pack8(wv);
    }
    in.bias = p.gla_b[(size_t)(l * 2 + d) * 256 + h * 64 + kk];
}
DEVI void gla_cum(const GlaIn& in, float* cum) {
    const int tid = opaque_tid(), wid = tid >> 6, lane = tid & 63, fr = lane & 15, fq = lane >> 4, d = wid >> 2, kf = wid & 3;
    const int kk = kf * 16 + fr;
    float la[4][4];
#pragma unroll
    for (int f = 0; f < 4; ++f) {
        const bf16x8 az = (f == 0) ? in.z0 : (f == 1) ? in.z1 : (f == 2) ? in.z2 : in.z3;
        f32x4 acc = {0.f, 0.f, 0.f, 0.f};
        acc = __builtin_amdgcn_mfma_f32_16x16x32_bf16(az, in.bw, acc, 0, 0, 0);
#pragma unroll
        for (int r = 0; r < 4; ++r) la[f][r] = log_sigmoid_f(acc[r] + in.bias) * (1.f / 16.f);
    }
    if (d == 0) {
        float carry = 0.f;
#pragma unroll
        for (int f = 0; f < 4; ++f) {
            la[f][1] += la[f][0]; la[f][2] += la[f][1]; la[f][3] += la[f][2];
            float x = la[f][3]; const float own = x;
            float y = __shfl_up(x, 16); if (fq >= 1) x += y;
            y = __shfl_up(x, 32); if (fq >= 2) x += y;
            const float excl = x - own + carry;
            carry += __shfl(x, 48 + fr);
#pragma unroll
            for (int r = 0; r < 4; ++r) la[f][r] += excl;
        }
    } else {
        float carry = 0.f;
#pragma unroll
        for (int f = 3; f >= 0; --f) {
            la[f][2] += la[f][3]; la[f][1] += la[f][2]; la[f][0] += la[f][1];
            float x = la[f][0]; const float own = x;
            float y = __shfl_down(x, 16); if (fq <= 2) x += y;
            y = __shfl_down(x, 32); if (fq <= 1) x += y;
            const float excl = x - own + carry;
            carry += __shfl(x, fr);
#pragma unroll
            for (int r = 0; r < 4; ++r) la[f][r] += excl;
        }
    }
#pragma unroll
    for (int f = 0; f < 4; ++f)
#pragma unroll
        for (int r = 0; r < 4; ++r) cum[(d * 64 + f * 16 + fq * 4 + r) * 64 + kk] = la[f][r];
    __syncthreads();
}

DEVI void scan_a_gla(const Params& p, int l, int b, int h, int c, const GlaIn& in, char* smem) {
    float* cum = (float*)(smem + 18432);
    bf16_t* kTf = (bf16_t*)(smem + 51200); bf16_t* kTb = kTf + 64 * 72; bf16_t* vT = kTb + 64 * 72;
    const int tid = opaque_tid(), wid = tid >> 6, lane = tid & 63, fr = lane & 15, fq = lane >> 4;
    const int tk = tid >> 3, c8 = (tid & 7) * 8;
    const bf16x8 kreg = in.k, v0 = in.v0, v1 = in.v1;
    gla_cum(in, cum);
    {   float kf[8]; unpack8(kreg, kf);
#pragma unroll
        for (int e = 0; e < 8; ++e) { const int kk = c8 + e;
            kTf[kk * 72 + tk] = f2bf(kf[e] * __expf(cum[(0 * 64 + 63) * 64 + kk] - cum[(0 * 64 + tk) * 64 + kk]));
            kTb[kk * 72 + tk] = f2bf(kf[e] * __expf(cum[(1 * 64 + 0) * 64 + kk] - cum[(1 * 64 + tk) * 64 + kk])); }
#pragma unroll
        for (int e = 0; e < 8; ++e) { vT[(c8 + e) * 72 + tk] = (bf16_t)v0[e]; vT[(64 + c8 + e) * 72 + tk] = (bf16_t)v1[e]; }
    }
    if (tid < 128) { const int d = tid >> 6, kk = tid & 63;
        ((float*)(p.ws + WS_DECG))[((size_t)((b * 4 + h) * 2 + d) * NCH + order_idx(d, c)) * 64 + kk] = __expf(d == 0 ? cum[(0 * 64 + 63) * 64 + kk] : cum[(1 * 64 + 0) * 64 + kk]); }
    __syncthreads();
    {   const int dir = wid >> 2, kkf = wid & 3;
        const bf16_t* kT = dir ? kTb : kTf;
        const bf16x8 a0 = ldfrag(kT, 72, kkf * 16, 0, fr, fq), a1 = ldfrag(kT, 72, kkf * 16, 32, fr, fq);
        bf16_t* UT = (bf16_t*)(p.ws + WS_UTG) + ((size_t)((b * 4 + h) * 2 + dir) * NCH + order_idx(dir, c)) * (128 * 64);
#pragma unroll
        for (int vf = 0; vf < 8; ++vf) {
            f32x4 acc = {0.f, 0.f, 0.f, 0.f};
            acc = __builtin_amdgcn_mfma_f32_16x16x32_bf16(a0, ldfrag(vT, 72, vf * 16, 0, fr, fq), acc, 0, 0, 0);
            acc = __builtin_amdgcn_mfma_f32_16x16x32_bf16(a1, ldfrag(vT, 72, vf * 16, 32, fr, fq), acc, 0, 0, 0);
            *(u32x2*)(UT + (vf * 16 + fr) * 64 + kkf * 16 + fq * 4) = (u32x2){cvt_pk(acc[0], acc[1]), cvt_pk(acc[2], acc[3])};
        }
    }
    __syncthreads();
}

DEVI void ret_decays(int h, float& ldf, float& ldb) { ldf = log1pf(-exp2f(-(5.f + 2.f * h))); ldb = log1pf(-exp2f(-(6.f + 2.f * h))); }

struct RetIn { bf16x8 q0, q1, k0, k1, v0, v1, g0, g1; f32x4 cs0, cs1, cs2, cs3; };
DEVI void ret_load(const Params& p, int b, int h, int c, bool need_qg, RetIn& in) {
    const bf16_t* P = (const bf16_t*)(p.ws + WS_P);
    const float* rret = (const float*)(p.ws + WS_RRET);
    const int tid = opaque_tid(), tk = tid >> 3, kk16 = (tid & 7) * 16;
    const size_t rb = (size_t)(chunk_row0(b, c) + tk) * INC;
    in.k0 = *(const bf16x8*)(P + rb + C_RK + h * 128 + kk16); in.k1 = *(const bf16x8*)(P + rb + C_RK + h * 128 + kk16 + 8);
    in.v0 = *(const bf16x8*)(P + rb + C_RV + h * 128 + kk16); in.v1 = *(const bf16x8*)(P + rb + C_RV + h * 128 + kk16 + 8);
    if (need_qg) {
        in.q0 = *(const bf16x8*)(P + rb + C_RQ + h * 128 + kk16); in.q1 = *(const bf16x8*)(P + rb + C_RQ + h * 128 + kk16 + 8);
        in.g0 = *(const bf16x8*)(P + rb + C_RG + h * 128 + kk16); in.g1 = *(const bf16x8*)(P + rb + C_RG + h * 128 + kk16 + 8);
    }
    if (c >= 4) { const float* tb = rret + ((size_t)((c - 4) * 64 + tk) * 64 + (kk16 >> 1)) * 2;
        in.cs0 = *(const f32x4*)(tb); in.cs1 = *(const f32x4*)(tb + 4); in.cs2 = *(const f32x4*)(tb + 8); in.cs3 = *(const f32x4*)(tb + 12); }
}
DEVI void ret_rot(const bf16x8 r0, const bf16x8 r1, const RetIn& in, bool lat, float scale, float (&o)[16]) {
    float a[8], c[8]; unpack8(r0, a); unpack8(r1, c);
#pragma unroll
    for (int i = 0; i < 8; ++i) { o[i] = a[i]; o[8 + i] = c[i]; }
    if (lat) {
#pragma unroll
        for (int q = 0; q < 4; ++q) { const f32x4 cs = (q == 0) ? in.cs0 : (q == 1) ? in.cs1 : (q == 2) ? in.cs2 : in.cs3;
            const float x1 = o[4 * q], x2 = o[4 * q + 1], y1 = o[4 * q + 2], y2 = o[4 * q + 3];
            o[4 * q] = x1 * cs[0] - x2 * cs[1]; o[4 * q + 1] = x1 * cs[1] + x2 * cs[0];
            o[4 * q + 2] = y1 * cs[2] - y2 * cs[3]; o[4 * q + 3] = y1 * cs[3] + y2 * cs[2]; }
    }
#pragma unroll
    for (int i = 0; i < 16; ++i) o[i] *= scale;
}

DEVI void scan_a_ret(const Params& p, int l, int b, int h, int c, const RetIn& in, char* smem) {
    bf16_t* kTf = (bf16_t*)smem; bf16_t* kTb = kTf + 128 * 72; bf16_t* vT = kTb + 128 * 72;
    const int tid = opaque_tid(), wid = tid >> 6, lane = tid & 63, fr = lane & 15, fq = lane >> 4;
    const bool lat = c >= 4;
    const int tk = tid >> 3, kk16 = (tid & 7) * 16;
    float ldf, ldb; ret_decays(h, ldf, ldb);
    float kf[16];
    ret_rot(in.k0, in.k1, in, lat, 0.08838834764831845f, kf);
    const float ef = __expf(ldf * (float)(63 - tk)), eb = __expf(ldb * (float)tk);
#pragma unroll
    for (int e = 0; e < 16; ++e) { kTf[(kk16 + e) * 72 + tk] = f2bf(kf[e] * ef); kTb[(kk16 + e) * 72 + tk] = f2bf(kf[e] * eb); }
    {   const bf16x8 v0 = in.v0, v1 = in.v1;
#pragma unroll
        for (int e = 0; e < 8; ++e) { vT[(kk16 + e) * 72 + tk] = (bf16_t)v0[e]; vT[(kk16 + 8 + e) * 72 + tk] = (bf16_t)v1[e]; } }
    __syncthreads();
    {   const int dir = wid >> 2;
        const bf16_t* kT = dir ? kTb : kTf;
        bf16_t* UT = (bf16_t*)(p.ws + WS_UTR) + ((size_t)((b * 4 + h) * 2 + dir) * NCH + order_idx(dir, c)) * (128 * 128);
#pragma unroll
        for (int q = 0; q < 2; ++q) { const int kkf = (wid & 3) * 2 + q;
            const bf16x8 a0 = ldfrag(kT, 72, kkf * 16, 0, fr, fq), a1 = ldfrag(kT, 72, kkf * 16, 32, fr, fq);
#pragma unroll
            for (int vf = 0; vf < 8; ++vf) {
                f32x4 acc = {0.f, 0.f, 0.f, 0.f};
                acc = __builtin_amdgcn_mfma_f32_16x16x32_bf16(a0, ldfrag(vT, 72, vf * 16, 0, fr, fq), acc, 0, 0, 0);
                acc = __builtin_amdgcn_mfma_f32_16x16x32_bf16(a1, ldfrag(vT, 72, vf * 16, 32, fr, fq), acc, 0, 0, 0);
                *(u32x2*)(UT + (vf * 16 + fr) * 128 + kkf * 16 + fq * 4) = (u32x2){cvt_pk(acc[0], acc[1]), cvt_pk(acc[2], acc[3])};
            } }
    }
    __syncthreads();
}

DEVI void phase_prefix(const Params& p, char* smem) {
    const int NT_G = 32 * 2048, NT_R = 32 * 4096;
    for (int g = obid() * 512 + threadIdx.x; g < NT_G + NT_R; g += gridDim.x * 512) {
        if (g < NT_G) {
            const int seq = g >> 11, e4 = (g & 2047) * 4, kk = e4 & 63;
            const bf16_t* U = (const bf16_t*)(p.ws + WS_UTG) + (size_t)seq * NCH * 8192 + e4;
            bf16_t* S = (bf16_t*)(p.ws + WS_STG) + (size_t)seq * NCH * 8192 + e4;
            const float* dec = (const float*)(p.ws + WS_DECG) + (size_t)seq * NCH * 64 + kk;
            f32x4 st = {0.f, 0.f, 0.f, 0.f};
#pragma unroll 12
            for (int o = 0; o < NCH; ++o) {
                const u32x2 uw = *(const u32x2*)(U + (size_t)o * 8192); const f32x4 u = {bflo(uw[0]), bfhi(uw[0]), bflo(uw[1]), bfhi(uw[1])}; const f32x4 dd = *(const f32x4*)(dec + o * 64);
                *(u32x2*)(S + (size_t)o * 8192) = (u32x2){cvt_pk(st[0], st[1]), cvt_pk(st[2], st[3])};
                st = dd * st + u;
            }
        } else {
            const int g2 = g - NT_G, seq = g2 >> 12, e4 = (g2 & 4095) * 4;
            const int h = (seq >> 1) & 3, dir = seq & 1;
            float ldf, ldb; ret_decays(h, ldf, ldb);
            const float dd = __expf(64.f * (dir ? ldb : ldf));
            const bf16_t* U = (const bf16_t*)(p.ws + WS_UTR) + (size_t)seq * NCH * 16384 + e4;
            bf16_t* S = (bf16_t*)(p.ws + WS_STR) + (size_t)seq * NCH * 16384 + e4;
            f32x4 st = {0.f, 0.f, 0.f, 0.f};
#pragma unroll 12
            for (int o = 0; o < NCH; ++o) {
                const u32x2 uw = *(const u32x2*)(U + (size_t)o * 16384); const f32x4 u = {bflo(uw[0]), bfhi(uw[0]), bflo(uw[1]), bfhi(uw[1])};
                *(u32x2*)(S + (size_t)o * 16384) = (u32x2){cvt_pk(st[0], st[1]), cvt_pk(st[2], st[3])};
                st = dd * st + u;
            }
        }
    }
}

DEVI void scan_c_tail(const float* o, int tid, const bf16x8 g0, const bf16x8 g1, int row0, bf16_t* ymix, int ycol) {
    const int tk = tid >> 3, v16 = (tid & 7) * 16;
    float ov[16]; float ss = 0.f;
#pragma unroll
    for (int q = 0; q < 4; ++q) { const f32x4 t = *(const f32x4*)(o + tk * 128 + v16 + q * 4); ov[q * 4] = t[0]; ov[q * 4 + 1] = t[1]; ov[q * 4 + 2] = t[2]; ov[q * 4 + 3] = t[3]; }
#pragma unroll
    for (int i = 0; i < 16; ++i) ss += ov[i] * ov[i];
    ss += __shfl_xor(ss, 1); ss += __shfl_xor(ss, 2); ss += __shfl_xor(ss, 4);
    const float rstd = rsqrtf(ss * (1.f / 128.f) + EPS);
    float ga[8], gb[8]; unpack8(g0, ga); unpack8(g1, gb);
    float y0[8], y1[8];
#pragma unroll
    for (int i = 0; i < 8; ++i) { y0[i] = ov[i] * rstd * silu_f(ga[i]); y1[i] = ov[8 + i] * rstd * silu_f(gb[i]); }
    *(bf16x8*)(ymix + (size_t)(row0 + tk) * DM + ycol + v16) = pack8(y0);
    *(bf16x8*)(ymix + (size_t)(row0 + tk) * DM + ycol + v16 + 8) = pack8(y1);
}

DEVI void scan_c_gla(const Params& p, int l, int b, int h, int c, const GlaIn& in, char* smem) {
    float* cum = (float*)(smem + 18432);
    float* obuf = cum;
    bf16_t* qdf = (bf16_t*)(smem + 51200); bf16_t* qdb = qdf + 64 * 72; bf16_t* kif = qdb + 64 * 72; bf16_t* kib = kif + 64 * 72;
    bf16_t* vT = kib + 64 * 72; bf16_t* att = vT + 128 * 72;
    const int tid = opaque_tid(), wid = tid >> 6, lane = tid & 63, fr = lane & 15, fq = lane >> 4;
    const int row0 = chunk_row0(b, c);
    const int tk = tid >> 3, c8 = (tid & 7) * 8;
    const bf16x8 qreg = in.q, kreg = in.k, v0 = in.v0, v1 = in.v1, gt0 = in.g0, gt1 = in.g1;
    const bf16_t* SF = (const bf16_t*)(p.ws + WS_STG) + ((size_t)((b * 4 + h) * 2 + 0) * NCH + order_idx(0, c)) * 8192;
    const bf16_t* SB = (const bf16_t*)(p.ws + WS_STG) + ((size_t)((b * 4 + h) * 2 + 1) * NCH + order_idx(1, c)) * 8192;
    const bf16x8 sf0 = *(const bf16x8*)(SF + (wid * 16 + fr) * 64 + fq * 8), sf1 = *(const bf16x8*)(SF + (wid * 16 + fr) * 64 + 32 + fq * 8);
    const bf16x8 sb0 = *(const bf16x8*)(SB + (wid * 16 + fr) * 64 + fq * 8), sb1 = *(const bf16x8*)(SB + (wid * 16 + fr) * 64 + 32 + fq * 8);
    gla_cum(in, cum);
    {   float qf[8], kf[8]; unpack8(qreg, qf); unpack8(kreg, kf);
        float a[8], bq[8], cc[8], dq[8];
#pragma unroll
        for (int e = 0; e < 8; ++e) { const float cf = cum[(0 * 64 + tk) * 64 + c8 + e], cb = cum[(1 * 64 + tk) * 64 + c8 + e];
            a[e] = qf[e] * 0.125f * __expf(cf); bq[e] = qf[e] * 0.125f * __expf(cb); cc[e] = kf[e] * __expf(-cf); dq[e] = kf[e] * __expf(-cb); }
        *(bf16x8*)(qdf + tk * 72 + c8) = pack8(a); *(bf16x8*)(qdb + tk * 72 + c8) = pack8(bq);
        *(bf16x8*)(kif + tk * 72 + c8) = pack8(cc); *(bf16x8*)(kib + tk * 72 + c8) = pack8(dq);
#pragma unroll
        for (int e = 0; e < 8; ++e) { vT[(c8 + e) * 72 + tk] = (bf16_t)v0[e]; vT[(64 + c8 + e) * 72 + tk] = (bf16_t)v1[e]; }
    }
    __syncthreads();
    {
        const int jf = wid & 3;
#pragma unroll
        for (int q = 0; q < 2; ++q) { const int iff = (wid >> 2) * 2 + q;
            f32x4 af = {0.f, 0.f, 0.f, 0.f}, ab = {0.f, 0.f, 0.f, 0.f};
            if (iff >= jf) {
                af = __builtin_amdgcn_mfma_f32_16x16x32_bf16(ldfrag(kif, 72, jf * 16, 0, fr, fq), ldfrag(qdf, 72, iff * 16, 0, fr, fq), af, 0, 0, 0);
                af = __builtin_amdgcn_mfma_f32_16x16x32_bf16(ldfrag(kif, 72, jf * 16, 32, fr, fq), ldfrag(qdf, 72, iff * 16, 32, fr, fq), af, 0, 0, 0); }
            if (iff <= jf) {
                ab = __builtin_amdgcn_mfma_f32_16x16x32_bf16(ldfrag(kib, 72, jf * 16, 0, fr, fq), ldfrag(qdb, 72, iff * 16, 0, fr, fq), ab, 0, 0, 0);
                ab = __builtin_amdgcn_mfma_f32_16x16x32_bf16(ldfrag(kib, 72, jf * 16, 32, fr, fq), ldfrag(qdb, 72, iff * 16, 32, fr, fq), ab, 0, 0, 0); }
            const int i = iff * 16 + fr, j0 = jf * 16 + fq * 4;
            float r[4];
#pragma unroll
            for (int e = 0; e < 4; ++e) r[e] = (j0 + e <= i) ? af[e] : ab[e];
            *(u32x2*)(att + i * 72 + j0) = (u32x2){cvt_pk(r[0], r[1]), cvt_pk(r[2], r[3])};
        }
    }
    __syncthreads();
    {   const int vf = wid;
        const bf16x8 vt0 = ldfrag(vT, 72, vf * 16, 0, fr, fq), vt1 = ldfrag(vT, 72, vf * 16, 32, fr, fq);
#pragma unroll
        for (int iff = 0; iff < 4; ++iff) {
            f32x4 acc = {0.f, 0.f, 0.f, 0.f};
            acc = __builtin_amdgcn_mfma_f32_16x16x32_bf16(vt0, ldfrag(att, 72, iff * 16, 0, fr, fq), acc, 0, 0, 0);
            acc = __builtin_amdgcn_mfma_f32_16x16x32_bf16(vt1, ldfrag(att, 72, iff * 16, 32, fr, fq), acc, 0, 0, 0);
            acc = __builtin_amdgcn_mfma_f32_16x16x32_bf16(sf0, ldfrag(qdf, 72, iff * 16, 0, fr, fq), acc, 0, 0, 0);
            acc = __builtin_amdgcn_mfma_f32_16x16x32_bf16(sf1, ldfrag(qdf, 72, iff * 16, 32, fr, fq), acc, 0, 0, 0);
            acc = __builtin_amdgcn_mfma_f32_16x16x32_bf16(sb0, ldfrag(qdb, 72, iff * 16, 0, fr, fq), acc, 0, 0, 0);
            acc = __builtin_amdgcn_mfma_f32_16x16x32_bf16(sb1, ldfrag(qdb, 72, iff * 16, 32, fr, fq), acc, 0, 0, 0);
            *(f32x4*)(obuf + (iff * 16 + fr) * 128 + vf * 16 + fq * 4) = acc;
        }
    }
    __syncthreads();
    scan_c_tail(obuf, tid, gt0, gt1, row0, (bf16_t*)(p.ws + WS_YMIX), 1024 + h * 128);
    __syncthreads();
}

DEVI void scan_c_ret(const Params& p, int l, int b, int h, int c, const RetIn& in, char* smem) {
    float* obuf = (float*)smem;
    bf16_t* qs = (bf16_t*)(smem + 32768); bf16_t* ks = qs + 64 * 136; bf16_t* vT = ks + 64 * 136; bf16_t* att = vT + 128 * 72;
    const int tid = opaque_tid(), wid = tid >> 6, lane = tid & 63, fr = lane & 15, fq = lane >> 4;
    const int row0 = chunk_row0(b, c); const bool lat = c >= 4;
    const int tk = tid >> 3, kk16 = (tid & 7) * 16;
    float ldf, ldb; ret_decays(h, ldf, ldb);
    const bf16x8 gt0 = in.g0, gt1 = in.g1;
    const bf16_t* SF = (const bf16_t*)(p.ws + WS_STR) + ((size_t)((b * 4 + h) * 2 + 0) * NCH + order_idx(0, c)) * 16384;
    const bf16_t* SB = (const bf16_t*)(p.ws + WS_STR) + ((size_t)((b * 4 + h) * 2 + 1) * NCH + order_idx(1, c)) * 16384;
    bf16x8 sff[4], sbf[4];
#pragma unroll
    for (int ksx = 0; ksx < 4; ++ksx) { sff[ksx] = *(const bf16x8*)(SF + (wid * 16 + fr) * 128 + ksx * 32 + fq * 8); sbf[ksx] = *(const bf16x8*)(SB + (wid * 16 + fr) * 128 + ksx * 32 + fq * 8); }
    {   float qf[16], kf[16];
        ret_rot(in.q0, in.q1, in, lat, 1.f, qf);
        ret_rot(in.k0, in.k1, in, lat, 0.08838834764831845f, kf);
        float t0[8], t1[8];
#pragma unroll
        for (int e = 0; e < 8; ++e) { t0[e] = qf[e]; t1[e] = qf[8 + e]; }
        *(bf16x8*)(qs + tk * 136 + kk16) = pack8(t0); *(bf16x8*)(qs + tk * 136 + kk16 + 8) = pack8(t1);
#pragma unroll
        for (int e = 0; e < 8; ++e) { t0[e] = kf[e]; t1[e] = kf[8 + e]; }
        *(bf16x8*)(ks + tk * 136 + kk16) = pack8(t0); *(bf16x8*)(ks + tk * 136 + kk16 + 8) = pack8(t1);
        const bf16x8 v0 = in.v0, v1 = in.v1;
#pragma unroll
        for (int e = 0; e < 8; ++e) { vT[(kk16 + e) * 72 + tk] = (bf16_t)v0[e]; vT[(kk16 + 8 + e) * 72 + tk] = (bf16_t)v1[e]; }
    }
    __syncthreads();
    {   const int jf = wid & 3;
#pragma unroll
        for (int q = 0; q < 2; ++q) { const int iff = (wid >> 2) * 2 + q;
            f32x4 a = {0.f, 0.f, 0.f, 0.f};
#pragma unroll
            for (int ksx = 0; ksx < 4; ++ksx) a = __builtin_amdgcn_mfma_f32_16x16x32_bf16(ldfrag(ks, 136, jf * 16, ksx * 32, fr, fq), ldfrag(qs, 136, iff * 16, ksx * 32, fr, fq), a, 0, 0, 0);
            const int i = iff * 16 + fr, j0 = jf * 16 + fq * 4;
            float r[4];
#pragma unroll
            for (int e = 0; e < 4; ++e) { const int j = j0 + e; r[e] = a[e] * ((j <= i) ? __expf(ldf * (float)(i - j)) : __expf(ldb * (float)(j - i))); }
            *(u32x2*)(att + i * 72 + j0) = (u32x2){cvt_pk(r[0], r[1]), cvt_pk(r[2], r[3])};
        }
    }
    __syncthreads();
    {   const int vf = wid;
        const bf16x8 vt0 = ldfrag(vT, 72, vf * 16, 0, fr, fq), vt1 = ldfrag(vT, 72, vf * 16, 32, fr, fq);
#pragma unroll
        for (int iff = 0; iff < 4; ++iff) {
            const int i = iff * 16 + fr;
            const float sf = __expf(ldf * (float)(i + 1)), sb = __expf(ldb * (float)(64 - i));
            f32x4 acc = {0.f, 0.f, 0.f, 0.f}, accf = {0.f, 0.f, 0.f, 0.f}, accb = {0.f, 0.f, 0.f, 0.f};
            acc = __builtin_amdgcn_mfma_f32_16x16x32_bf16(vt0, ldfrag(att, 72, iff * 16, 0, fr, fq), acc, 0, 0, 0);
            acc = __builtin_amdgcn_mfma_f32_16x16x32_bf16(vt1, ldfrag(att, 72, iff * 16, 32, fr, fq), acc, 0, 0, 0);
#pragma unroll
            for (int ksx = 0; ksx < 4; ++ksx) { const bf16x8 qv = ldfrag(qs, 136, iff * 16, ksx * 32, fr, fq);
                accf = __builtin_amdgcn_mfma_f32_16x16x32_bf16(sff[ksx], qv, accf, 0, 0, 0);
                accb = __builtin_amdgcn_mfma_f32_16x16x32_bf16(sbf[ksx], qv, accb, 0, 0, 0); }
            *(f32x4*)(obuf + i * 128 + vf * 16 + fq * 4) = acc + sf * accf + sb * accb;
        }
    }
    __syncthreads();
    scan_c_tail(obuf, tid, gt0, gt1, row0, (bf16_t*)(p.ws + WS_YMIX), 1536 + h * 128);
    __syncthreads();
}

namespace att {
constexpr int DQ = 192, DV = 128, NW = 8, QBLK = 32, KVBLK = 64;
constexpr int SHM_V = KVBLK * DV * 2, SHM_K = KVBLK * 400;
constexpr float THR = 8.f;
#define KSWZ(row, colB) ((row) * 400 + (colB))
#define SBAR() __builtin_amdgcn_sched_barrier(0)
DEVI int crow(int r, int hi) { return (r & 3) + 8 * (r >> 2) + 4 * hi; }
DEVI unsigned cvtpk(float lo, float hi) { unsigned r; asm volatile("v_cvt_pk_bf16_f32 %0, %1, %2" : "=v"(r) : "v"(lo), "v"(hi)); return r; }
DEVI void partialSM(f32x16& p0, f32x16& p1, float& m_reg, float& mn, float& alpha) {
    constexpr float C = 1.4426950408889634f;
    float pmax = p0[0];
#pragma unroll
    for (int r = 1; r < 16; ++r) pmax = fmaxf(pmax, p0[r]);
#pragma unroll
    for (int r = 0; r < 16; ++r) pmax = fmaxf(pmax, p1[r]);
    { auto rr = __builtin_amdgcn_permlane32_swap(__float_as_uint(pmax), __float_as_uint(pmax), false, false);
      pmax = fmaxf(__uint_as_float(rr[0]), __uint_as_float(rr[1])); }
    if (__builtin_expect(__all(pmax - m_reg <= THR), 1)) { mn = m_reg; alpha = 1.f; }
    else { mn = fmaxf(m_reg, pmax); alpha = __builtin_amdgcn_exp2f((m_reg - mn) * C); m_reg = mn; }
    const float mnC = -mn * C;
#pragma unroll
    for (int r = 0; r < 16; ++r) p0[r] = fmaf(p0[r], C, mnC);
#pragma unroll
    for (int r = 0; r < 16; ++r) p1[r] = fmaf(p1[r], C, mnC);
#pragma unroll
    for (int r = 0; r < 16; ++r) p0[r] = __builtin_amdgcn_exp2f(p0[r]);
}
DEVI void finishSM(f32x16& p0, f32x16& p1, float alpha, float& l_reg, bf16x8& pa0, bf16x8& pa1, bf16x8& pa2, bf16x8& pa3) {
#pragma unroll
    for (int r = 0; r < 16; ++r) p1[r] = __builtin_amdgcn_exp2f(p1[r]);
    float ps = 0;
#pragma unroll
    for (int r = 0; r < 16; ++r) ps += p0[r];
#pragma unroll
    for (int r = 0; r < 16; ++r) ps += p1[r];
    { auto rr = __builtin_amdgcn_permlane32_swap(__float_as_uint(ps), __float_as_uint(ps), false, false);
      ps = __uint_as_float(rr[0]) + __uint_as_float(rr[1]); }
    l_reg = l_reg * alpha + ps;
#define PK4(P, BASE, OUT) do { unsigned a0 = cvtpk(P[BASE + 0], P[BASE + 1]), a1 = cvtpk(P[BASE + 2], P[BASE + 3]);   \
    unsigned b0 = cvtpk(P[BASE + 4], P[BASE + 5]), b1 = cvtpk(P[BASE + 6], P[BASE + 7]);                              \
    auto r0 = __builtin_amdgcn_permlane32_swap(a0, b0, false, false); auto r1 = __builtin_amdgcn_permlane32_swap(a1, b1, false, false); \
    u32x4 w = {r0[0], r1[0], r0[1], r1[1]}; OUT = __builtin_bit_cast(bf16x8, w); } while (0)
    PK4(p0, 0, pa0); PK4(p0, 8, pa1); PK4(p1, 0, pa2); PK4(p1, 8, pa3);
#undef PK4
}
DEVI void qkt(f32x16& p0, f32x16& p1, const char* Ks, const bf16x8* qr, const char* qL, int r32, int hi) {
    p0 = (f32x16){0.f, 0.f, 0.f, 0.f, 0.f, 0.f, 0.f, 0.f, 0.f, 0.f, 0.f, 0.f, 0.f, 0.f, 0.f, 0.f}; p1 = p0;
#pragma unroll
    for (int d0 = 0; d0 < 12; ++d0) { const int cb = (d0 * 16 + hi * 8) * 2;
        const bf16x8 b0 = *(const bf16x8*)(Ks + KSWZ(r32, cb));
        const bf16x8 b1 = *(const bf16x8*)(Ks + KSWZ(32 + r32, cb));
        const bf16x8 qv = (d0 < 8) ? qr[d0 < 8 ? d0 : 0] : *(const bf16x8*)(qL + (d0 - 8) * 1024);
        p0 = __builtin_amdgcn_mfma_f32_32x32x16_bf16(b0, qv, p0, 0, 0, 0);
        p1 = __builtin_amdgcn_mfma_f32_32x32x16_bf16(b1, qv, p1, 0, 0, 0); }
}
DEVI int v_st(int k, int c) { const int kk = (k & ~0xC) | ((k & 4) << 1) | ((k & 8) >> 1); return ((kk >> 3) * 4 + (c >> 5)) * 512 + ((kk & 7) * 32 + (c & 31)) * 2; }
DEVI int v_rd_base(int lane) { return ((lane & 3) << 3) | (((lane >> 2) & 3) << 6) | (((lane >> 4) & 1) << 5) | (((lane >> 5) & 1) << 8); }
constexpr int v_rd_off(int d0, int ks, int half) { return d0 * 512 + ks * 4096 + half * 2048; }
template <int OFF> DEVI s16x4 tr_read(int vb) { s16x4 r; asm volatile("ds_read_b64_tr_b16 %0, %1 offset:%2" : "=&v"(r) : "v"(vb), "i"(OFF) : "memory"); return r; }
template <int D0> DEVI void pv_one(f32x16& od, int vb, bf16x8 pa0, bf16x8 pa1, bf16x8 pa2, bf16x8 pa3) {
    const s16x4 l0 = tr_read<v_rd_off(D0, 0, 0)>(vb), h0 = tr_read<v_rd_off(D0, 0, 1)>(vb), l1 = tr_read<v_rd_off(D0, 1, 0)>(vb), h1 = tr_read<v_rd_off(D0, 1, 1)>(vb);
    const s16x4 l2 = tr_read<v_rd_off(D0, 2, 0)>(vb), h2 = tr_read<v_rd_off(D0, 2, 1)>(vb), l3 = tr_read<v_rd_off(D0, 3, 0)>(vb), h3 = tr_read<v_rd_off(D0, 3, 1)>(vb);
    asm volatile("s_waitcnt lgkmcnt(0)" ::: "memory"); SBAR();
#define PKV(L, H) (bf16x8){L[0], L[1], L[2], L[3], H[0], H[1], H[2], H[3]}
    od = __builtin_amdgcn_mfma_f32_32x32x16_bf16(pa0, PKV(l0, h0), od, 0, 0, 0);
    od = __builtin_amdgcn_mfma_f32_32x32x16_bf16(pa1, PKV(l1, h1), od, 0, 0, 0);
    od = __builtin_amdgcn_mfma_f32_32x32x16_bf16(pa2, PKV(l2, h2), od, 0, 0, 0);
    od = __builtin_amdgcn_mfma_f32_32x32x16_bf16(pa3, PKV(l3, h3), od, 0, 0, 0);
#undef PKV
}
DEVI void pv_d0(f32x16* o, int vb, bf16x8 pa0, bf16x8 pa1, bf16x8 pa2, bf16x8 pa3) {
    pv_one<0>(o[0], vb, pa0, pa1, pa2, pa3); pv_one<1>(o[1], vb, pa0, pa1, pa2, pa3); pv_one<2>(o[2], vb, pa0, pa1, pa2, pa3); pv_one<3>(o[3], vb, pa0, pa1, pa2, pa3);
}
DEVI void attn_body(const bf16_t* __restrict__ Qb, const bf16_t* __restrict__ Kh, const bf16_t* __restrict__ Vh, bf16_t* __restrict__ Ob, int seq, char* lds) {
    const int tid = opaque_tid(), wid = tid >> 6, lane = tid & 63, r32 = lane & 31, hi = lane >> 5;
    char* V_lds = lds; char* K_lds = lds + 2 * SHM_V;
    float* wsf = (float*)(lds + 2 * SHM_V + 2 * SHM_K) + wid * 64; float* li_l = wsf; float* al_l = wsf + 32;
    float m_reg = -1e30f, l_reg = 0;
    f32x16 o[4];
#pragma unroll
    for (int d = 0; d < 4; ++d) o[d] = (f32x16){0.f, 0.f, 0.f, 0.f, 0.f, 0.f, 0.f, 0.f, 0.f, 0.f, 0.f, 0.f, 0.f, 0.f, 0.f, 0.f};
    bf16x8 qr[8];
    const bf16_t* Qw = Qb + (size_t)(wid * QBLK + r32) * DQ + hi * 8;
    char* qL = lds + 2 * SHM_V + 2 * SHM_K + NW * 64 * 4 + wid * 4096 + lane * 16;
#pragma unroll
    for (int d0 = 0; d0 < 8; ++d0) qr[d0] = *(const bf16x8*)(Qw + d0 * 16);
#pragma unroll
    for (int d0 = 8; d0 < 12; ++d0) *(bf16x8*)(qL + (d0 - 8) * 1024) = *(const bf16x8*)(Qw + d0 * 16);
    const int sr = tid >> 4, sc = (tid & 15) * 8, vst0 = v_st(sr, sc), vst1 = v_st(32 + sr, sc);
    const int kr0 = tid / 24, kc0 = (tid % 24) * 8, kr1 = (tid + 512) / 24, kc1 = ((tid + 512) % 24) * 8, kr2 = (tid + 1024) / 24, kc2 = ((tid + 1024) % 24) * 8;
    const int kst0 = KSWZ(kr0, kc0 * 2), kst1 = KSWZ(kr1, kc1 * 2), kst2 = KSWZ(kr2, kc2 * 2);
    const int vb0 = (int)(uintptr_t)V_lds + v_rd_base(lane);
    bf16x8 sv0, sv1, sk0, sk1, sk2;
#define SLOAD(k0) do { sv0 = *(const bf16x8*)(Vh + (size_t)((k0) + sr) * DV + sc); sv1 = *(const bf16x8*)(Vh + (size_t)((k0) + 32 + sr) * DV + sc); \
    sk0 = *(const bf16x8*)(Kh + (size_t)((k0) + kr0) * DQ + kc0); sk1 = *(const bf16x8*)(Kh + (size_t)((k0) + kr1) * DQ + kc1); sk2 = *(const bf16x8*)(Kh + (size_t)((k0) + kr2) * DQ + kc2); } while (0)
#define SWRITE(b) do { *(bf16x8*)(V_lds + (b) * SHM_V + vst0) = sv0; *(bf16x8*)(V_lds + (b) * SHM_V + vst1) = sv1; \
    *(bf16x8*)(K_lds + (b) * SHM_K + kst0) = sk0; *(bf16x8*)(K_lds + (b) * SHM_K + kst1) = sk1; *(bf16x8*)(K_lds + (b) * SHM_K + kst2) = sk2; } while (0)
#define RESC(a) do { if (__any((a) < 1.f)) { if (hi == 0) al_l[r32] = (a); asm volatile("s_waitcnt lgkmcnt(0)" ::: "memory"); \
    _Pragma("unroll") for (int d = 0; d < 4; ++d) _Pragma("unroll") for (int r = 0; r < 16; ++r) o[d][r] *= al_l[crow(r, hi)]; } } while (0)
    f32x16 pA0, pA1, pB0, pB1; float mnA, mnB, alA, alB; bf16x8 pa0, pa1, pa2, pa3; const int NT = seq / KVBLK;
    SLOAD(0); SWRITE(0); __syncthreads();
    qkt(pA0, pA1, K_lds, qr, qL, r32, hi); partialSM(pA0, pA1, m_reg, mnA, alA);
    SLOAD(KVBLK); SWRITE(1); __syncthreads();
    for (int j = 1; j + 1 < NT; j += 2) {
        SBAR(); qkt(pB0, pB1, K_lds + SHM_K, qr, qL, r32, hi);
        finishSM(pA0, pA1, alA, l_reg, pa0, pa1, pa2, pa3); SBAR();
        SLOAD((j + 1) * KVBLK); SBAR();
        pv_d0(o, vb0, pa0, pa1, pa2, pa3); partialSM(pB0, pB1, m_reg, mnB, alB);
        __syncthreads(); SWRITE(0);
        RESC(alB); __syncthreads();
        SBAR(); qkt(pA0, pA1, K_lds, qr, qL, r32, hi);
        finishSM(pB0, pB1, alB, l_reg, pa0, pa1, pa2, pa3); SBAR();
        SLOAD((j + 2) * KVBLK); SBAR();
        pv_d0(o, vb0 + SHM_V, pa0, pa1, pa2, pa3); partialSM(pA0, pA1, m_reg, mnA, alA);
        __syncthreads(); SWRITE(1);
        RESC(alA); __syncthreads();
    }
    SBAR(); qkt(pB0, pB1, K_lds + SHM_K, qr, qL, r32, hi);
    finishSM(pA0, pA1, alA, l_reg, pa0, pa1, pa2, pa3); SBAR();
    pv_d0(o, vb0, pa0, pa1, pa2, pa3); partialSM(pB0, pB1, m_reg, mnB, alB);
    __syncthreads(); RESC(alB);
    finishSM(pB0, pB1, alB, l_reg, pa0, pa1, pa2, pa3); SBAR();
    pv_d0(o, vb0 + SHM_V, pa0, pa1, pa2, pa3);
    if (hi == 0) li_l[r32] = l_reg; asm volatile("s_waitcnt lgkmcnt(0)" ::: "memory");
    float rli[16];
#pragma unroll
    for (int r = 0; r < 16; ++r) rli[r] = __builtin_amdgcn_rcpf(li_l[crow(r, hi)]);
    bf16_t* Ow = Ob + (size_t)(wid * QBLK) * DM;
#pragma unroll
    for (int r = 0; r < 16; ++r) { const int orow = crow(r, hi);
#pragma unroll
        for (int d0 = 0; d0 < 4; ++d0) Ow[(size_t)orow * DM + d0 * 32 + r32] = f2bf(o[d0][r] * rli[r]); }
    __syncthreads();
#undef SLOAD
#undef SWRITE
#undef RESC
}
}

template <int WIDTH>
DEVI void rstd_table(const bf16_t* P, int row0, int col0, float* rs) {
    constexpr int hw = WIDTH >> 1;
    const int tid = opaque_tid(), r = tid >> 1, half = tid & 1;
    const bf16_t* src = P + (size_t)(row0 + r) * INC + col0 + half * hw;
    float ss = 0.f;
#pragma unroll
    for (int i0 = 0; i0 < hw; i0 += 128) {
        bf16x8 t[16];
#pragma unroll
        for (int i = 0; i < 16; ++i) t[i] = *(const bf16x8*)(src + i0 + i * 8);
#pragma unroll
        for (int i = 0; i < 16; ++i) { float f[8]; unpack8(t[i], f);
#pragma unroll
            for (int e = 0; e < 8; ++e) ss += f[e] * f[e]; }
    }
    ss += __shfl_xor(ss, 1);
    if (half == 0) rs[r] = rsqrtf(ss / (float)WIDTH + EPS);
    __syncthreads();
}
struct EpiQ { static constexpr bool PERM = true; bf16_t* Q; const float* rs; const float* rax;
    DEVI void operator()(const f32x4 (&acc)[2][2][4][2], const pg8::Unit& u, int wr, int wc, int fr, int fq) const {
#pragma unroll
        for (int ai = 0; ai < 2; ++ai)
#pragma unroll
            for (int m = 0; m < 4; ++m) { const int rl = ai * 128 + wr * 64 + m * 16 + fr, row = u.pm * 256 + rl; const float sc = rs[u.ord * 256 + rl] * QSCALE;
                const bool lat = row < NLAT; const int b = lat ? (row >> 11) : ((row - NLAT) >> 8); const int t = lat ? (row & 2047) : ((row - NLAT) & 255);
                const int qpos = lat ? (CL + t) : t;
#pragma unroll
                for (int bj = 0; bj < 2; ++bj) { const int col = u.pn * 256 + bj * 128 + wc * 32 + 8 * fq; const int head = col / 192, d = col - head * 192;
                    f32x4 v0 = acc[ai][bj][m][0] * sc, v1 = acc[ai][bj][m][1] * sc;
                    if (lat && d >= 128) { const int pi = (d - 128) >> 1; const int pos = (pi < 16) ? (t >> 6) : (t & 63);
                        const f32x4 c0 = *(const f32x4*)(rax + (pos * 16 + (pi & 15)) * 2), c1 = *(const f32x4*)(rax + (pos * 16 + (pi & 15)) * 2 + 4);
                        v0 = (f32x4){v0[0] * c0[0] - v0[1] * c0[1], v0[0] * c0[1] + v0[1] * c0[0], v0[2] * c0[2] - v0[3] * c0[3], v0[2] * c0[3] + v0[3] * c0[2]};
                        v1 = (f32x4){v1[0] * c1[0] - v1[1] * c1[1], v1[0] * c1[1] + v1[1] * c1[0], v1[2] * c1[2] - v1[3] * c1[3], v1[2] * c1[3] + v1[3] * c1[2]}; }
                    *(u32x4*)(Q + ((size_t)(b * 8 + head) * KEYS + qpos) * 192 + d) = (u32x4){cvt_pk(v0[0], v0[1]), cvt_pk(v0[2], v0[3]), cvt_pk(v1[0], v1[1]), cvt_pk(v1[2], v1[3])}; }
                __builtin_amdgcn_sched_barrier(0); }
    } };
struct EpiKV { static constexpr bool PERM = true; bf16_t* Kb; bf16_t* Vb; const float* rs;
    DEVI void operator()(const f32x4 (&acc)[2][2][4][2], const pg8::Unit& u, int wr, int wc, int fr, int fq) const {
#pragma unroll
        for (int ai = 0; ai < 2; ++ai)
#pragma unroll
            for (int m = 0; m < 4; ++m) { const int rl = ai * 128 + wr * 64 + m * 16 + fr, row = u.pm * 256 + rl; const float sc = rs[u.ord * 256 + rl];
                const bool lat = row < NLAT; const int b = lat ? (row >> 11) : ((row - NLAT) >> 8); const int t = lat ? (row & 2047) : ((row - NLAT) & 255);
                const int kpos = lat ? (CL + t) : t; const int d = wc * 32 + 8 * fq;
                { const f32x4 v0 = acc[ai][0][m][0] * sc, v1 = acc[ai][0][m][1] * sc;
                  *(u32x4*)(Kb + ((size_t)(b * 8 + u.pn) * KEYS + kpos) * 192 + d) = (u32x4){cvt_pk(v0[0], v0[1]), cvt_pk(v0[2], v0[3]), cvt_pk(v1[0], v1[1]), cvt_pk(v1[2], v1[3])}; }
                { const f32x4 v0 = acc[ai][1][m][0] * sc, v1 = acc[ai][1][m][1] * sc;
                  *(u32x4*)(Vb + ((size_t)(b * 8 + u.pn) * KEYS + kpos) * 128 + d) = (u32x4){cvt_pk(v0[0], v0[1]), cvt_pk(v0[2], v0[3]), cvt_pk(v1[0], v1[1]), cvt_pk(v1[2], v1[3])}; } }
    } };

DEVI void phase_l2(const Params& p, int l, char* smem) {
    const bf16_t* P = (const bf16_t*)(p.ws + WS_P);
    float* rsq = (float*)(smem + 131072); float* rskv = rsq + 4 * 256;
    const float* rax = (const float*)(p.ws + WS_RAX);
    const int nqm = (l == 0) ? 36 : 32, nq = nqm * 6, nkv = 36 * 8, nsc = 2 * 16 * NCH;
    const pg8::PlainSched Sq{P, (const bf16_t*)(p.ws + WS_WUQ) + (size_t)l * 1536 * 512, INC, C_CQ, 512, nqm, 6, nq};
    const pg8::PlainSched Skv{P, (const bf16_t*)(p.ws + WS_WUKV) + (size_t)l * 2048 * 256, INC, C_CKV, 256, 36, 8, nkv};
    for (int i = 0; i < 4; ++i) { pg8::Unit u; if (Sq.next(i, u)) rstd_table<512>(P, u.pm * 256, C_CQ, rsq + i * 256); }
    for (int i = 0; i < 4; ++i) { pg8::Unit u; if (Skv.next(i, u)) rstd_table<256>(P, u.pm * 256, C_CKV, rskv + i * 256); }
#ifndef L2_GEMM_REP
#define L2_GEMM_REP 1
#endif
#ifndef L2_SCAN_REP
#define L2_SCAN_REP 1
#endif
#pragma nounroll
    for (int rep = 0; rep < L2_GEMM_REP; ++rep) {
    SUB(0) { pg8::gemm_phase((LAS unsigned char*)smem, 512, Sq, EpiQ{(bf16_t*)(p.ws + WS_Q), rsq, rax}); }
    SUB(1) { pg8::gemm_phase((LAS unsigned char*)smem, 256, Skv, EpiKV{(bf16_t*)(p.ws + WS_K), (bf16_t*)(p.ws + WS_V), rskv}); }
    }
    for (int i = 0; i < 4; ++i) {
        pg8::Unit uk; if (!Skv.next(i, uk)) break;
        const int pm = uk.pm, pn = uk.pn;
        bf16_t* Kb = (bf16_t*)(p.ws + WS_K);
        const int tid = opaque_tid(), rl = tid >> 1, half = tid & 1, row = pm * 256 + rl;
        const bool lat = row < NLAT; const int b = lat ? (row >> 11) : ((row - NLAT) >> 8); const int t = lat ? (row & 2047) : ((row - NLAT) & 255);
        const int kpos = lat ? (CL + t) : t;
        bf16_t* dst = Kb + ((size_t)(b * 8 + pn) * KEYS + kpos) * 192 + 128 + half * 32;
#pragma unroll
        for (int q = 0; q < 4; ++q) {
            float f[8]; unpack8(*(const bf16x8*)(P + (size_t)row * INC + C_KR + half * 32 + q * 8), f);
            if (lat) {
#pragma unroll
                for (int e = 0; e < 4; ++e) { const int pi = half * 16 + q * 4 + e; const int pos = (pi < 16) ? (t >> 6) : (t & 63);
                    const f32x2 cs = *(const f32x2*)(rax + (pos * 16 + (pi & 15)) * 2);
                    const float x1 = f[2 * e], x2 = f[2 * e + 1]; f[2 * e] = x1 * cs[0] - x2 * cs[1]; f[2 * e + 1] = x1 * cs[1] + x2 * cs[0]; }
            }
            *(bf16x8*)(dst + q * 8) = pack8(f);
        }
    }
    __syncthreads();
    {
        const int G = gridDim.x, nG = 16 * NCH;
        int u = (obid() + (G >> 1)) % G;
        {   GlaIn cur; bool have = u < nG;
            if (have) gla_load(p, l, (u / NCH) >> 2, (u / NCH) & 3, u % NCH, false, cur);
            while (have) { const int un = u + G; const bool hn = un < nG; GlaIn nxt;
                if (hn) gla_load(p, l, (un / NCH) >> 2, (un / NCH) & 3, un % NCH, false, nxt);
                CvtIn ci; cvt8_load(p, l, (l == 0 ? TS0A : TS1A) + u, ci);
                SUB(2) scan_a_gla(p, l, (u / NCH) >> 2, (u / NCH) & 3, u % NCH, cur, smem);
                cvt8_finish(p, l, (l == 0 ? TS0A : TS1A) + u, ci, smem);
                cur = nxt; u = un; have = hn; } }
        {   RetIn cur; bool have = u < nsc;
            if (have) { const int r = u - nG; ret_load(p, (r / NCH) >> 2, (r / NCH) & 3, r % NCH, false, cur); }
            while (have) { const int un = u + G; const bool hn = un < nsc; RetIn nxt; const int r = u - nG, rn = un - nG;
                if (hn) ret_load(p, (rn / NCH) >> 2, (rn / NCH) & 3, rn % NCH, false, nxt);
                CvtIn ci; cvt8_load(p, l, (l == 0 ? TS0A : TS1A) + u, ci);
                SUB(3) scan_a_ret(p, l, (r / NCH) >> 2, (r / NCH) & 3, r % NCH, cur, smem);
                cvt8_finish(p, l, (l == 0 ? TS0A : TS1A) + u, ci, smem);
                cur = nxt; u = un; have = hn; } }
    }
}

DEVI void phase_l4(const Params& p, int l, char* smem) {
    const bf16_t* Q = (const bf16_t*)(p.ws + WS_Q); const bf16_t* Kb = (const bf16_t*)(p.ws + WS_K); const bf16_t* Vb = (const bf16_t*)(p.ws + WS_V);
    bf16_t* ymix = (bf16_t*)(p.ws + WS_YMIX);
    const int nal = 256, nac = (l == 0) ? 32 : 0, ncs = (l == 0) ? NCH : 32, nsc = 2 * 16 * ncs;
#ifndef L4_ATT_REP
#define L4_ATT_REP 1
#endif
#ifndef L4_SCAN_REP
#define L4_SCAN_REP 1
#endif
    phase_prefix(p, smem);
    asm volatile("s_waitcnt vmcnt(0)" ::: "memory");
    __syncthreads();
    if (threadIdx.x == 0) { __builtin_amdgcn_fence(__ATOMIC_RELEASE, "agent"); asm volatile("s_waitcnt vmcnt(0)" ::: "memory");
        __hip_atomic_fetch_add((unsigned*)(p.ws + WS_BAR) + PFXCNT_WORD + 64 * l, 1u, __ATOMIC_RELAXED, __HIP_MEMORY_SCOPE_AGENT); }
#pragma nounroll
    for (int rep = 0; rep < L4_ATT_REP; ++rep)
    for (int u = obid(); u < nal + nac; u += gridDim.x) {
        if (u < nal) { SUB(4) {
            const int bh = u >> 3, qb = u & 7, b = bh >> 3, h = bh & 7;
            att::attn_body(Q + ((size_t)bh * KEYS + CL + qb * 256) * 192, Kb + (size_t)bh * KEYS * 192, Vb + (size_t)bh * KEYS * 128,
                           ymix + (size_t)(b * SEQ + qb * 256) * DM + h * 128, KEYS, smem);
        } } else { SUB(4) {
            const int bh = u - nal, b = bh >> 3, h = bh & 7;
            att::attn_body(Q + (size_t)bh * KEYS * 192, Kb + (size_t)bh * KEYS * 192, Vb + (size_t)bh * KEYS * 128,
                           ymix + (size_t)(NLAT + b * CL) * DM + h * 128, CL, smem);
        } }
    }
    if (threadIdx.x == 0) {
        unsigned* c = (unsigned*)(p.ws + WS_BAR) + PFXCNT_WORD + 64 * l; unsigned sp = 0;
        while (__hip_atomic_load(c, __ATOMIC_RELAXED, __HIP_MEMORY_SCOPE_AGENT) < gridDim.x) { __builtin_amdgcn_s_sleep(2); if (++sp > (1u << 22)) break; }
        __builtin_amdgcn_fence(__ATOMIC_ACQUIRE, "agent");
        asm volatile("s_waitcnt vmcnt(0)" ::: "memory");
    }
    __syncthreads();
    {
        const int G = gridDim.x, nG = 16 * ncs, c0 = NCH - ncs;
        int u = (obid() + G - (nal + nac) % G) % G;
        {   GlaIn cur; bool have = u < nG;
            if (have) gla_load(p, l, (u / ncs) >> 2, (u / ncs) & 3, u % ncs + c0, true, cur);
            while (have) { const int un = u + G; const bool hn = un < nG; GlaIn nxt;
                if (hn) gla_load(p, l, (un / ncs) >> 2, (un / ncs) & 3, un % ncs + c0, true, nxt);
                CvtIn ci; cvt8_load(p, l, (l == 0 ? TS0C : TS1C) + u, ci);
                SUB(5) scan_c_gla(p, l, (u / ncs) >> 2, (u / ncs) & 3, u % ncs + c0, cur, smem);
                cvt8_finish(p, l, (l == 0 ? TS0C : TS1C) + u, ci, smem);
                cur = nxt; u = un; have = hn; } }
        {   RetIn cur; bool have = u < nsc;
            if (have) { const int r = u - nG; ret_load(p, (r / ncs) >> 2, (r / ncs) & 3, r % ncs + c0, true, cur); }
            while (have) { const int un = u + G; const bool hn = un < nsc; RetIn nxt; const int r = u - nG, rn = un - nG;
                if (hn) ret_load(p, (rn / ncs) >> 2, (rn / ncs) & 3, rn % ncs + c0, true, nxt);
                CvtIn ci; cvt8_load(p, l, (l == 0 ? TS0C : TS1C) + u, ci);
                SUB(6) scan_c_ret(p, l, (r / ncs) >> 2, (r / ncs) & 3, r % ncs + c0, cur, smem);
                cvt8_finish(p, l, (l == 0 ? TS0C : TS1C) + u, ci, smem);
                cur = nxt; u = un; have = hn; } }
    }
}

struct EpiOut { static constexpr bool PERM = false; const Params* pp; int l;
    DEVI void operator()(const f32x4 (&acc)[2][2][4][2], const pg8::Unit& u, int wr, int wc, int fr, int fq) const {
        const Params& p = *pp; float* xres = (float*)(p.ws + WS_XRES);
        const float* mod = (const float*)(p.ws + WS_MOD) + (size_t)l * 5 * 12288;
#pragma unroll
        for (int ai = 0; ai < 2; ++ai)
#pragma unroll
            for (int m = 0; m < 4; ++m) { const int row = u.pm * 256 + ai * 128 + wr * 64 + m * 16 + fr;
                const bool lat = row < NLAT; const int b = lat ? (row >> 11) : 4;
                const float* xin = (l == 0) ? (lat ? p.x + (size_t)row * DM : p.ctx + (size_t)(row - NLAT) * DM) : xres + (size_t)row * DM;
                const float* ga = mod + (size_t)b * 12288 + 4096;
#pragma unroll
                for (int bj = 0; bj < 2; ++bj)
#pragma unroll
                    for (int n = 0; n < 2; ++n) { const int col = u.pn * 256 + bj * 128 + wc * 32 + n * 16 + 4 * fq;
                        const f32x4 xo = *(const f32x4*)(xin + col); const f32x4 g = *(const f32x4*)(ga + col);
                        *(f32x4*)(xres + (size_t)row * DM + col) = xo + g * acc[ai][bj][m][n]; }
                __builtin_amdgcn_sched_barrier(0); }
    } };
DEVI void phase_wout(const Params& p, int l, char* smem) {
    const int nm = (l == 0) ? 36 : 32;
    pg8::PlainSched S{(const bf16_t*)(p.ws + WS_YMIX), (const bf16_t*)(p.ws + WS_WOUT) + (size_t)l * 2048 * 2048, DM, 0, 2048, nm, 8, nm * 8};
    pg8::gemm_phase((LAS unsigned char*)smem, 2048, S, EpiOut{&p, l});
    if (l == 0) tail_convert(p, 0, TAIL_WOUT_B0, T0A, TAILT_WOUT, smem);
}

template <int N>
DEVI void bitonic_desc(unsigned long long* key, int tid) {
    for (int k = 2; k <= N; k <<= 1)
        for (int j = k >> 1; j > 0; j >>= 1) {
            for (int t = tid; t < N / 2; t += 512) {
                const int i = ((t & ~(j - 1)) << 1) | (t & (j - 1)), q = i | j;
                const unsigned long long a = key[i], b = key[q];
                const bool desc = (i & k) == 0;
                if (desc ? (a < b) : (a > b)) { key[i] = b; key[q] = a; }
            }
            __syncthreads();
        }
}
DEVI void phase_rank(const Params& p, int l, char* smem) {
    unsigned long long* key = (unsigned long long*)smem;
    const float* aff = (const float*)(p.ws + WS_AFF);
    int* rank = (int*)(p.ws + WS_RANK); int* selrow = (int*)(p.ws + WS_SELROW); float* selgate = (float*)(p.ws + WS_SELGATE);
    const int tid = opaque_tid();
    const int nl = 64, nc = (l == 0) ? 64 : 0;
#ifndef RANK_REP
#define RANK_REP 1
#endif
#pragma nounroll
    for (int rep = 0; rep < RANK_REP; ++rep)
    for (int u = obid(); u < nl + nc; u += (gridDim.x == 256 ? 64 : gridDim.x)) {
        if (gridDim.x == 256 && obid() >= 64) break;
        if (u < nl) {
            const int be = u, b = be >> 4, e = be & 15;
            const float* a = aff + (size_t)be * KEYS;
            for (int i = tid; i < 2048; i += 512) key[i] = ((unsigned long long)__float_as_uint(a[i]) << 32) | (unsigned)(2047 - i);
            __syncthreads();
            bitonic_desc<2048>(key, tid);
            for (int pos = tid; pos < 2048; pos += 512) { const unsigned long long kv = key[pos]; const int i = 2047 - (int)(unsigned)(kv & 0xffffffffull);
                rank[(size_t)be * KEYS + i] = pos;
                if (pos < 256) { selrow[e * MSLOT + b * 256 + pos] = b * SEQ + i; selgate[e * MSLOT + b * 256 + pos] = __uint_as_float((unsigned)(kv >> 32)); } }
            __syncthreads();
        } else {
            const int be = u - nl, b = be >> 4, e = be & 15;
            const float* a = aff + (size_t)be * KEYS + SEQ;
            if (tid < 256) key[tid] = ((unsigned long long)__float_as_uint(a[tid]) << 32) | (unsigned)(255 - tid);
            __syncthreads();
            bitonic_desc<256>(key, tid);
            if (tid < 256) { const int pos = tid; const unsigned long long kv = key[pos]; const int i = 255 - (int)(unsigned)(kv & 0xffffffffull);
                rank[(size_t)be * KEYS + SEQ + i] = pos;
                if (pos < 32) { selrow[e * MSLOT + 1024 + b * 32 + pos] = NLAT + b * CL + i; selgate[e * MSLOT + 1024 + b * 32 + pos] = __uint_as_float((unsigned)(kv >> 32)); } }
            __syncthreads();
        }
    }
    if (gridDim.x == 256) {
        const int first = 64, bid = obid();
        const int nt = (l == 0) ? RANKT0 : RANKT1;
        if (bid >= first) cvt8_stream3(p, l, ((l == 0) ? T0B : T1B) + (bid - first), 256 - first, nt, smem);
    }
}

struct MoeGuSched { const bf16_t* hbuf; const bf16_t* Wgu; const int* selrow; int mvalid, nmt, units;
    DEVI bool next(int i, pg8::Unit& u) const {
        const int g = obid() + i * gridDim.x; if (g >= units) return false;
        int e, pm, pn;
        if (gridDim.x == 256) {
            const int c = g & 255, q = (g >> 8) * 32 + (c >> 3), per = nmt * 16, r = q % per, rr = r % (nmt * 4);
            e = 2 * (c & 7) + q / per; pm = rr % nmt; pn = (r / (nmt * 4)) * 4 + rr / nmt;
        } else { e = g / (nmt * 16); const int r = g % (nmt * 16); pm = r / 16; pn = r % 16; }
        u.e = e; u.pm = pm; u.pn = pn; u.ord = i; u.half = (nmt == 5 && pm == 4) ? 1 : 0;
        u.A = (const char*)hbuf; u.B = (const char*)Wgu + ((size_t)e * 4096 + u.pn * 256) * 2048; return true; }
    DEVI unsigned one(const pg8::Unit& u, int R, int C) const { const int slot = u.pm * 256 + R; const int row = (slot < mvalid) ? selrow[u.e * MSLOT + slot] : 0; return (unsigned)(row * (DM / 2) + C) * 2u; }
    DEVI void aoff(const pg8::Unit& u, int R0, int C0, int R1, int C1, unsigned (&o)[4]) const { o[0] = one(u, R0, C0); o[1] = one(u, R1, C1); o[2] = one(u, 128 + R0, C0); o[3] = one(u, 128 + R1, C1); }
};
struct EpiGU { static constexpr bool PERM = true; bf16_t* actb; int mvalid;
    DEVI void operator()(const f32x4 (&acc)[2][2][4][2], const pg8::Unit& u, int wr, int wc, int fr, int fq) const {
#pragma unroll
        for (int ai = 0; ai < 2; ++ai)
#pragma unroll
            for (int m = 0; m < 4; ++m) { const int slot = u.pm * 256 + ai * 128 + wr * 64 + m * 16 + fr;
                if (slot < mvalid) { const int col = u.pn * 128 + wc * 32 + 8 * fq;
                    constexpr float is = 1.f / W8_SCALE, us = ACT8_SCALE / W8_SCALE;
                    const f32x4 g0 = acc[ai][0][m][0] * is, g1 = acc[ai][0][m][1] * is, u0 = acc[ai][1][m][0] * us, u1 = acc[ai][1][m][1] * us;
                    *(u32x2*)((unsigned char*)actb + ((size_t)u.e * MSLOT + slot) * DM + col) = (u32x2){cvt4_fp8c(silu_f(g0[0]) * u0[0], silu_f(g0[1]) * u0[1], silu_f(g0[2]) * u0[2], silu_f(g0[3]) * u0[3]),
                                                                                                    cvt4_fp8c(silu_f(g1[0]) * u1[0], silu_f(g1[1]) * u1[1], silu_f(g1[2]) * u1[2], silu_f(g1[3]) * u1[3])}; } }
    } };
DEVI void phase_moe_gu(const Params& p, int l, char* smem) {
    const int mvalid = (l == 0) ? 1152 : 1024, nmt = (l == 0) ? 5 : 4;
    MoeGuSched S{(const bf16_t*)(p.ws + WS_H), (const bf16_t*)((const char*)(p.ws + WS_WGU) + (size_t)l * 16 * 4096 * 2048), (const int*)(p.ws + WS_SELROW), mvalid, nmt, 16 * nmt * 16};
    pg8::gemm_phase<MoeGuSched, EpiGU, true>((LAS unsigned char*)smem, 1024, S, EpiGU{(bf16_t*)(p.ws + WS_ACT), mvalid});
}
struct MoeDnSched { const bf16_t* actb; const bf16_t* Wdn; int nmt, units;
    DEVI bool next(int i, pg8::Unit& u) const {
        const int g = obid() + i * gridDim.x; if (g >= units) return false;
        int e, pm, pn;
        if (gridDim.x == 256 && nmt == 4) {
            const int c = g & 255, q = (g >> 8) * 32 + (c >> 3), per = nmt * 8, r = q % per, rr = r % (nmt * 4);
            e = 2 * (c & 7) + q / per; pm = rr % nmt; pn = (r / (nmt * 4)) * 4 + rr / nmt;
        } else { e = g / (nmt * 8); const int r = g % (nmt * 8); pm = r / 8; pn = r % 8; }
        u.e = e; u.pm = pm; u.pn = pn; u.ord = i; u.half = (nmt == 5 && pm == 4) ? 1 : 0;
        u.A = (const char*)actb + ((size_t)e * MSLOT + u.pm * 256) * DM; u.B = (const char*)Wdn + ((size_t)e * 2048 + u.pn * 256) * 2048; return true; }
    DEVI void aoff(const pg8::Unit&, int R0, int C0, int R1, int C1, unsigned (&o)[4]) const {
        o[0] = (unsigned)(R0 * (DM / 2) + C0) * 2u; o[1] = (unsigned)(R1 * (DM / 2) + C1) * 2u; o[2] = (unsigned)((128 + R0) * (DM / 2) + C0) * 2u; o[3] = (unsigned)((128 + R1) * (DM / 2) + C1) * 2u; }
};
struct EpiDN { static constexpr bool PERM = true; bf16_t* ydn; const float* selgate; int mvalid;
    DEVI void operator()(const f32x4 (&acc)[2][2][4][2], const pg8::Unit& u, int wr, int wc, int fr, int fq) const {
#pragma unroll
        for (int ai = 0; ai < 2; ++ai)
#pragma unroll
            for (int m = 0; m < 4; ++m) { const int slot = u.pm * 256 + ai * 128 + wr * 64 + m * 16 + fr;
                if (slot < mvalid) { const float gt = selgate[u.e * MSLOT + slot] * (1.f / (W8_SCALE * ACT8_SCALE));
#pragma unroll
                    for (int bj = 0; bj < 2; ++bj) { const int col = u.pn * 256 + bj * 128 + wc * 32 + 8 * fq; const f32x4 v0 = acc[ai][bj][m][0] * gt, v1 = acc[ai][bj][m][1] * gt;
                        *(u32x4*)(ydn + ((size_t)u.e * MSLOT + slot) * DM + col) = (u32x4){cvt_pk(v0[0], v0[1]), cvt_pk(v0[2], v0[3]), cvt_pk(v1[0], v1[1]), cvt_pk(v1[2], v1[3])}; } } }
    } };
DEVI void phase_moe_dn(const Params& p, int l, char* smem) {
    const int mvalid = (l == 0) ? 1152 : 1024, nmt = (l == 0) ? 5 : 4;
    MoeDnSched S{(const bf16_t*)(p.ws + WS_ACT), (const bf16_t*)((const char*)(p.ws + WS_WDN) + (size_t)l * 16 * 2048 * 2048), nmt, 16 * nmt * 8};
    pg8::gemm_phase<MoeDnSched, EpiDN, true>((LAS unsigned char*)smem, 1024, S, EpiDN{(bf16_t*)(p.ws + WS_YDN), (const float*)(p.ws + WS_SELGATE), mvalid});
    if (l == 0) tail_convert(p, 1, TAIL_DN_B0, 0, TAILT_DN, smem);
}

constexpr int NPHASE = 2 + 2 * 10;
__global__ void __launch_bounds__(512, 2) mega(Params p) {
    extern __shared__ __attribute__((aligned(1024))) char smem[];
    if (threadIdx.x == 0) *(uint4*)(smem + LDS_XB) = make_uint4(0u, 0u, 0u, 0u);
    __syncthreads();
    XcdBarrier bar = xcd_barrier_post((unsigned*)(p.ws + WS_BAR), (volatile LAS unsigned*)(smem + LDS_XB));
#ifndef PHMASK
#define PHMASK 0xFFFF
#endif
#ifndef PROBE_DUP
#define PROBE_DUP 0
#endif
#define RUN(bit, k, call) do { if constexpr ((PHMASK >> (bit)) & 1) { if ((k) >= p.ph_lo && (k) < p.ph_hi) { call; \
    if constexpr ((PROBE_DUP >> (bit)) & 1) { if ((bit) != 6 || l_probe == 0) { xcd_barrier(bar); call; } } \
    if ((k) + 1 < p.ph_hi) xcd_barrier(bar); } } } while (0)
    int l_probe = 0;
    RUN(0, 0, (phase_p0(p, smem), wait_mod(p), phase_rows<0>(p, 0, smem)));
#ifdef PROBE_XBAR
    for (int i = 0; i < PROBE_XBAR; ++i) xcd_barrier(bar);
#endif
    for (int l = 0; l < 2; ++l) {
        const int k0 = 2 + l * 10; l_probe = l;
        RUN(2, k0 + 0, phase_win(p, l, smem));
        RUN(3, k0 + 1, phase_l2(p, l, smem));
        RUN(5, k0 + 3, phase_l4(p, l, smem));
        RUN(6, k0 + 4, phase_wout(p, l, smem));
        RUN(7, k0 + 5, phase_rows<1>(p, l, smem));
        RUN(8, k0 + 6, phase_rank(p, l, smem));
        RUN(9, k0 + 7, phase_moe_gu(p, l, smem));
        RUN(10, k0 + 8, phase_moe_dn(p, l, smem));
        if (l == 0) RUN(11, k0 + 9, phase_rows<2>(p, 0, smem)); else RUN(12, k0 + 9, phase_rows<3>(p, 1, smem));
    }
#undef RUN
}

extern "C" void kernel_launch(void* const* d_in, const int* in_sizes, int n_in, void* d_out, int out_size, void* d_ws, size_t ws_size, hipStream_t stream) {
    static int grid = 0;
    if (!grid) {
        if (ws_size < WS_END) { fprintf(stderr, "kernel_launch: workspace too small: %zu < %zu\n", ws_size, (size_t)WS_END); return; }
        if (hipFuncSetAttribute((const void*)mega, hipFuncAttributeMaxDynamicSharedMemorySize, LDS_BYTES) != hipSuccess) { fprintf(stderr, "kernel_launch: LDS attribute failed\n"); return; }
        int dev = 0, cus = 0, per_cu = 0;
        hipGetDevice(&dev);
        hipDeviceGetAttribute(&cus, hipDeviceAttributeMultiprocessorCount, dev);
        hipOccupancyMaxActiveBlocksPerMultiprocessor(&per_cu, (const void*)mega, 512, LDS_BYTES);
        if (per_cu < 1) { fprintf(stderr, "kernel_launch: occupancy query says 0\n"); return; }
        grid = cus;
    }
    Params p{};
    p.x = (const float*)d_in[0]; p.c = (const float*)d_in[1]; p.ctx = (const float*)d_in[2]; p.c_ctx = (const float*)d_in[3];
    p.ada_w = (const float*)d_in[4]; p.ada_b = (const float*)d_in[5]; p.w_in = (const float*)d_in[6]; p.q_norm = (const float*)d_in[7];
    p.w_uq = (const float*)d_in[8]; p.kv_norm = (const float*)d_in[9]; p.w_ukv = (const float*)d_in[10]; p.gla_w2 = (const float*)d_in[11];
    p.gla_b = (const float*)d_in[12]; p.w_out = (const float*)d_in[13]; p.router_w = (const float*)d_in[14]; p.w_gate = (const float*)d_in[15];
    p.w_up = (const float*)d_in[16]; p.w_down = (const float*)d_in[17]; p.final_norm = (const float*)d_in[18];
    p.out = (float*)d_out; p.ws = (char*)d_ws;
    hipMemsetAsync((char*)d_ws + WS_BAR, 0, 16384, stream);
#if MK_ONE_LAUNCH
    p.ph_lo = 0; p.ph_hi = NPHASE;
    hipLaunchKernelGGL(mega, dim3(grid), dim3(512), LDS_BYTES, stream, p);
#else
    for (int k = 0; k < NPHASE; ++k) { p.ph_lo = k; p.ph_hi = k + 1; hipLaunchKernelGGL(mega, dim3(grid), dim3(512), LDS_BYTES, stream, p); }
#endif
    const hipError_t le = hipPeekAtLastError();
    if (le != hipSuccess) fprintf(stderr, "kernel_launch: launch failed: %s\n", hipGetErrorName(le));
}
```

```cpp
#include <hip/hip_runtime.h>
#include <stdint.h>
#include <stdio.h>

#ifndef MK_ONE_LAUNCH
#define MK_ONE_LAUNCH 1
#endif

#define DEVI __device__ __forceinline__
typedef unsigned short bf16_t;
typedef short bf16x8 __attribute__((ext_vector_type(8)));
typedef short s16x4 __attribute__((ext_vector_type(4)));
typedef float f32x2 __attribute__((ext_vector_type(2)));
typedef float f32x4 __attribute__((ext_vector_type(4)));
typedef float f32x8 __attribute__((ext_vector_type(8)));
typedef float f32x16 __attribute__((ext_vector_type(16)));
typedef unsigned u32x2 __attribute__((ext_vector_type(2)));
typedef unsigned u32x4 __attribute__((ext_vector_type(4)));
typedef int i32x4 __attribute__((ext_vector_type(4)));
typedef __bf16 bf16x2_t __attribute__((ext_vector_type(2)));

constexpr int DM = 2048, NB = 4, SEQ = 2048, CL = 256, NLAT = NB * SEQ, NCTX = NB * CL, NROW = NLAT + NCTX;
constexpr int INC = 4448, INCP = 4608;
constexpr int C_CQ = 0, C_CKV = 512, C_KR = 768, C_GQ = 832, C_GK = 1088, C_GV = 1344, C_GZ = 1856, C_GOG = 1888, C_RQ = 2400, C_RK = 2912, C_RV = 3424, C_RG = 3936;
constexpr int KEYS = SEQ + CL;
constexpr int NCH = 36;
constexpr int MSLOT = 1280;
constexpr float QSCALE = 0.07216878364870322f;
constexpr float EPS = 1e-6f;

constexpr size_t al256(size_t x) { return (x + 255) / 256 * 256; }
constexpr size_t WS_BAR = 0;
constexpr size_t WS_MOD = 16384;
constexpr size_t WS_RAX = WS_MOD + al256((size_t)2 * 5 * 12288 * 4);
constexpr size_t WS_RRET = WS_RAX + al256((size_t)64 * 16 * 2 * 4);
constexpr size_t WS_WIN = WS_RRET + al256((size_t)2048 * 64 * 2 * 4);
constexpr size_t WS_WUQ = WS_WIN + al256((size_t)2 * INCP * 2048 * 2);
constexpr size_t WS_WUKV = WS_WUQ + al256((size_t)2 * 1536 * 512 * 2);
constexpr size_t WS_WOUT = WS_WUKV + al256((size_t)2 * 2048 * 256 * 2);
constexpr size_t WS_WGU = WS_WOUT + al256((size_t)2 * 2048 * 2048 * 2);
constexpr size_t WS_WDN = WS_WGU + al256((size_t)2 * 16 * 4096 * 2048 * 2);
constexpr size_t WS_XRES = WS_WDN + al256((size_t)2 * 16 * 2048 * 2048 * 2);
constexpr size_t WS_H = WS_XRES + al256((size_t)NROW * DM * 4);
constexpr size_t WS_P = WS_H + al256((size_t)NROW * DM * 2);
constexpr size_t WS_Q = WS_P + al256((size_t)NROW * INC * 2);
constexpr size_t WS_K = WS_Q + al256((size_t)NB * 8 * KEYS * 192 * 2);
constexpr size_t WS_V = WS_K + al256((size_t)NB * 8 * KEYS * 192 * 2);
constexpr size_t WS_YMIX = WS_V + al256((size_t)NB * 8 * KEYS * 128 * 2);
constexpr size_t WS_UTG = WS_YMIX + al256((size_t)NROW * DM * 2);
constexpr size_t WS_UTR = WS_UTG + al256((size_t)32 * NCH * 128 * 64 * 4);
constexpr size_t WS_STG = WS_UTR + al256((size_t)32 * NCH * 128 * 128 * 4);
constexpr size_t WS_STR = WS_STG + al256((size_t)32 * NCH * 128 * 64 * 2);
constexpr size_t WS_DECG = WS_STR + al256((size_t)32 * NCH * 128 * 128 * 2);
constexpr size_t WS_AFF = WS_DECG + al256((size_t)32 * NCH * 64 * 4);
constexpr size_t WS_RANK = WS_AFF + al256((size_t)NB * 16 * KEYS * 4);
constexpr size_t WS_SELROW = WS_RANK + al256((size_t)NB * 16 * KEYS * 4);
constexpr size_t WS_SELGATE = WS_SELROW + al256((size_t)16 * MSLOT * 4);
constexpr size_t WS_ACT = WS_SELGATE + al256((size_t)16 * MSLOT * 4);
constexpr size_t WS_YDN = WS_ACT + al256((size_t)16 * MSLOT * 2048 * 2);
constexpr size_t WS_END = WS_YDN + al256((size_t)16 * MSLOT * 2048 * 2);

constexpr int MODCNT_WORD = 3584, P0_N_MOD_ITEMS = 512, PFXCNT_WORD = 3648;
constexpr int LDS_RS = 131072, LDS_XB = 131072 + 8192, LDS_BYTES = 131072 + 8192 + 64;
#ifndef SUBMASK
#define SUBMASK 0xFF
#endif
#define SUB(n) if constexpr ((SUBMASK >> (n)) & 1)

struct Params {
    const float *x, *c, *ctx, *c_ctx, *ada_w, *ada_b, *w_in, *q_norm, *w_uq, *kv_norm, *w_ukv, *gla_w2, *gla_b, *w_out, *router_w, *w_gate, *w_up, *w_down, *final_norm;
    float* out; char* ws; int ph_lo, ph_hi;
};

DEVI unsigned cvt_pk(float lo, float hi) { f32x2 v = {lo, hi}; bf16x2_t b = __builtin_convertvector(v, bf16x2_t); return __builtin_bit_cast(unsigned, b); }
DEVI bf16_t f2bf(float x) { return (bf16_t)(cvt_pk(x, 0.f) & 0xffffu); }
DEVI float bf2f(bf16_t b) { return __uint_as_float(((unsigned)b) << 16); }
DEVI float bflo(unsigned w) { return __uint_as_float(w << 16); }
DEVI float bfhi(unsigned w) { return __uint_as_float(w & 0xffff0000u); }
DEVI int obid() { int b = blockIdx.x; asm volatile("" : "+s"(b)); return b; }
DEVI int opaque_tid() { int t = threadIdx.x; asm volatile("" : "+v"(t)); return t; }
typedef int i32x8 __attribute__((ext_vector_type(8)));
DEVI float clamp8(float x) { return __builtin_amdgcn_fmed3f(x, -448.f, 448.f); }
DEVI unsigned cvt4_fp8(float a, float b, float c, float d) { int w = 0; w = __builtin_amdgcn_cvt_pk_fp8_f32(a, b, w, false); w = __builtin_amdgcn_cvt_pk_fp8_f32(c, d, w, true); return (unsigned)w; }
DEVI unsigned cvt4_fp8c(float a, float b, float c, float d) { return cvt4_fp8(clamp8(a), clamp8(b), clamp8(c), clamp8(d)); }
constexpr float W8_SCALE = 64.f, ACT8_SCALE = 4.f;
DEVI float silu_f(float x) { return x / (1.f + __expf(-x)); }
DEVI float wave_sum(float s) {
#pragma unroll
    for (int off = 32; off >= 1; off >>= 1) s += __shfl_xor(s, off);
    return s;
}
DEVI void unpack8(bf16x8 v, float (&f)[8]) {
    u32x4 w = __builtin_bit_cast(u32x4, v);
#pragma unroll
    for (int i = 0; i < 4; ++i) { f[2 * i] = bflo(w[i]); f[2 * i + 1] = bfhi(w[i]); }
}
DEVI bf16x8 pack8(const float (&f)[8]) {
    u32x4 w = {cvt_pk(f[0], f[1]), cvt_pk(f[2], f[3]), cvt_pk(f[4], f[5]), cvt_pk(f[6], f[7])};
    return __builtin_bit_cast(bf16x8, w);
}

#define XB_TMO      128
#define XB_XCNT(j)  (256  + 64 * (j))
#define XB_XSUB(j)  (1280 + 64 * (j))
#define XB_XGEN(j)  (2304 + 64 * (j))
#define XB_TOP      3328
#define XB_TOPGEN   3392
#define XCD_BAR_WORDS 3456
#define XB_SPIN_CAP (1u << 18)
#define LAS __attribute__((address_space(3)))
DEVI unsigned xb_ld(unsigned* p)              { return __hip_atomic_load(p, __ATOMIC_RELAXED, __HIP_MEMORY_SCOPE_AGENT); }
DEVI unsigned xb_add(unsigned* p, unsigned v) { return __hip_atomic_fetch_add(p, v, __ATOMIC_RELAXED, __HIP_MEMORY_SCOPE_AGENT); }
DEVI unsigned xb_xcc_id() { return (unsigned)__builtin_amdgcn_s_getreg((3 << 11) | 20) & 0xFu; }
#define XB_SPIN(cond, bar) do { unsigned _sp = 0; while (cond) { __builtin_amdgcn_s_sleep(1); \
    if ((++_sp & 255u) == 0u) { if (xb_ld(&(bar)[XB_TMO])) break; if (_sp > XB_SPIN_CAP) { atomicAdd(&(bar)[XB_TMO], 1u); break; } } } } while (0)
struct XcdBarrier { unsigned* bar; unsigned x; volatile LAS unsigned* st; };
DEVI XcdBarrier xcd_barrier_post(unsigned* bar, volatile LAS unsigned* st) {
    XcdBarrier b; b.bar = bar; b.x = xb_xcc_id(); b.st = st;
    if (threadIdx.x == 0) (void)xb_add(&bar[XB_XCNT(b.x)], 1u);
    return b;
}
DEVI void xcd_barrier_complete(unsigned* bar, unsigned x, unsigned& nloc, unsigned& nx) {
    const unsigned G = gridDim.x * gridDim.y * gridDim.z;
    unsigned sum, cnt, mine, sp = 0u;
    for (;;) {
        sum = 0u; cnt = 0u; mine = 0u;
#pragma unroll
        for (unsigned j = 0; j < 16; ++j) { const unsigned c = xb_ld(&bar[XB_XCNT(j)]); sum += c; cnt += (c > 0u) ? 1u : 0u; mine = (j == x) ? c : mine; }
        if (sum == G) break;
        __builtin_amdgcn_s_sleep(1);
        if ((++sp & 255u) == 0u) { if (xb_ld(&bar[XB_TMO])) break; if (sp > XB_SPIN_CAP) { atomicAdd(&bar[XB_TMO], 1u); break; } }
    }
    nloc = mine > 0u ? mine : 1u; nx = cnt > 0u ? cnt : 1u;
}
DEVI void xcd_barrier(const XcdBarrier& b) {
    asm volatile("s_waitcnt vmcnt(0)" ::: "memory");
    __syncthreads();
    if (threadIdx.x == 0) {
        unsigned* bar = b.bar;
        __builtin_amdgcn_s_waitcnt(0);
        unsigned nloc = b.st[0], nx = b.st[1];
        if (nloc == 0u) { xcd_barrier_complete(bar, b.x, nloc, nx); b.st[0] = nloc; b.st[1] = nx; }
        const unsigned old = xb_add(&bar[XB_XSUB(b.x)], 1u);
        const unsigned gen = old / nloc;
        if (old + 1u == (gen + 1u) * nloc) {
            __builtin_amdgcn_fence(__ATOMIC_RELEASE, "agent");
            asm volatile("s_waitcnt vmcnt(0)" ::: "memory");
            const unsigned og = xb_add(&bar[XB_TOP], 1u);
            const unsigned tg = og / nx;
            if (og + 1u == (tg + 1u) * nx) xb_add(&bar[XB_TOPGEN], 1u);
            else XB_SPIN(xb_ld(&bar[XB_TOPGEN]) == tg, bar);
            __builtin_amdgcn_fence(__ATOMIC_ACQUIRE, "agent");
            xb_add(&bar[XB_XGEN(b.x)], 1u);
            asm volatile("s_waitcnt vmcnt(0)" ::: "memory");
        } else {
            XB_SPIN(xb_ld(&bar[XB_XGEN(b.x)]) == gen, bar);
            __builtin_amdgcn_fence(__ATOMIC_ACQUIRE, "agent");
            asm volatile("s_waitcnt vmcnt(0)" ::: "memory");
        }
    }
    __syncthreads();
}

namespace pg8 {
constexpr int BM = 256, BK = 64, HALF = 128, HTB = HALF * BK * 2, STAGE_BYTES = 8 * HTB;
DEVI int lds_byte(int r, int c) { const int st = (r >> 4) * 2 + (c >> 5), rr = r & 15, cc = c & 31, ob = rr * 64 + cc * 2; return st * 1024 + (ob ^ (((ob >> 9) & 1) << 5)); }
DEVI void stage_rc(int b, int& R, int& C) { const int st = b / 1024, sb = b % 1024, swz = sb ^ (((sb >> 9) & 1) << 5); R = (st >> 1) * 16 + swz / 64; C = (st & 1) * 32 + (swz % 64) / 2; }
DEVI int perm32(int rho) { const int n = rho >> 4, i = rho & 15; return 8 * (i >> 2) + 4 * n + (i & 3); }
struct Unit { const char* A; const char* B; int pm, pn, e, ord, half; };

template <class Sched, class Epi, bool FP8 = false>
DEVI void gemm_phase(LAS unsigned char* lds, const int K, const Sched& S, const Epi& E) {
    const int tid = opaque_tid(), wid = __builtin_amdgcn_readfirstlane(tid >> 6), lane = tid & 63, wr = wid >> 2, wc = wid & 3, fr = lane & 15, fq = lane >> 4;
    const int nt = K / BK;
    int R0, C0, R1, C1; stage_rc(tid * 16, R0, C0); stage_rc(tid * 16 + 8192, R1, C1);
    unsigned voffB[2];
    { const int Rb0 = Epi::PERM ? ((R0 & ~31) + perm32(R0 & 31)) : R0, Rb1 = Epi::PERM ? ((R1 & ~31) + perm32(R1 & 31)) : R1;
      voffB[0] = (unsigned)(Rb0 * K + C0) * 2u; voffB[1] = (unsigned)(Rb1 * K + C1) * 2u; }
    const size_t kstep = (size_t)(BK * 2);
    const size_t hstepB = (size_t)HALF * K * 2;
    const unsigned ldsw = (unsigned)wid * 1024u;
    const int aoff = lds_byte(wr * 64 + fr, fq * 8), boff = lds_byte(wc * 32 + fr, fq * 8);
#define PG8_SA(b, h) (((b) * 2 + (h)) * HTB)
#define PG8_SB(b, h) ((4 + (b) * 2 + (h)) * HTB)
#define PG8_STAGE2(bufoff, gbase, v0, v1) do { \
        __builtin_amdgcn_global_load_lds((const unsigned*)((const char*)(gbase) + (v0)), (LAS unsigned*)(lds + (bufoff) + ldsw), 16, 0, 0); \
        __builtin_amdgcn_global_load_lds((const unsigned*)((const char*)(gbase) + (v1)), (LAS unsigned*)(lds + (bufoff) + ldsw + 8192), 16, 0, 0); } while (0)
#define PG8_STAGEB(bufoff, gbase) PG8_STAGE2(bufoff, gbase, voffB[0], voffB[1])
#define PG8_RD8(addr) __builtin_shufflevector(*(const LAS i32x4*)(addr), *(const LAS i32x4*)((addr) + 1024), 0, 1, 2, 3, 4, 5, 6, 7)
#define PG8_LDA(dst, b, h) do { if constexpr (FP8) { _Pragma("unroll") for (int m = 0; m < 4; ++m) dst##8[m] = PG8_RD8(lds + PG8_SA(b, h) + aoff + m * 2048); } \
        else { _Pragma("unroll") for (int m = 0; m < 4; ++m) _Pragma("unroll") for (int k = 0; k < 2; ++k) dst[m][k] = *(const LAS bf16x8*)(lds + PG8_SA(b, h) + aoff + m * 2048 + k * 1024); } } while (0)
#define PG8_LDB(dst, b, h) do { if constexpr (FP8) { _Pragma("unroll") for (int n = 0; n < 2; ++n) dst##8[n] = PG8_RD8(lds + PG8_SB(b, h) + boff + n * 2048); } \
        else { _Pragma("unroll") for (int n = 0; n < 2; ++n) _Pragma("unroll") for (int k = 0; k < 2; ++k) dst[n][k] = *(const LAS bf16x8*)(lds + PG8_SB(b, h) + boff + n * 2048 + k * 1024); } } while (0)
#define PG8_MMA(ai, bj, At, Bt) do { __builtin_amdgcn_s_setprio(1); _Pragma("unroll") for (int m = 0; m < 4; ++m) _Pragma("unroll") for (int n = 0; n < 2; ++n) { \
        if constexpr (FP8) asm volatile("v_mfma_scale_f32_16x16x128_f8f6f4 %0, %1, %2, %0, %3, %3 op_sel_hi:[0,0,0]" : "+v"(acc[ai][bj][m][n]) : "v"(Bt##8[n]), "v"(At##8[m]), "v"(mx_one));   \
        else { _Pragma("unroll") for (int k = 0; k < 2; ++k) acc[ai][bj][m][n] = __builtin_amdgcn_mfma_f32_16x16x32_bf16(Bt[n][k], At[m][k], acc[ai][bj][m][n], 0, 0, 0); } } \
        __builtin_amdgcn_s_setprio(0); } while (0)
#define PG8_WAIT_V(n) asm volatile("s_waitcnt vmcnt(" #n ")" ::: "memory")
#define PG8_WAIT_L(n) asm volatile("s_waitcnt lgkmcnt(" #n ")" ::: "memory")
#define PG8_BAR __builtin_amdgcn_s_barrier()
#define PG8_SCHED __builtin_amdgcn_sched_barrier(0)
    Unit cur, nxt; int ui = 0;
    if (!S.next(0, cur)) return;
    f32x4 acc[2][2][4][2];
#pragma unroll
    for (int a = 0; a < 2; ++a)
#pragma unroll
        for (int b = 0; b < 2; ++b)
#pragma unroll
            for (int m = 0; m < 4; ++m)
#pragma unroll
                for (int n = 0; n < 2; ++n) acc[a][b][m][n] = (f32x4){0.f, 0.f, 0.f, 0.f};
    bf16x8 At[4][2], B0[2][2], B1[2][2];
    i32x8 At8[4], B08[2], B18[2];
    const int mx_one = 0x7f7f7f7f;
    unsigned vc[4], vn[4];
    S.aoff(cur, R0, C0, R1, C1, vc);
    const char* cA = cur.A; const char* cB = cur.B;
    PG8_STAGEB(PG8_SB(0, 0), cB); PG8_STAGEB(PG8_SB(0, 1), cB + hstepB); PG8_STAGE2(PG8_SA(0, 0), cA, vc[0], vc[1]); PG8_STAGE2(PG8_SA(0, 1), cA, vc[2], vc[3]);
    if (wr == 1) PG8_BAR;
    PG8_WAIT_V(2); PG8_BAR;
    PG8_STAGEB(PG8_SB(1, 0), cB + kstep); PG8_STAGE2(PG8_SA(1, 0), cA + kstep, vc[0], vc[1]); PG8_STAGEB(PG8_SB(1, 1), cB + hstepB + kstep);
    PG8_WAIT_V(6); PG8_BAR;
    for (;;) {
        const bool has_next = S.next(ui + 1, nxt);
        if (has_next) S.aoff(nxt, R0, C0, R1, C1, vn);
        else { vn[0] = vc[0]; vn[1] = vc[1]; vn[2] = vc[2]; vn[3] = vc[3]; }
        const char* nA = has_next ? nxt.A : cA; const char* nB = has_next ? nxt.B : cB;
        const bool chalf = cur.half != 0;
#pragma nounroll
        for (int t = 0; t < nt; t += 2) {
            const bool last = (t == nt - 2);
            const char* a1 = cA + (size_t)(t + 1) * kstep;
            const char* a2 = last ? nA : cA + (size_t)(t + 2) * kstep; const char* b2 = last ? nB : cB + (size_t)(t + 2) * kstep;
            const char* a3 = a2 + kstep; const char* b3 = b2 + kstep;
            const unsigned w0 = last ? vn[0] : vc[0], w1 = last ? vn[1] : vc[1], w2 = last ? vn[2] : vc[2], w3 = last ? vn[3] : vc[3];
            PG8_LDB(B0, 0, 0); PG8_LDB(B1, 0, 1); PG8_SCHED; PG8_LDA(At, 0, 0); PG8_STAGE2(PG8_SA(1, 1), a1, vc[2], vc[3]);
            PG8_WAIT_V(8); PG8_WAIT_L(0); PG8_BAR; PG8_MMA(0, 0, At, B0); PG8_MMA(0, 1, At, B1); PG8_BAR; PG8_SCHED;
            PG8_LDA(At, 0, 1); PG8_STAGEB(PG8_SB(0, 0), b2); PG8_STAGEB(PG8_SB(0, 1), b2 + hstepB); PG8_STAGE2(PG8_SA(0, 0), a2, w0, w1);
            PG8_WAIT_V(8); PG8_WAIT_L(0); PG8_BAR; if (!chalf) { PG8_MMA(1, 0, At, B0); PG8_MMA(1, 1, At, B1); } PG8_BAR; PG8_SCHED;
            PG8_LDB(B0, 1, 0); PG8_LDB(B1, 1, 1); PG8_SCHED; PG8_LDA(At, 1, 0); PG8_STAGE2(PG8_SA(0, 1), a2, w2, w3);
            PG8_WAIT_V(8); PG8_WAIT_L(0); PG8_BAR; PG8_MMA(0, 0, At, B0); PG8_MMA(0, 1, At, B1); PG8_BAR; PG8_SCHED;
            PG8_LDA(At, 1, 1); PG8_STAGEB(PG8_SB(1, 0), b3); PG8_STAGEB(PG8_SB(1, 1), b3 + hstepB); PG8_STAGE2(PG8_SA(1, 0), a3, w0, w1);
            PG8_WAIT_V(8); PG8_WAIT_L(0); PG8_BAR; if (!chalf) { PG8_MMA(1, 0, At, B0); PG8_MMA(1, 1, At, B1); } PG8_BAR; PG8_SCHED;
        }
        if (wr == 0) PG8_BAR;
        E(acc, cur, wr, wc, fr, fq);
        if (!has_next) break;
#pragma unroll
        for (int a = 0; a < 2; ++a)
#pragma unroll
            for (int b = 0; b < 2; ++b)
#pragma unroll
                for (int m = 0; m < 4; ++m)
#pragma unroll
                    for (int n = 0; n < 2; ++n) acc[a][b][m][n] = (f32x4){0.f, 0.f, 0.f, 0.f};
        cur = nxt; cA = nA; cB = nB; ++ui; vc[0] = vn[0]; vc[1] = vn[1]; vc[2] = vn[2]; vc[3] = vn[3];
        if (wr == 1) PG8_BAR;
    }
    PG8_WAIT_V(0);
    PG8_BAR;
#undef PG8_SA
#undef PG8_SB
#undef PG8_STAGE2
#undef PG8_STAGEB
#undef PG8_LDA
#undef PG8_LDB
#undef PG8_MMA
#undef PG8_RD8
#undef PG8_WAIT_V
#undef PG8_WAIT_L
#undef PG8_BAR
#undef PG8_SCHED
}
struct PlainSched {
    const bf16_t* A; const bf16_t* Bt; int lda, acol0, K, nM, nN, units;
    DEVI bool next(int i, Unit& u) const {
        const int g = obid() + i * gridDim.x; if (g >= units) return false;
        int wgid = g; { const int q = units / 8, r = units % 8, xcd = wgid % 8, off = wgid / 8; wgid = (xcd < r ? xcd * (q + 1) : r * (q + 1) + (xcd - r) * q) + off; }
        const int nig = 8 * nN, gid = wgid / nig, fm = gid * 8, gsz = (nM - fm) < 8 ? (nM - fm) : 8;
        u.pm = fm + ((wgid % nig) % gsz); u.pn = (wgid % nig) / gsz; u.e = 0; u.ord = i; u.half = 0;
        u.A = (const char*)(A + (size_t)u.pm * 256 * lda + acol0); u.B = (const char*)(Bt + (size_t)u.pn * 256 * K); return true; }
    DEVI void aoff(const Unit&, int R0, int C0, int R1, int C1, unsigned (&o)[4]) const {
        o[0] = (unsigned)(R0 * lda + C0) * 2u; o[1] = (unsigned)(R1 * lda + C1) * 2u; o[2] = (unsigned)((128 + R0) * lda + C0) * 2u; o[3] = (unsigned)((128 + R1) * lda + C1) * 2u; }
};
}

DEVI void p0_mod_item(const Params& p, int item, char* smem) {
    const int l = item / 256, cb = item % 256, n0 = cb * 48;
    float* sv = (float*)smem;
    float* red = (float*)(smem + 65536);
    const int tid = opaque_tid(), wid = tid >> 6, lane = tid & 63;
    for (int idx = tid; idx < 2048; idx += 512) {
#pragma unroll
        for (int b = 0; b < 4; ++b) sv[idx * 8 + b] = silu_f(p.c[b * 2048 + idx]);
        sv[idx * 8 + 4] = silu_f(p.c_ctx[idx]);
    }
    __syncthreads();
    const int ln_c = lane < 48 ? lane : 47;
    const float* W = p.ada_w + (size_t)l * 2048 * 12288 + n0 + ln_c;
    float a0 = 0.f, a1 = 0.f, a2 = 0.f, a3 = 0.f, a4 = 0.f;
#pragma unroll 32
    for (int kk = 0; kk < 256; ++kk) {
        const int k = wid * 256 + kk;
        const float w = W[(size_t)k * 12288];
        const f32x4 s = *(const f32x4*)(sv + k * 8); const float s4 = sv[k * 8 + 4];
        a0 += s[0] * w; a1 += s[1] * w; a2 += s[2] * w; a3 += s[3] * w; a4 += s4 * w;
    }
    red[(wid * 5 + 0) * 64 + lane] = a0; red[(wid * 5 + 1) * 64 + lane] = a1; red[(wid * 5 + 2) * 64 + lane] = a2;
    red[(wid * 5 + 3) * 64 + lane] = a3; red[(wid * 5 + 4) * 64 + lane] = a4;
    __syncthreads();
    if (tid < 320 && (tid & 63) < 48) {
        const int i = tid >> 6, ln = tid & 63; float s = 0.f;
#pragma unroll
        for (int w = 0; w < 8; ++w) s += red[(w * 5 + i) * 64 + ln];
        float* mod = (float*)(p.ws + WS_MOD);
        __hip_atomic_store(&mod[(size_t)(l * 5 + i) * 12288 + n0 + ln], s + p.ada_b[l * 12288 + n0 + ln], __ATOMIC_RELAXED, __HIP_MEMORY_SCOPE_AGENT);
    }
    asm volatile("s_waitcnt vmcnt(0)" ::: "memory");
    __syncthreads();
    if (tid == 0) __hip_atomic_fetch_add((unsigned*)(p.ws + WS_BAR) + MODCNT_WORD, 1u, __ATOMIC_RELAXED, __HIP_MEMORY_SCOPE_AGENT);
}
DEVI void wait_mod(const Params& p) {
    if (threadIdx.x == 0) {
        unsigned* c = (unsigned*)(p.ws + WS_BAR) + MODCNT_WORD; unsigned sp = 0;
        while (__hip_atomic_load(c, __ATOMIC_RELAXED, __HIP_MEMORY_SCOPE_AGENT) < (unsigned)P0_N_MOD_ITEMS) { __builtin_amdgcn_s_sleep(2); if (++sp > (1u << 22)) break; }
        __builtin_amdgcn_fence(__ATOMIC_ACQUIRE, "agent");
        asm volatile("s_waitcnt vmcnt(0)" ::: "memory");
    }
    __syncthreads();
}

struct CvtD { const float* src; const float* scale; bf16_t* dst; int ldn, nvalid, K, k0, n0, d0; };
DEVI CvtD p0_bf16_desc(const Params& p, int j) {
    CvtD d;
    if (j < 1152) { const int l = j / 576, r = j % 576, kt = r / 36, nt = r % 36;
        d = CvtD{p.w_in + (size_t)l * 2048 * INC, nullptr, (bf16_t*)(p.ws + WS_WIN) + (size_t)l * INCP * 2048, INC, INC, 2048, kt * 128, nt * 128, nt * 128}; return d; }
    j -= 1152;
    if (j < 96) { const int l = j / 48, r = j % 48, kt = r / 12, nt = r % 12;
        d = CvtD{p.w_uq + (size_t)l * 512 * 1536, p.q_norm + l * 512, (bf16_t*)(p.ws + WS_WUQ) + (size_t)l * 1536 * 512, 1536, 1536, 512, kt * 128, nt * 128, nt * 128}; return d; }
    j -= 96;
    if (j < 64) { const int l = j / 32, r = j % 32, kt = r / 16, nt = r % 16;
        d = CvtD{p.w_ukv + (size_t)l * 256 * 2048, p.kv_norm + l * 256, (bf16_t*)(p.ws + WS_WUKV) + (size_t)l * 2048 * 256, 2048, 2048, 256, kt * 128, nt * 128, nt * 128}; return d; }
    j -= 64;
    { const int l = j / 256, r = j % 256, kt = r / 16, nt = r % 16;
        d = CvtD{p.w_out + (size_t)l * 2048 * 2048, nullptr, (bf16_t*)(p.ws + WS_WOUT) + (size_t)l * 2048 * 2048, 2048, 2048, 2048, kt * 128, nt * 128, nt * 128}; return d; }
}
struct CvtRegs { f32x4 v[8]; };
DEVI void cvt_tile_load(const CvtD& d, CvtRegs& rg) {
    const int tid = opaque_tid(), nq = tid & 31, kq0 = tid >> 5;
#pragma unroll
    for (int it = 0; it < 2; ++it)
#pragma unroll
        for (int kk = 0; kk < 4; ++kk) { const int k = d.k0 + (kq0 + it * 16) * 4 + kk, n = d.n0 + nq * 4;
            f32x4 v = (n < d.nvalid) ? *(const f32x4*)(d.src + (size_t)k * d.ldn + n) : (f32x4){0.f, 0.f, 0.f, 0.f};
            if (d.scale) v *= d.scale[k];
            rg.v[it * 4 + kk] = v; }
}
DEVI void cvt_tile_finish(const CvtD& d, const CvtRegs& rg, char* smem) {
    bf16_t* T = (bf16_t*)smem;
    const int tid = opaque_tid(), nq = tid & 31, kq0 = tid >> 5;
#pragma unroll
    for (int it = 0; it < 2; ++it) { const int kq = kq0 + it * 16;
#pragma unroll
        for (int j = 0; j < 4; ++j) { u32x2 w = {cvt_pk(rg.v[it * 4][j], rg.v[it * 4 + 1][j]), cvt_pk(rg.v[it * 4 + 2][j], rg.v[it * 4 + 3][j])};
            *(u32x2*)(T + (nq * 4 + j) * 132 + kq * 4) = w; } }
    __syncthreads();
#pragma unroll
    for (int i = 0; i < 8; ++i) { const int nl = (tid >> 5) + 16 * i, kc = (tid & 31) * 4;
        *(u32x2*)(d.dst + (size_t)(d.d0 + nl) * d.K + d.k0 + kc) = *(const u32x2*)(T + nl * 132 + kc); }
    __syncthreads();
}

struct CvtIn { f32x4 v[8]; };
DEVI void cvt8_load(const Params& p, int L, int t, CvtIn& in) {
    const int which = t / 4096, r = t % 4096, le = L * 16 + r / 256, kt = (r % 256) / 16, nt = r % 16;
    const float* src = (which == 2 ? p.w_down : (which == 0 ? p.w_gate : p.w_up)) + (size_t)le * 2048 * 2048;
    const int tid = opaque_tid(), nq = tid & 31, kq0 = tid >> 5;
#pragma unroll
    for (int it = 0; it < 2; ++it)
#pragma unroll
        for (int kk = 0; kk < 4; ++kk) in.v[it * 4 + kk] = __builtin_nontemporal_load((const f32x4*)(src + (size_t)(kt * 128 + (kq0 + it * 16) * 4 + kk) * 2048 + nt * 128 + nq * 4));
}
DEVI void cvt8_finish(const Params& p, int L, int t, const CvtIn& in, char* smem) {
    const int which = t / 4096, r = t % 4096, le = L * 16 + r / 256, kt = (r % 256) / 16, nt = r % 16;
    unsigned char* dst = (which == 2) ? (unsigned char*)(p.ws + WS_WDN) + (size_t)le * 2048 * 2048 + (size_t)(nt * 128) * 2048
                                      : (unsigned char*)(p.ws + WS_WGU) + (size_t)le * 4096 * 2048 + (size_t)(nt * 256 + which * 128) * 2048;
    unsigned char* T = (unsigned char*)smem;
    const int tid = opaque_tid(), nq = tid & 31, kq0 = tid >> 5;
#pragma unroll
    for (int it = 0; it < 2; ++it) { const int kq = kq0 + it * 16;
#pragma unroll
        for (int j = 0; j < 4; ++j) *(unsigned*)(T + (nq * 4 + j) * 144 + kq * 4) =
            cvt4_fp8(in.v[it * 4][j] * W8_SCALE, in.v[it * 4 + 1][j] * W8_SCALE, in.v[it * 4 + 2][j] * W8_SCALE, in.v[it * 4 + 3][j] * W8_SCALE); }
    __syncthreads();
#pragma unroll
    for (int i = 0; i < 2; ++i) { const int nl = (tid >> 3) + 64 * i, kc = (tid & 7) * 16;
        *(u32x4*)(dst + (size_t)nl * 2048 + kt * 128 + kc) = *(const u32x4*)(T + nl * 144 + kc); }
    __syncthreads();
}
DEVI void cvt8_stream(const Params& p, int L, int t0, int step, int count, char* smem) {
    if (count <= 0) return;
    CvtIn cur; cvt8_load(p, L, t0, cur);
    for (int i = 0; i < count; ++i) { const int t = t0 + i * step; CvtIn nxt;
        if (i + 1 < count) cvt8_load(p, L, t + step, nxt);
        cvt8_finish(p, L, t, cur, smem);
        cur = nxt; }
}
DEVI void cvt8_stream3(const Params& p, int L, int t0, int step, int count, char* smem) {
    if (count <= 0) return;
    CvtIn a, b; cvt8_load(p, L, t0, a);
    if (count > 1) cvt8_load(p, L, t0 + step, b);
#pragma nounroll
    for (int i = 0; i < count; ++i) { CvtIn c;
        if (i + 2 < count) cvt8_load(p, L, t0 + (i + 2) * step, c);
        cvt8_finish(p, L, t0 + i * step, a, smem);
        a = b; b = c; }
}
#ifndef TAILT_WIN
#define TAILT_WIN 18
#endif
#ifndef TAILT_WOUT
#define TAILT_WOUT 14
#endif
#ifndef TAILT_DN
#define TAILT_DN 10
#endif
constexpr int TAIL_WIN_B0 = 648 - 2 * 256, TAIL_WOUT_B0 = 288 - 256, TAIL_DN_B0 = 640 - 2 * 256;
constexpr int T0A = (256 - TAIL_WIN_B0) * TAILT_WIN, T0B = T0A + (256 - TAIL_WOUT_B0) * TAILT_WOUT, T1A = (256 - TAIL_DN_B0) * TAILT_DN, T1B = T1A + (256 - TAIL_WIN_B0) * TAILT_WIN;
static_assert(T0B <= 12288 && T1B <= 12288, "tail tiles");
DEVI void tail_convert(const Params& p, int L, int first_block, int base, int ntile, char* smem) {
    if (gridDim.x != 256 || obid() < first_block) return;
    cvt8_stream3(p, L, base + (obid() - first_block), 256 - first_block, ntile, smem);
}
#ifndef RANKT0
#define RANKT0 14
#endif
#ifndef RANKT1
#define RANKT1 14
#endif
constexpr int T0C = T0B + 192 * RANKT0, T1C = T1B + 192 * RANKT1;
static_assert(T0C <= 12288 && T1C <= 12288, "tail tiles");
constexpr int SCAN_A_UNITS = 2 * 16 * NCH, SCAN_C0_UNITS = 2 * 16 * NCH, SCAN_C1_UNITS = 2 * 16 * 32;
constexpr int TS0A = 12288 - SCAN_A_UNITS - SCAN_C0_UNITS, TS0C = 12288 - SCAN_C0_UNITS;
constexpr int TS1A = 12288 - SCAN_A_UNITS - SCAN_C1_UNITS, TS1C = 12288 - SCAN_C1_UNITS;
static_assert(T0C <= TS0A && T1C <= TS1A, "scan tiles");
constexpr int P0_N_MOD = 512, P0_N_WIN = 2 * 16 * 36, P0_N_WUQ = 2 * 4 * 12, P0_N_WUKV = 2 * 2 * 16, P0_N_WOUT = 2 * 16 * 16, P0_N_EXP0 = TS0A - T0C, P0_N_EXP = (TS0A - T0C) + (TS1A - T1C), P0_N_TAB = (1024 + 2048 * 64) / 512;
constexpr int P0_ITEMS = P0_N_MOD + P0_N_WIN + P0_N_WUQ + P0_N_WUKV + P0_N_WOUT + P0_N_EXP + P0_N_TAB;

DEVI void phase_p0(const Params& p, char* smem) {
    if (gridDim.x != 256) {
        { const int b0 = obid(), G = gridDim.x; if (b0 < T0C) cvt8_stream(p, 0, b0, G, (T0C - b0 + G - 1) / G, smem); if (b0 < T1C) cvt8_stream(p, 1, b0, G, (T1C - b0 + G - 1) / G, smem); }
    }
    for (int item = obid(); item < P0_ITEMS; item += gridDim.x) {
        int j = item;
        if (j < P0_N_MOD) { p0_mod_item(p, j, smem); continue; }
        j -= P0_N_MOD;
        if (j < P0_N_WIN + P0_N_WUQ + P0_N_WUKV + P0_N_WOUT) continue;
        j -= P0_N_WIN + P0_N_WUQ + P0_N_WUKV + P0_N_WOUT;
        if (j < P0_N_EXP) continue;
        j -= P0_N_EXP;
        {
            const int idx = j * 512 + threadIdx.x;
            if (idx < 1024) { const int pos = idx >> 4, f = idx & 15;
                const float inv = (float)pow(10000.0, -(double)f / 16.0); const float ang = (float)pos * inv;
                float* t = (float*)(p.ws + WS_RAX); t[idx * 2] = (float)cos((double)ang); t[idx * 2 + 1] = (float)sin((double)ang);
            } else { const int q = idx - 1024, tt = q >> 6, pp = q & 63;
                const float inv = (float)(1.0 / pow(10000.0, (double)pp / 63.0)); const float ang = (float)tt * inv;
                float* t = (float*)(p.ws + WS_RRET); t[q * 2] = (float)cos((double)ang); t[q * 2 + 1] = (float)sin((double)ang);
            }
        }
    }
    {
        const int G = gridDim.x, NB16 = P0_N_WIN + P0_N_WUQ + P0_N_WUKV + P0_N_WOUT;
        int first = obid() - P0_N_MOD % G; if (first < 0) first += G;
        if (first < NB16) { CvtD dc = p0_bf16_desc(p, first); CvtRegs rc; cvt_tile_load(dc, rc);
            for (int jj = first; jj < NB16; jj += G) { CvtD dn = dc; CvtRegs rn;
                if (jj + G < NB16) { dn = p0_bf16_desc(p, jj + G); cvt_tile_load(dn, rn); }
                cvt_tile_finish(dc, rc, smem);
                dc = dn; rc = rn; } }
    }
    {
        const int G = gridDim.x, EXP_BASE = P0_N_MOD + P0_N_WIN + P0_N_WUQ + P0_N_WUKV + P0_N_WOUT;
        int first = obid() - EXP_BASE % G; if (first < 0) first += G;
        if (first < P0_N_EXP0) cvt8_stream3(p, 0, T0C + first, G, (P0_N_EXP0 - first + G - 1) / G, smem);
        int f1 = first; if (f1 < P0_N_EXP0) f1 += ((P0_N_EXP0 - f1 + G - 1) / G) * G;
        if (f1 < P0_N_EXP) cvt8_stream3(p, 1, T1C + (f1 - P0_N_EXP0), G, (P0_N_EXP - f1 + G - 1) / G, smem);
    }
}

template <int MODE>
DEVI void phase_rows(const Params& p, int l, char* smem) {
    const int tid = opaque_tid(), wid = tid >> 6, lane = tid & 63;
    float* xres = (float*)(p.ws + WS_XRES);
    bf16_t* hbuf = (bf16_t*)(p.ws + WS_H);
    const float* mod = (const float*)(p.ws + WS_MOD);
    float* wT = (float*)smem;
    if (MODE == 1) {
        const float* rw = p.router_w + (size_t)l * 2048 * 16;
        f32x4 rwv[16];
#pragma unroll
        for (int it = 0; it < 16; ++it) { const int i = tid + it * 512; rwv[it] = *(const f32x4*)(rw + (i >> 2) * 16 + (i & 3) * 4); }
#pragma unroll
        for (int it = 0; it < 16; ++it) { const int i = tid + it * 512, k = i >> 2, e4 = (i & 3) * 4; const f32x4 v = rwv[it];
            wT[(e4 + 0) * 2048 + k] = v[0]; wT[(e4 + 1) * 2048 + k] = v[1]; wT[(e4 + 2) * 2048 + k] = v[2]; wT[(e4 + 3) * 2048 + k] = v[3]; }
        __syncthreads();
    }
    const int nrows = (MODE == 3 || (MODE == 1 && l == 1)) ? NLAT : NROW;
    for (int row = obid() * 8 + wid; row < nrows; row += gridDim.x * 8) {
        const bool lat = row < NLAT;
        const int b = lat ? (row >> 11) : ((row - NLAT) >> 8);
        const int tok = lat ? (row & 2047) : (SEQ + ((row - NLAT) & 255));
        const float* src = (MODE == 0) ? (lat ? p.x + (size_t)row * DM : p.ctx + (size_t)(row - NLAT) * DM) : xres + (size_t)row * DM;
        float v[32];
#pragma unroll
        for (int i = 0; i < 8; ++i) { const f32x4 t = *(const f32x4*)(src + i * 256 + lane * 4); v[i * 4] = t[0]; v[i * 4 + 1] = t[1]; v[i * 4 + 2] = t[2]; v[i * 4 + 3] = t[3]; }
        const float* mrow = mod + (size_t)(((MODE == 2) ? l : l) * 5 + (lat ? b : 4)) * 12288;
        if (MODE == 2 || MODE == 3) {
            float cacc[32];
#pragma unroll
            for (int i = 0; i < 32; ++i) cacc[i] = 0.f;
            const int* rk = (const int*)(p.ws + WS_RANK) + (size_t)b * 16 * KEYS + tok;
            const bf16_t* ydn = (const bf16_t*)(p.ws + WS_YDN);
            const int cap = lat ? 256 : 32;
            int rke[16];
#pragma unroll
            for (int e = 0; e < 16; ++e) rke[e] = rk[e * KEYS];
#pragma unroll
            for (int e = 0; e < 16; ++e) {
                const int r = rke[e];
                if (r < cap) {
                    const int slot = lat ? (b * 256 + r) : (1024 + b * 32 + r);
                    const bf16_t* yr = ydn + ((size_t)e * MSLOT + slot) * DM;
#pragma unroll
                    for (int i = 0; i < 8; ++i) { const u32x2 w = *(const u32x2*)(yr + i * 256 + lane * 4);
                        cacc[i * 4] += bflo(w[0]); cacc[i * 4 + 1] += bfhi(w[0]); cacc[i * 4 + 2] += bflo(w[1]); cacc[i * 4 + 3] += bfhi(w[1]); }
                }
            }
            const float* gf = mrow + 10240;
#pragma unroll
            for (int i = 0; i < 8; ++i) { const f32x4 g = *(const f32x4*)(gf + i * 256 + lane * 4);
                v[i * 4] += g[0] * cacc[i * 4]; v[i * 4 + 1] += g[1] * cacc[i * 4 + 1]; v[i * 4 + 2] += g[2] * cacc[i * 4 + 2]; v[i * 4 + 3] += g[3] * cacc[i * 4 + 3]; }
            if (MODE == 2) {
#pragma unroll
                for (int i = 0; i < 8; ++i) *(f32x4*)(xres + (size_t)row * DM + i * 256 + lane * 4) = (f32x4){v[i * 4], v[i * 4 + 1], v[i * 4 + 2], v[i * 4 + 3]};
            }
        }
        float ss = 0.f;
#pragma unroll
        for (int i = 0; i < 32; ++i) ss += v[i] * v[i];
        ss = wave_sum(ss);
        const float rstd = rsqrtf(ss * (1.f / DM) + EPS);
        if (MODE == 3) {
#pragma unroll
            for (int i = 0; i < 8; ++i) { const f32x4 g = *(const f32x4*)(p.final_norm + i * 256 + lane * 4);
                __builtin_nontemporal_store((f32x4){v[i * 4] * rstd * g[0], v[i * 4 + 1] * rstd * g[1], v[i * 4 + 2] * rstd * g[2], v[i * 4 + 3] * rstd * g[3]}, (f32x4*)(p.out + (size_t)row * DM + i * 256 + lane * 4)); }
            continue;
        }
        const float* mr2 = (MODE == 2) ? mrow + (size_t)5 * 12288 : mrow;
        const float* sh = mr2 + ((MODE == 1) ? 6144 : 0);
        const float* sc = mr2 + ((MODE == 1) ? 8192 : 2048);
#pragma unroll
        for (int i = 0; i < 8; ++i) { const f32x4 a = *(const f32x4*)(sh + i * 256 + lane * 4); const f32x4 s = *(const f32x4*)(sc + i * 256 + lane * 4);
#pragma unroll
            for (int j = 0; j < 4; ++j) v[i * 4 + j] = v[i * 4 + j] * rstd * (1.f + s[j]) + a[j];
            if (MODE == 1) *(unsigned*)((unsigned char*)hbuf + (size_t)row * DM + i * 256 + lane * 4) = cvt4_fp8c(v[i * 4], v[i * 4 + 1], v[i * 4 + 2], v[i * 4 + 3]);
            else *(u32x2*)(hbuf + (size_t)row * DM + i * 256 + lane * 4) = (u32x2){cvt_pk(v[i * 4], v[i * 4 + 1]), cvt_pk(v[i * 4 + 2], v[i * 4 + 3])}; }
        if (MODE == 1) {
            float a[16];
#pragma unroll
            for (int e = 0; e < 16; ++e) { float t = 0.f;
#pragma unroll
                for (int i = 0; i < 8; ++i) { const f32x4 w = *(const f32x4*)(wT + e * 2048 + i * 256 + lane * 4);
                    t += v[i * 4] * w[0] + v[i * 4 + 1] * w[1] + v[i * 4 + 2] * w[2] + v[i * 4 + 3] * w[3]; }
                a[e] = t; if ((e & 3) == 3) __builtin_amdgcn_sched_barrier(0); }
            const bool b5 = (lane & 32) != 0, b4 = (lane & 16) != 0, b3 = (lane & 8) != 0, b2 = (lane & 4) != 0;
            float s8[8], s4[4], s2[2], s1;
#pragma unroll
            for (int i = 0; i < 8; ++i) { const float keep = b5 ? a[8 + i] : a[i], give = b5 ? a[i] : a[8 + i]; s8[i] = keep + __shfl_xor(give, 32); }
#pragma unroll
            for (int i = 0; i < 4; ++i) { const float keep = b4 ? s8[4 + i] : s8[i], give = b4 ? s8[i] : s8[4 + i]; s4[i] = keep + __shfl_xor(give, 16); }
#pragma unroll
            for (int i = 0; i < 2; ++i) { const float keep = b3 ? s4[2 + i] : s4[i], give = b3 ? s4[i] : s4[2 + i]; s2[i] = keep + __shfl_xor(give, 8); }
            { const float keep = b2 ? s2[1] : s2[0], give = b2 ? s2[0] : s2[1]; s1 = keep + __shfl_xor(give, 4); }
            s1 += __shfl_xor(s1, 2); s1 += __shfl_xor(s1, 1);
            float mx = s1;
#pragma unroll
            for (int off = 32; off >= 4; off >>= 1) mx = fmaxf(mx, __shfl_xor(mx, off));
            const float ex = expf(s1 - mx); float den = ex;
#pragma unroll
            for (int off = 32; off >= 4; off >>= 1) den += __shfl_xor(den, off);
            const int eidx = (b5 ? 8 : 0) + (b4 ? 4 : 0) + (b3 ? 2 : 0) + (b2 ? 1 : 0);
            if ((lane & 3) == 0) ((float*)(p.ws + WS_AFF))[((size_t)b * 16 + eidx) * KEYS + tok] = ex / den;
        }
    }
    if (MODE == 1) __syncthreads();
}

struct EpiWin { static constexpr bool PERM = true; bf16_t* P;
    DEVI void operator()(const f32x4 (&acc)[2][2][4][2], const pg8::Unit& u, int wr, int wc, int fr, int fq) const {
#pragma unroll
        for (int ai = 0; ai < 2; ++ai)
#pragma unroll
            for (int m = 0; m < 4; ++m) { const int row = u.pm * 256 + ai * 128 + wr * 64 + m * 16 + fr;
#pragma unroll
                for (int bj = 0; bj < 2; ++bj) { const int col = u.pn * 256 + bj * 128 + wc * 32 + 8 * fq;
                    if (col < INC) { const f32x4 a = acc[ai][bj][m][0], b = acc[ai][bj][m][1];
                        *(u32x4*)(P + (size_t)row * INC + col) = (u32x4){cvt_pk(a[0], a[1]), cvt_pk(a[2], a[3]), cvt_pk(b[0], b[1]), cvt_pk(b[2], b[3])}; } } }
    } };
DEVI void phase_win(const Params& p, int l, char* smem) {
    pg8::PlainSched S{(const bf16_t*)(p.ws + WS_H), (const bf16_t*)(p.ws + WS_WIN) + (size_t)l * INCP * 2048, DM, 0, 2048, 36, 18, 36 * 18};
    pg8::gemm_phase((LAS unsigned char*)smem, 2048, S, EpiWin{(bf16_t*)(p.ws + WS_P)});
    if (l == 0) tail_convert(p, 0, TAIL_WIN_B0, 0, TAILT_WIN, smem); else tail_convert(p, 1, TAIL_WIN_B0, T1A, TAILT_WIN, smem);
}

DEVI float log_sigmoid_f(float x) { return fminf(x, 0.f) - __logf(1.f + __expf(-fabsf(x))); }
DEVI bf16x8 ldfrag(const bf16_t* base, int ld, int row0, int k0, int fr, int fq) { return *(const bf16x8*)(base + (row0 + fr) * ld + k0 + fq * 8); }
DEVI int chunk_row0(int b, int c) { return (c < 4) ? (NLAT + b * CL + c * 64) : (b * SEQ + (c - 4) * 64); }
DEVI int order_idx(int dir, int c) { return dir == 0 ? c : ((c < 4) ? (3 - c) : (4 + 35 - c)); }

struct GlaIn { bf16x8 q, k, v0, v1, g0, g1, z0, z1, z2, z3, bw; float bias; };
DEVI void gla_load(const Params& p, int l, int b, int h, int c, bool need_qg, GlaIn& in) {
    const bf16_t* P = (const bf16_t*)(p.ws + WS_P);
    const int tid = opaque_tid(), wid = tid >> 6, lane = tid & 63, fr = lane & 15, fq = lane >> 4, d = wid >> 2, kf = wid & 3, kk = kf * 16 + fr;
    const int row0 = chunk_row0(b, c), tk = tid >> 3, c8 = (tid & 7) * 8;
    in.k = *(const bf16x8*)(P + (size_t)(row0 + tk) * INC + C_GK + h * 64 + c8);
    in.v0 = *(const bf16x8*)(P + (size_t)(row0 + tk) * INC + C_GV + h * 128 + c8);
    in.v1 = *(const bf16x8*)(P + (size_t)(row0 + tk) * INC + C_GV + h * 128 + 64 + c8);
    if (need_qg) {
        in.q = *(const bf16x8*)(P + (size_t)(row0 + tk) * INC + C_GQ + h * 64 + c8);
        in.g0 = *(const bf16x8*)(P + (size_t)(row0 + tk) * INC + C_GOG + h * 128 + (tid & 7) * 16);
        in.g1 = *(const bf16x8*)(P + (size_t)(row0 + tk) * INC + C_GOG + h * 128 + (tid & 7) * 16 + 8);
    }
    const bf16x8 zero = {0, 0, 0, 0, 0, 0, 0, 0};
    in.z0 = zero; in.z1 = zero; in.z2 = zero; in.z3 = zero; in.bw = zero;
    if (fq < 2) {
        const bf16_t* zp = P + (size_t)(row0 + fr) * INC + C_GZ + d * 16 + fq * 8;
        in.z0 = *(const bf16x8*)(zp); in.z1 = *(const bf16x8*)(zp + (size_t)16 * INC); in.z2 = *(const bf16x8*)(zp + (size_t)32 * INC); in.z3 = *(const bf16x8*)(zp + (size_t)48 * INC);
        float wv[8];
#pragma unroll
        for (int j = 0; j < 8; ++j) wv[j] = p.gla_w2[((size_t)(l * 2 + d) * 16 + fq * 8 + j) * 256 + h * 64 + kk];
        in.bw = pack8(wv);
    }
    in.bias = p.gla_b[(size_t)(l * 2 + d) * 256 + h * 64 + kk];
}
DEVI void gla_cum(const GlaIn& in, float* cum) {
    const int tid = opaque_tid(), wid = tid >> 6, lane = tid & 63, fr = lane & 15, fq = lane >> 4, d = wid >> 2, kf = wid & 3;
    const int kk = kf * 16 + fr;
    float la[4][4];
#pragma unroll
    for (int f = 0; f < 4; ++f) {
        const bf16x8 az = (f == 0) ? in.z0 : (f == 1) ? in.z1 : (f == 2) ? in.z2 : in.z3;
        f32x4 acc = {0.f, 0.f, 0.f, 0.f};
        acc = __builtin_amdgcn_mfma_f32_16x16x32_bf16(az, in.bw, acc, 0, 0, 0);
#pragma unroll
        for (int r = 0; r < 4; ++r) la[f][r] = log_sigmoid_f(acc[r] + in.bias) * (1.f / 16.f);
    }
    if (d == 0) {
        float carry = 0.f;
#pragma unroll
        for (int f = 0; f < 4; ++f) {
            la[f][1] += la[f][0]; la[f][2] += la[f][1]; la[f][3] += la[f][2];
            float x = la[f][3]; const float own = x;
            float y = __shfl_up(x, 16); if (fq >= 1) x += y;
            y = __shfl_up(x, 32); if (fq >= 2) x += y;
            const float excl = x - own + carry;
            carry += __shfl(x, 48 + fr);
#pragma unroll
            for (int r = 0; r < 4; ++r) la[f][r] += excl;
        }
    } else {
        float carry = 0.f;
#pragma unroll
        for (int f = 3; f >= 0; --f) {
            la[f][2] += la[f][3]; la[f][1] += la[f][2]; la[f][0] += la[f][1];
            float x = la[f][0]; const float own = x;
            float y = __shfl_down(x, 16); if (fq <= 2) x += y;
            y = __shfl_down(x, 32); if (fq <= 1) x += y;
            const float excl = x - own + carry;
            carry += __shfl(x, fr);
#pragma unroll
            for (int r = 0; r < 4; ++r) la[f][r] += excl;
        }
    }
#pragma unroll
    for (int f = 0; f < 4; ++f)
#pragma unroll
        for (int r = 0; r < 4; ++r) cum[(d * 64 + f * 16 + fq * 4 + r) * 64 + kk] = la[f][r];
    __syncthreads();
}

DEVI void scan_a_gla(const Params& p, int l, int b, int h, int c, const GlaIn& in, char* smem) {
    float* cum = (float*)(smem + 18432);
    bf16_t* kTf = (bf16_t*)(smem + 51200); bf16_t* kTb = kTf + 64 * 72; bf16_t* vT = kTb + 64 * 72;
    const int tid = opaque_tid(), wid = tid >> 6, lane = tid & 63, fr = lane & 15, fq = lane >> 4;
    const int tk = tid >> 3, c8 = (tid & 7) * 8;
    const bf16x8 kreg = in.k, v0 = in.v0, v1 = in.v1;
    gla_cum(in, cum);
    {   float kf[8]; unpack8(kreg, kf);
#pragma unroll
        for (int e = 0; e < 8; ++e) { const int kk = c8 + e;
            kTf[kk * 72 + tk] = f2bf(kf[e] * __expf(cum[(0 * 64 + 63) * 64 + kk] - cum[(0 * 64 + tk) * 64 + kk]));
            kTb[kk * 72 + tk] = f2bf(kf[e] * __expf(cum[(1 * 64 + 0) * 64 + kk] - cum[(1 * 64 + tk) * 64 + kk])); }
#pragma unroll
        for (int e = 0; e < 8; ++e) { vT[(c8 + e) * 72 + tk] = (bf16_t)v0[e]; vT[(64 + c8 + e) * 72 + tk] = (bf16_t)v1[e]; }
    }
    if (tid < 128) { const int d = tid >> 6, kk = tid & 63;
        ((float*)(p.ws + WS_DECG))[((size_t)((b * 4 + h) * 2 + d) * NCH + order_idx(d, c)) * 64 + kk] = __expf(d == 0 ? cum[(0 * 64 + 63) * 64 + kk] : cum[(1 * 64 + 0) * 64 + kk]); }
    __syncthreads();
    {   const int dir = wid >> 2, kkf = wid & 3;
        const bf16_t* kT = dir ? kTb : kTf;
        const bf16x8 a0 = ldfrag(kT, 72, kkf * 16, 0, fr, fq), a1 = ldfrag(kT, 72, kkf * 16, 32, fr, fq);
        bf16_t* UT = (bf16_t*)(p.ws + WS_UTG) + ((size_t)((b * 4 + h) * 2 + dir) * NCH + order_idx(dir, c)) * (128 * 64);
#pragma unroll
        for (int vf = 0; vf < 8; ++vf) {
            f32x4 acc = {0.f, 0.f, 0.f, 0.f};
            acc = __builtin_amdgcn_mfma_f32_16x16x32_bf16(a0, ldfrag(vT, 72, vf * 16, 0, fr, fq), acc, 0, 0, 0);
            acc = __builtin_amdgcn_mfma_f32_16x16x32_bf16(a1, ldfrag(vT, 72, vf * 16, 32, fr, fq), acc, 0, 0, 0);
            *(u32x2*)(UT + (vf * 16 + fr) * 64 + kkf * 16 + fq * 4) = (u32x2){cvt_pk(acc[0], acc[1]), cvt_pk(acc[2], acc[3])};
        }
    }
    __syncthreads();
}

DEVI void ret_decays(int h, float& ldf, float& ldb) { ldf = log1pf(-exp2f(-(5.f + 2.f * h))); ldb = log1pf(-exp2f(-(6.f + 2.f * h))); }

struct RetIn { bf16x8 q0, q1, k0, k1, v0, v1, g0, g1; f32x4 cs0, cs1, cs2, cs3; };
DEVI void ret_load(const Params& p, int b, int h, int c, bool need_qg, RetIn& in) {
    const bf16_t* P = (const bf16_t*)(p.ws + WS_P);
    const float* rret = (const float*)(p.ws + WS_RRET);
    const int tid = opaque_tid(), tk = tid >> 3, kk16 = (tid & 7) * 16;
    const size_t rb = (size_t)(chunk_row0(b, c) + tk) * INC;
    in.k0 = *(const bf16x8*)(P + rb + C_RK + h * 128 + kk16); in.k1 = *(const bf16x8*)(P + rb + C_RK + h * 128 + kk16 + 8);
    in.v0 = *(const bf16x8*)(P + rb + C_RV + h * 128 + kk16); in.v1 = *(const bf16x8*)(P + rb + C_RV + h * 128 + kk16 + 8);
    if (need_qg) {
        in.q0 = *(const bf16x8*)(P + rb + C_RQ + h * 128 + kk16); in.q1 = *(const bf16x8*)(P + rb + C_RQ + h * 128 + kk16 + 8);
        in.g0 = *(const bf16x8*)(P + rb + C_RG + h * 128 + kk16); in.g1 = *(const bf16x8*)(P + rb + C_RG + h * 128 + kk16 + 8);
    }
    if (c >= 4) { const float* tb = rret + ((size_t)((c - 4) * 64 + tk) * 64 + (kk16 >> 1)) * 2;
        in.cs0 = *(const f32x4*)(tb); in.cs1 = *(const f32x4*)(tb + 4); in.cs2 = *(const f32x4*)(tb + 8); in.cs3 = *(const f32x4*)(tb + 12); }
}
DEVI void ret_rot(const bf16x8 r0, const bf16x8 r1, const RetIn& in, bool lat, float scale, float (&o)[16]) {
    float a[8], c[8]; unpack8(r0, a); unpack8(r1, c);
#pragma unroll
    for (int i = 0; i < 8; ++i) { o[i] = a[i]; o[8 + i] = c[i]; }
    if (lat) {
#pragma unroll
        for (int q = 0; q < 4; ++q) { const f32x4 cs = (q == 0) ? in.cs0 : (q == 1) ? in.cs1 : (q == 2) ? in.cs2 : in.cs3;
            const float x1 = o[4 * q], x2 = o[4 * q + 1], y1 = o[4 * q + 2], y2 = o[4 * q + 3];
            o[4 * q] = x1 * cs[0] - x2 * cs[1]; o[4 * q + 1] = x1 * cs[1] + x2 * cs[0];
            o[4 * q + 2] = y1 * cs[2] - y2 * cs[3]; o[4 * q + 3] = y1 * cs[3] + y2 * cs[2]; }
    }
#pragma unroll
    for (int i = 0; i < 16; ++i) o[i] *= scale;
}

DEVI void scan_a_ret(const Params& p, int l, int b, int h, int c, const RetIn& in, char* smem) {
    bf16_t* kTf = (bf16_t*)smem; bf16_t* kTb = kTf + 128 * 72; bf16_t* vT = kTb + 128 * 72;
    const int tid = opaque_tid(), wid = tid >> 6, lane = tid & 63, fr = lane & 15, fq = lane >> 4;
    const bool lat = c >= 4;
    const int tk = tid >> 3, kk16 = (tid & 7) * 16;
    float ldf, ldb; ret_decays(h, ldf, ldb);
    float kf[16];
    ret_rot(in.k0, in.k1, in, lat, 0.08838834764831845f, kf);
    const float ef = __expf(ldf * (float)(63 - tk)), eb = __expf(ldb * (float)tk);
#pragma unroll
    for (int e = 0; e < 16; ++e) { kTf[(kk16 + e) * 72 + tk] = f2bf(kf[e] * ef); kTb[(kk16 + e) * 72 + tk] = f2bf(kf[e] * eb); }
    {   const bf16x8 v0 = in.v0, v1 = in.v1;
#pragma unroll
        for (int e = 0; e < 8; ++e) { vT[(kk16 + e) * 72 + tk] = (bf16_t)v0[e]; vT[(kk16 + 8 + e) * 72 + tk] = (bf16_t)v1[e]; } }
    __syncthreads();
    {   const int dir = wid >> 2;
        const bf16_t* kT = dir ? kTb : kTf;
        bf16_t* UT = (bf16_t*)(p.ws + WS_UTR) + ((size_t)((b * 4 + h) * 2 + dir) * NCH + order_idx(dir, c)) * (128 * 128);
#pragma unroll
        for (int q = 0; q < 2; ++q) { const int kkf = (wid & 3) * 2 + q;
            const bf16x8 a0 = ldfrag(kT, 72, kkf * 16, 0, fr, fq), a1 = ldfrag(kT, 72, kkf * 16, 32, fr, fq);
#pragma unroll
            for (int vf = 0; vf < 8; ++vf) {
                f32x4 acc = {0.f, 0.f, 0.f, 0.f};
                acc = __builtin_amdgcn_mfma_f32_16x16x32_bf16(a0, ldfrag(vT, 72, vf * 16, 0, fr, fq), acc, 0, 0, 0);
                acc = __builtin_amdgcn_mfma_f32_16x16x32_bf16(a1, ldfrag(vT, 72, vf * 16, 32, fr, fq), acc, 0, 0, 0);
                *(u32x2*)(UT + (vf * 16 + fr) * 128 + kkf * 16 + fq * 4) = (u32x2){cvt_pk(acc[0], acc[1]), cvt_pk(acc[2], acc[3])};
            } }
    }
    __syncthreads();
}

DEVI void phase_prefix(const Params& p, char* smem) {
    const int NT_G = 32 * 2048, NT_R = 32 * 4096;
    for (int g = obid() * 512 + threadIdx.x; g < NT_G + NT_R; g += gridDim.x * 512) {
        if (g < NT_G) {
            const int seq = g >> 11, e4 = (g & 2047) * 4, kk = e4 & 63;
            const bf16_t* U = (const bf16_t*)(p.ws + WS_UTG) + (size_t)seq * NCH * 8192 + e4;
            bf16_t* S = (bf16_t*)(p.ws + WS_STG) + (size_t)seq * NCH * 8192 + e4;
            const float* dec = (const float*)(p.ws + WS_DECG) + (size_t)seq * NCH * 64 + kk;
            f32x4 st = {0.f, 0.f, 0.f, 0.f};
#pragma unroll 12
            for (int o = 0; o < NCH; ++o) {
                const u32x2 uw = *(const u32x2*)(U + (size_t)o * 8192); const f32x4 u = {bflo(uw[0]), bfhi(uw[0]), bflo(uw[1]), bfhi(uw[1])}; const f32x4 dd = *(const f32x4*)(dec + o * 64);
                *(u32x2*)(S + (size_t)o * 8192) = (u32x2){cvt_pk(st[0], st[1]), cvt_pk(st[2], st[3])};
                st = dd * st + u;
            }
        } else {
            const int g2 = g - NT_G, seq = g2 >> 12, e4 = (g2 & 4095) * 4;
            const int h = (seq >> 1) & 3, dir = seq & 1;
            float ldf, ldb; ret_decays(h, ldf, ldb);
            const float dd = __expf(64.f * (dir ? ldb : ldf));
            const bf16_t* U = (const bf16_t*)(p.ws + WS_UTR) + (size_t)seq * NCH * 16384 + e4;
            bf16_t* S = (bf16_t*)(p.ws + WS_STR) + (size_t)seq * NCH * 16384 + e4;
            f32x4 st = {0.f, 0.f, 0.f, 0.f};
#pragma unroll 12
            for (int o = 0; o < NCH; ++o) {
                const u32x2 uw = *(const u32x2*)(U + (size_t)o * 16384); const f32x4 u = {bflo(uw[0]), bfhi(uw[0]), bflo(uw[1]), bfhi(uw[1])};
                *(u32x2*)(S + (size_t)o * 16384) = (u32x2){cvt_pk(st[0], st[1]), cvt_pk(st[2], st[3])};
                st = dd * st + u;
            }
        }
    }
}

DEVI void scan_c_tail(const float* o, int tid, const bf16x8 g0, const bf16x8 g1, int row0, bf16_t* ymix, int ycol) {
    const int tk = tid >> 3, v16 = (tid & 7) * 16;
    float ov[16]; float ss = 0.f;
#pragma unroll
    for (int q = 0; q < 4; ++q) { const f32x4 t = *(const f32x4*)(o + tk * 128 + v16 + q * 4); ov[q * 4] = t[0]; ov[q * 4 + 1] = t[1]; ov[q * 4 + 2] = t[2]; ov[q * 4 + 3] = t[3]; }
#pragma unroll
    for (int i = 0; i < 16; ++i) ss += ov[i] * ov[i];
    ss += __shfl_xor(ss, 1); ss += __shfl_xor(ss, 2); ss += __shfl_xor(ss, 4);
    const float rstd = rsqrtf(ss * (1.f / 128.f) + EPS);
    float ga[8], gb[8]; unpack8(g0, ga); unpack8(g1, gb);
    float y0[8], y1[8];
#pragma unroll
    for (int i = 0; i < 8; ++i) { y0[i] = ov[i] * rstd * silu_f(ga[i]); y1[i] = ov[8 + i] * rstd * silu_f(gb[i]); }
    *(bf16x8*)(ymix + (size_t)(row0 + tk) * DM + ycol + v16) = pack8(y0);
    *(bf16x8*)(ymix + (size_t)(row0 + tk) * DM + ycol + v16 + 8) = pack8(y1);
}

DEVI void scan_c_gla(const Params& p, int l, int b, int h, int c, const GlaIn& in, char* smem) {
    float* cum = (float*)(smem + 18432);
    float* obuf = cum;
    bf16_t* qdf = (bf16_t*)(smem + 51200); bf16_t* qdb = qdf + 64 * 72; bf16_t* kif = qdb + 64 * 72; bf16_t* kib = kif + 64 * 72;
    bf16_t* vT = kib + 64 * 72; bf16_t* att = vT + 128 * 72;
    const int tid = opaque_tid(), wid = tid >> 6, lane = tid & 63, fr = lane & 15, fq = lane >> 4;
    const int row0 = chunk_row0(b, c);
    const int tk = tid >> 3, c8 = (tid & 7) * 8;
    const bf16x8 qreg = in.q, kreg = in.k, v0 = in.v0, v1 = in.v1, gt0 = in.g0, gt1 = in.g1;
    const bf16_t* SF = (const bf16_t*)(p.ws + WS_STG) + ((size_t)((b * 4 + h) * 2 + 0) * NCH + order_idx(0, c)) * 8192;
    const bf16_t* SB = (const bf16_t*)(p.ws + WS_STG) + ((size_t)((b * 4 + h) * 2 + 1) * NCH + order_idx(1, c)) * 8192;
    const bf16x8 sf0 = *(const bf16x8*)(SF + (wid * 16 + fr) * 64 + fq * 8), sf1 = *(const bf16x8*)(SF + (wid * 16 + fr) * 64 + 32 + fq * 8);
    const bf16x8 sb0 = *(const bf16x8*)(SB + (wid * 16 + fr) * 64 + fq * 8), sb1 = *(const bf16x8*)(SB + (wid * 16 + fr) * 64 + 32 + fq * 8);
    gla_cum(in, cum);
    {   float qf[8], kf[8]; unpack8(qreg, qf); unpack8(kreg, kf);
        float a[8], bq[8], cc[8], dq[8];
#pragma unroll
        for (int e = 0; e < 8; ++e) { const float cf = cum[(0 * 64 + tk) * 64 + c8 + e], cb = cum[(1 * 64 + tk) * 64 + c8 + e];
            a[e] = qf[e] * 0.125f * __expf(cf); bq[e] = qf[e] * 0.125f * __expf(cb); cc[e] = kf[e] * __expf(-cf); dq[e] = kf[e] * __expf(-cb); }
        *(bf16x8*)(qdf + tk * 72 + c8) = pack8(a); *(bf16x8*)(qdb + tk * 72 + c8) = pack8(bq);
        *(bf16x8*)(kif + tk * 72 + c8) = pack8(cc); *(bf16x8*)(kib + tk * 72 + c8) = pack8(dq);
#pragma unroll
        for (int e = 0; e < 8; ++e) { vT[(c8 + e) * 72 + tk] = (bf16_t)v0[e]; vT[(64 + c8 + e) * 72 + tk] = (bf16_t)v1[e]; }
    }
    __syncthreads();
    {
        const int jf = wid & 3;
#pragma unroll
        for (int q = 0; q < 2; ++q) { const int iff = (wid >> 2) * 2 + q;
            f32x4 af = {0.f, 0.f, 0.f, 0.f}, ab = {0.f, 0.f, 0.f, 0.f};
            if (iff >= jf) {
                af = __builtin_amdgcn_mfma_f32_16x16x32_bf16(ldfrag(kif, 72, jf * 16, 0, fr, fq), ldfrag(qdf, 72, iff * 16, 0, fr, fq), af, 0, 0, 0);
                af = __builtin_amdgcn_mfma_f32_16x16x32_bf16(ldfrag(kif, 72, jf * 16, 32, fr, fq), ldfrag(qdf, 72, iff * 16, 32, fr, fq), af, 0, 0, 0); }
            if (iff <= jf) {
                ab = __builtin_amdgcn_mfma_f32_16x16x32_bf16(ldfrag(kib, 72, jf * 16, 0, fr, fq), ldfrag(qdb, 72, iff * 16, 0, fr, fq), ab, 0, 0, 0);
                ab = __builtin_amdgcn_mfma_f32_16x16x32_bf16(ldfrag(kib, 72, jf * 16, 32, fr, fq), ldfrag(qdb, 72, iff * 16, 32, fr, fq), ab, 0, 0, 0); }
            const int i = iff * 16 + fr, j0 = jf * 16 + fq * 4;
            float r[4];
#pragma unroll
            for (int e = 0; e < 4; ++e) r[e] = (j0 + e <= i) ? af[e] : ab[e];
            *(u32x2*)(att + i * 72 + j0) = (u32x2){cvt_pk(r[0], r[1]), cvt_pk(r[2], r[3])};
        }
    }
    __syncthreads();
    {   const int vf = wid;
        const bf16x8 vt0 = ldfrag(vT, 72, vf * 16, 0, fr, fq), vt1 = ldfrag(vT, 72, vf * 16, 32, fr, fq);
#pragma unroll
        for (int iff = 0; iff < 4; ++iff) {
            f32x4 acc = {0.f, 0.f, 0.f, 0.f};
            acc = __builtin_amdgcn_mfma_f32_16x16x32_bf16(vt0, ldfrag(att, 72, iff * 16, 0, fr, fq), acc, 0, 0, 0);
            acc = __builtin_amdgcn_mfma_f32_16x16x32_bf16(vt1, ldfrag(att, 72, iff * 16, 32, fr, fq), acc, 0, 0, 0);
            acc = __builtin_amdgcn_mfma_f32_16x16x32_bf16(sf0, ldfrag(qdf, 72, iff * 16, 0, fr, fq), acc, 0, 0, 0);
            acc = __builtin_amdgcn_mfma_f32_16x16x32_bf16(sf1, ldfrag(qdf, 72, iff * 16, 32, fr, fq), acc, 0, 0, 0);
            acc = __builtin_amdgcn_mfma_f32_16x16x32_bf16(sb0, ldfrag(qdb, 72, iff * 16, 0, fr, fq), acc, 0, 0, 0);
            acc = __builtin_amdgcn_mfma_f32_16x16x32_bf16(sb1, ldfrag(qdb, 72, iff * 16, 32, fr, fq), acc, 0, 0, 0);
            *(f32x4*)(obuf + (iff * 16 + fr) * 128 + vf * 16 + fq * 4) = acc;
        }
    }
    __syncthreads();
    scan_c_tail(obuf, tid, gt0, gt1, row0, (bf16_t*)(p.ws + WS_YMIX), 1024 + h * 128);
    __syncthreads();
}

DEVI void scan_c_ret(const Params& p, int l, int b, int h, int c, const RetIn& in, char* smem) {
    float* obuf = (float*)smem;
    bf16_t* qs = (bf16_t*)(smem + 32768); bf16_t* ks = qs + 64 * 136; bf16_t* vT = ks + 64 * 136; bf16_t* att = vT + 128 * 72;
    const int tid = opaque_tid(), wid = tid >> 6, lane = tid & 63, fr = lane & 15, fq = lane >> 4;
    const int row0 = chunk_row0(b, c); const bool lat = c >= 4;
    const int tk = tid >> 3, kk16 = (tid & 7) * 16;
    float ldf, ldb; ret_decays(h, ldf, ldb);
    const bf16x8 gt0 = in.g0, gt1 = in.g1;
    const bf16_t* SF = (const bf16_t*)(p.ws + WS_STR) + ((size_t)((b * 4 + h) * 2 + 0) * NCH + order_idx(0, c)) * 16384;
    const bf16_t* SB = (const bf16_t*)(p.ws + WS_STR) + ((size_t)((b * 4 + h) * 2 + 1) * NCH + order_idx(1, c)) * 16384;
    bf16x8 sff[4], sbf[4];
#pragma unroll
    for (int ksx = 0; ksx < 4; ++ksx) { sff[ksx] = *(const bf16x8*)(SF + (wid * 16 + fr) * 128 + ksx * 32 + fq * 8); sbf[ksx] = *(const bf16x8*)(SB + (wid * 16 + fr) * 128 + ksx * 32 + fq * 8); }
    {   float qf[16], kf[16];
        ret_rot(in.q0, in.q1, in, lat, 1.f, qf);
        ret_rot(in.k0, in.k1, in, lat, 0.08838834764831845f, kf);
        float t0[8], t1[8];
#pragma unroll
        for (int e = 0; e < 8; ++e) { t0[e] = qf[e]; t1[e] = qf[8 + e]; }
        *(bf16x8*)(qs + tk * 136 + kk16) = pack8(t0); *(bf16x8*)(qs + tk * 136 + kk16 + 8) = pack8(t1);
#pragma unroll
        for (int e = 0; e < 8; ++e) { t0[e] = kf[e]; t1[e] = kf[8 + e]; }
        *(bf16x8*)(ks + tk * 136 + kk16) = pack8(t0); *(bf16x8*)(ks + tk * 136 + kk16 + 8) = pack8(t1);
        const bf16x8 v0 = in.v0, v1 = in.v1;
#pragma unroll
        for (int e = 0; e < 8; ++e) { vT[(kk16 + e) * 72 + tk] = (bf16_t)v0[e]; vT[(kk16 + 8 + e) * 72 + tk] = (bf16_t)v1[e]; }
    }
    __syncthreads();
    {   const int jf = wid & 3;
#pragma unroll
        for (int q = 0; q < 2; ++q) { const int iff = (wid >> 2) * 2 + q;
            f32x4 a = {0.f, 0.f, 0.f, 0.f};
#pragma unroll
            for (int ksx = 0; ksx < 4; ++ksx) a = __builtin_amdgcn_mfma_f32_16x16x32_bf16(ldfrag(ks, 136, jf * 16, ksx * 32, fr, fq), ldfrag(qs, 136, iff * 16, ksx * 32, fr, fq), a, 0, 0, 0);
            const int i = iff * 16 + fr, j0 = jf * 16 + fq * 4;
            float r[4];
#pragma unroll
            for (int e = 0; e < 4; ++e) { const int j = j0 + e; r[e] = a[e] * ((j <= i) ? __expf(ldf * (float)(i - j)) : __expf(ldb * (float)(j - i))); }
            *(u32x2*)(att + i * 72 + j0) = (u32x2){cvt_pk(r[0], r[1]), cvt_pk(r[2], r[3])};
        }
    }
    __syncthreads();
    {   const int vf = wid;
        const bf16x8 vt0 = ldfrag(vT, 72, vf * 16, 0, fr, fq), vt1 = ldfrag(vT, 72, vf * 16, 32, fr, fq);
#pragma unroll
        for (int iff = 0; iff < 4; ++iff) {
            const int i = iff * 16 + fr;
            const float sf = __expf(ldf * (float)(i + 1)), sb = __expf(ldb * (float)(64 - i));
            f32x4 acc = {0.f, 0.f, 0.f, 0.f}, accf = {0.f, 0.f, 0.f, 0.f}, accb = {0.f, 0.f, 0.f, 0.f};
            acc = __builtin_amdgcn_mfma_f32_16x16x32_bf16(vt0, ldfrag(att, 72, iff * 16, 0, fr, fq), acc, 0, 0, 0);
            acc = __builtin_amdgcn_mfma_f32_16x16x32_bf16(vt1, ldfrag(att, 72, iff * 16, 32, fr, fq), acc, 0, 0, 0);
#pragma unroll
            for (int ksx = 0; ksx < 4; ++ksx) { const bf16x8 qv = ldfrag(qs, 136, iff * 16, ksx * 32, fr, fq);
                accf = __builtin_amdgcn_mfma_f32_16x16x32_bf16(sff[ksx], qv, accf, 0, 0, 0);
                accb = __builtin_amdgcn_mfma_f32_16x16x32_bf16(sbf[ksx], qv, accb, 0, 0, 0); }
            *(f32x4*)(obuf + i * 128 + vf * 16 + fq * 4) = acc + sf * accf + sb * accb;
        }
    }
    __syncthreads();
    scan_c_tail(obuf, tid, gt0, gt1, row0, (bf16_t*)(p.ws + WS_YMIX), 1536 + h * 128);
    __syncthreads();
}

namespace att {
constexpr int DQ = 192, DV = 128, NW = 8, QBLK = 32, KVBLK = 64;
constexpr int SHM_V = KVBLK * DV * 2, SHM_K = KVBLK * 400;
constexpr float THR = 8.f;
#define KSWZ(row, colB) ((row) * 400 + (colB))
#define SBAR() __builtin_amdgcn_sched_barrier(0)
DEVI int crow(int r, int hi) { return (r & 3) + 8 * (r >> 2) + 4 * hi; }
DEVI unsigned cvtpk(float lo, float hi) { unsigned r; asm volatile("v_cvt_pk_bf16_f32 %0, %1, %2" : "=v"(r) : "v"(lo), "v"(hi)); return r; }
DEVI void partialSM(f32x16& p0, f32x16& p1, float& m_reg, float& mn, float& alpha) {
    constexpr float C = 1.4426950408889634f;
    float pmax = p0[0];
#pragma unroll
    for (int r = 1; r < 16; ++r) pmax = fmaxf(pmax, p0[r]);
#pragma unroll
    for (int r = 0; r < 16; ++r) pmax = fmaxf(pmax, p1[r]);
    { auto rr = __builtin_amdgcn_permlane32_swap(__float_as_uint(pmax), __float_as_uint(pmax), false, false);
      pmax = fmaxf(__uint_as_float(rr[0]), __uint_as_float(rr[1])); }
    if (__builtin_expect(__all(pmax - m_reg <= THR), 1)) { mn = m_reg; alpha = 1.f; }
    else { mn = fmaxf(m_reg, pmax); alpha = __builtin_amdgcn_exp2f((m_reg - mn) * C); m_reg = mn; }
    const float mnC = -mn * C;
#pragma unroll
    for (int r = 0; r < 16; ++r) p0[r] = fmaf(p0[r], C, mnC);
#pragma unroll
    for (int r = 0; r < 16; ++r) p1[r] = fmaf(p1[r], C, mnC);
#pragma unroll
    for (int r = 0; r < 16; ++r) p0[r] = __builtin_amdgcn_exp2f(p0[r]);
}
DEVI void finishSM(f32x16& p0, f32x16& p1, float alpha, float& l_reg, bf16x8& pa0, bf16x8& pa1, bf16x8& pa2, bf16x8& pa3) {
#pragma unroll
    for (int r = 0; r < 16; ++r) p1[r] = __builtin_amdgcn_exp2f(p1[r]);
    float ps = 0;
#pragma unroll
    for (int r = 0; r < 16; ++r) ps += p0[r];
#pragma unroll
    for (int r = 0; r < 16; ++r) ps += p1[r];
    { auto rr = __builtin_amdgcn_permlane32_swap(__float_as_uint(ps), __float_as_uint(ps), false, false);
      ps = __uint_as_float(rr[0]) + __uint_as_float(rr[1]); }
    l_reg = l_reg * alpha + ps;
#define PK4(P, BASE, OUT) do { unsigned a0 = cvtpk(P[BASE + 0], P[BASE + 1]), a1 = cvtpk(P[BASE + 2], P[BASE + 3]);   \
    unsigned b0 = cvtpk(P[BASE + 4], P[BASE + 5]), b1 = cvtpk(P[BASE + 6], P[BASE + 7]);                              \
    auto r0 = __builtin_amdgcn_permlane32_swap(a0, b0, false, false); auto r1 = __builtin_amdgcn_permlane32_swap(a1, b1, false, false); \
    u32x4 w = {r0[0], r1[0], r0[1], r1[1]}; OUT = __builtin_bit_cast(bf16x8, w); } while (0)
    PK4(p0, 0, pa0); PK4(p0, 8, pa1); PK4(p1, 0, pa2); PK4(p1, 8, pa3);
#undef PK4
}
DEVI void qkt(f32x16& p0, f32x16& p1, const char* Ks, const bf16x8* qr, const char* qL, int r32, int hi) {
    p0 = (f32x16){0.f, 0.f, 0.f, 0.f, 0.f, 0.f, 0.f, 0.f, 0.f, 0.f, 0.f, 0.f, 0.f, 0.f, 0.f, 0.f}; p1 = p0;
#pragma unroll
    for (int d0 = 0; d0 < 12; ++d0) { const int cb = (d0 * 16 + hi * 8) * 2;
        const bf16x8 b0 = *(const bf16x8*)(Ks + KSWZ(r32, cb));
        const bf16x8 b1 = *(const bf16x8*)(Ks + KSWZ(32 + r32, cb));
        const bf16x8 qv = (d0 < 8) ? qr[d0 < 8 ? d0 : 0] : *(const bf16x8*)(qL + (d0 - 8) * 1024);
        p0 = __builtin_amdgcn_mfma_f32_32x32x16_bf16(b0, qv, p0, 0, 0, 0);
        p1 = __builtin_amdgcn_mfma_f32_32x32x16_bf16(b1, qv, p1, 0, 0, 0); }
}
DEVI int v_st(int k, int c) { const int kk = (k & ~0xC) | ((k & 4) << 1) | ((k & 8) >> 1); return ((kk >> 3) * 4 + (c >> 5)) * 512 + ((kk & 7) * 32 + (c & 31)) * 2; }
DEVI int v_rd_base(int lane) { return ((lane & 3) << 3) | (((lane >> 2) & 3) << 6) | (((lane >> 4) & 1) << 5) | (((lane >> 5) & 1) << 8); }
constexpr int v_rd_off(int d0, int ks, int half) { return d0 * 512 + ks * 4096 + half * 2048; }
template <int OFF> DEVI s16x4 tr_read(int vb) { s16x4 r; asm volatile("ds_read_b64_tr_b16 %0, %1 offset:%2" : "=&v"(r) : "v"(vb), "i"(OFF) : "memory"); return r; }
template <int D0> DEVI void pv_one(f32x16& od, int vb, bf16x8 pa0, bf16x8 pa1, bf16x8 pa2, bf16x8 pa3) {
    const s16x4 l0 = tr_read<v_rd_off(D0, 0, 0)>(vb), h0 = tr_read<v_rd_off(D0, 0, 1)>(vb), l1 = tr_read<v_rd_off(D0, 1, 0)>(vb), h1 = tr_read<v_rd_off(D0, 1, 1)>(vb);
    const s16x4 l2 = tr_read<v_rd_off(D0, 2, 0)>(vb), h2 = tr_read<v_rd_off(D0, 2, 1)>(vb), l3 = tr_read<v_rd_off(D0, 3, 0)>(vb), h3 = tr_read<v_rd_off(D0, 3, 1)>(vb);
    asm volatile("s_waitcnt lgkmcnt(0)" ::: "memory"); SBAR();
#define PKV(L, H) (bf16x8){L[0], L[1], L[2], L[3], H[0], H[1], H[2], H[3]}
    od = __builtin_amdgcn_mfma_f32_32x32x16_bf16(pa0, PKV(l0, h0), od, 0, 0, 0);
    od = __builtin_amdgcn_mfma_f32_32x32x16_bf16(pa1, PKV(l1, h1), od, 0, 0, 0);
    od = __builtin_amdgcn_mfma_f32_32x32x16_bf16(pa2, PKV(l2, h2), od, 0, 0, 0);
    od = __builtin_amdgcn_mfma_f32_32x32x16_bf16(pa3, PKV(l3, h3), od, 0, 0, 0);
#undef PKV
}
DEVI void pv_d0(f32x16* o, int vb, bf16x8 pa0, bf16x8 pa1, bf16x8 pa2, bf16x8 pa3) {
    pv_one<0>(o[0], vb, pa0, pa1, pa2, pa3); pv_one<1>(o[1], vb, pa0, pa1, pa2, pa3); pv_one<2>(o[2], vb, pa0, pa1, pa2, pa3); pv_one<3>(o[3], vb, pa0, pa1, pa2, pa3);
}
DEVI void attn_body(const bf16_t* __restrict__ Qb, const bf16_t* __restrict__ Kh, const bf16_t* __restrict__ Vh, bf16_t* __restrict__ Ob, int seq, char* lds) {
    const int tid = opaque_tid(), wid = tid >> 6, lane = tid & 63, r32 = lane & 31, hi = lane >> 5;
    char* V_lds = lds; char* K_lds = lds + 2 * SHM_V;
    float* wsf = (float*)(lds + 2 * SHM_V + 2 * SHM_K) + wid * 64; float* li_l = wsf; float* al_l = wsf + 32;
    float m_reg = -1e30f, l_reg = 0;
    f32x16 o[4];
#pragma unroll
    for (int d = 0; d < 4; ++d) o[d] = (f32x16){0.f, 0.f, 0.f, 0.f, 0.f, 0.f, 0.f, 0.f, 0.f, 0.f, 0.f, 0.f, 0.f, 0.f, 0.f, 0.f};
    bf16x8 qr[8];
    const bf16_t* Qw = Qb + (size_t)(wid * QBLK + r32) * DQ + hi * 8;
    char* qL = lds + 2 * SHM_V + 2 * SHM_K + NW * 64 * 4 + wid * 4096 + lane * 16;
#pragma unroll
    for (int d0 = 0; d0 < 8; ++d0) qr[d0] = *(const bf16x8*)(Qw + d0 * 16);
#pragma unroll
    for (int d0 = 8; d0 < 12; ++d0) *(bf16x8*)(qL + (d0 - 8) * 1024) = *(const bf16x8*)(Qw + d0 * 16);
    const int sr = tid >> 4, sc = (tid & 15) * 8, vst0 = v_st(sr, sc), vst1 = v_st(32 + sr, sc);
    const int kr0 = tid / 24, kc0 = (tid % 24) * 8, kr1 = (tid + 512) / 24, kc1 = ((tid + 512) % 24) * 8, kr2 = (tid + 1024) / 24, kc2 = ((tid + 1024) % 24) * 8;
    const int kst0 = KSWZ(kr0, kc0 * 2), kst1 = KSWZ(kr1, kc1 * 2), kst2 = KSWZ(kr2, kc2 * 2);
    const int vb0 = (int)(uintptr_t)V_lds + v_rd_base(lane);
    bf16x8 sv0, sv1, sk0, sk1, sk2;
#define SLOAD(k0) do { sv0 = *(const bf16x8*)(Vh + (size_t)((k0) + sr) * DV + sc); sv1 = *(const bf16x8*)(Vh + (size_t)((k0) + 32 + sr) * DV + sc); \
    sk0 = *(const bf16x8*)(Kh + (size_t)((k0) + kr0) * DQ + kc0); sk1 = *(const bf16x8*)(Kh + (size_t)((k0) + kr1) * DQ + kc1); sk2 = *(const bf16x8*)(Kh + (size_t)((k0) + kr2) * DQ + kc2); } while (0)
#define SWRITE(b) do { *(bf16x8*)(V_lds + (b) * SHM_V + vst0) = sv0; *(bf16x8*)(V_lds + (b) * SHM_V + vst1) = sv1; \
    *(bf16x8*)(K_lds + (b) * SHM_K + kst0) = sk0; *(bf16x8*)(K_lds + (b) * SHM_K + kst1) = sk1; *(bf16x8*)(K_lds + (b) * SHM_K + kst2) = sk2; } while (0)
#define RESC(a) do { if (__any((a) < 1.f)) { if (hi == 0) al_l[r32] = (a); asm volatile("s_waitcnt lgkmcnt(0)" ::: "memory"); \
    _Pragma("unroll") for (int d = 0; d < 4; ++d) _Pragma("unroll") for (int r = 0; r < 16; ++r) o[d][r] *= al_l[crow(r, hi)]; } } while (0)
    f32x16 pA0, pA1, pB0, pB1; float mnA, mnB, alA, alB; bf16x8 pa0, pa1, pa2, pa3; const int NT = seq / KVBLK;
    SLOAD(0); SWRITE(0); __syncthreads();
    qkt(pA0, pA1, K_lds, qr, qL, r32, hi); partialSM(pA0, pA1, m_reg, mnA, alA);
    SLOAD(KVBLK); SWRITE(1); __syncthreads();
    for (int j = 1; j + 1 < NT; j += 2) {
        SBAR(); qkt(pB0, pB1, K_lds + SHM_K, qr, qL, r32, hi);
        finishSM(pA0, pA1, alA, l_reg, pa0, pa1, pa2, pa3); SBAR();
        SLOAD((j + 1) * KVBLK); SBAR();
        pv_d0(o, vb0, pa0, pa1, pa2, pa3); partialSM(pB0, pB1, m_reg, mnB, alB);
        __syncthreads(); SWRITE(0);
        RESC(alB); __syncthreads();
        SBAR(); qkt(pA0, pA1, K_lds, qr, qL, r32, hi);
        finishSM(pB0, pB1, alB, l_reg, pa0, pa1, pa2, pa3); SBAR();
        SLOAD((j + 2) * KVBLK); SBAR();
        pv_d0(o, vb0 + SHM_V, pa0, pa1, pa2, pa3); partialSM(pA0, pA1, m_reg, mnA, alA);
        __syncthreads(); SWRITE(1);
        RESC(alA); __syncthreads();
    }
    SBAR(); qkt(pB0, pB1, K_lds + SHM_K, qr, qL, r32, hi);
    finishSM(pA0, pA1, alA, l_reg, pa0, pa1, pa2, pa3); SBAR();
    pv_d0(o, vb0, pa0, pa1, pa2, pa3); partialSM(pB0, pB1, m_reg, mnB, alB);
    __syncthreads(); RESC(alB);
    finishSM(pB0, pB1, alB, l_reg, pa0, pa1, pa2, pa3); SBAR();
    pv_d0(o, vb0 + SHM_V, pa0, pa1, pa2, pa3);
    if (hi == 0) li_l[r32] = l_reg; asm volatile("s_waitcnt lgkmcnt(0)" ::: "memory");
    float rli[16];
#pragma unroll
    for (int r = 0; r < 16; ++r) rli[r] = __builtin_amdgcn_rcpf(li_l[crow(r, hi)]);
    bf16_t* Ow = Ob + (size_t)(wid * QBLK) * DM;
#pragma unroll
    for (int r = 0; r < 16; ++r) { const int orow = crow(r, hi);
#pragma unroll
        for (int d0 = 0; d0 < 4; ++d0) Ow[(size_t)orow * DM + d0 * 32 + r32] = f2bf(o[d0][r] * rli[r]); }
    __syncthreads();
#undef SLOAD
#undef SWRITE
#undef RESC
}
}

template <int WIDTH>
DEVI void rstd_table(const bf16_t* P, int row0, int col0, float* rs) {
    constexpr int hw = WIDTH >> 1;
    const int tid = opaque_tid(), r = tid >> 1, half = tid & 1;
    const bf16_t* src = P + (size_t)(row0 + r) * INC + col0 + half * hw;
    float ss = 0.f;
#pragma unroll
    for (int i0 = 0; i0 < hw; i0 += 128) {
        bf16x8 t[16];
#pragma unroll
        for (int i = 0; i < 16; ++i) t[i] = *(const bf16x8*)(src + i0 + i * 8);
#pragma unroll
        for (int i = 0; i < 16; ++i) { float f[8]; unpack8(t[i], f);
#pragma unroll
            for (int e = 0; e < 8; ++e) ss += f[e] * f[e]; }
    }
    ss += __shfl_xor(ss, 1);
    if (half == 0) rs[r] = rsqrtf(ss / (float)WIDTH + EPS);
    __syncthreads();
}
struct EpiQ { static constexpr bool PERM = true; bf16_t* Q; const float* rs; const float* rax;
    DEVI void operator()(const f32x4 (&acc)[2][2][4][2], const pg8::Unit& u, int wr, int wc, int fr, int fq) const {
#pragma unroll
        for (int ai = 0; ai < 2; ++ai)
#pragma unroll
            for (int m = 0; m < 4; ++m) { const int rl = ai * 128 + wr * 64 + m * 16 + fr, row = u.pm * 256 + rl; const float sc = rs[u.ord * 256 + rl] * QSCALE;
                const bool lat = row < NLAT; const int b = lat ? (row >> 11) : ((row - NLAT) >> 8); const int t = lat ? (row & 2047) : ((row - NLAT) & 255);
                const int qpos = lat ? (CL + t) : t;
#pragma unroll
                for (int bj = 0; bj < 2; ++bj) { const int col = u.pn * 256 + bj * 128 + wc * 32 + 8 * fq; const int head = col / 192, d = col - head * 192;
                    f32x4 v0 = acc[ai][bj][m][0] * sc, v1 = acc[ai][bj][m][1] * sc;
                    if (lat && d >= 128) { const int pi = (d - 128) >> 1; const int pos = (pi < 16) ? (t >> 6) : (t & 63);
                        const f32x4 c0 = *(const f32x4*)(rax + (pos * 16 + (pi & 15)) * 2), c1 = *(const f32x4*)(rax + (pos * 16 + (pi & 15)) * 2 + 4);
                        v0 = (f32x4){v0[0] * c0[0] - v0[1] * c0[1], v0[0] * c0[1] + v0[1] * c0[0], v0[2] * c0[2] - v0[3] * c0[3], v0[2] * c0[3] + v0[3] * c0[2]};
                        v1 = (f32x4){v1[0] * c1[0] - v1[1] * c1[1], v1[0] * c1[1] + v1[1] * c1[0], v1[2] * c1[2] - v1[3] * c1[3], v1[2] * c1[3] + v1[3] * c1[2]}; }
                    *(u32x4*)(Q + ((size_t)(b * 8 + head) * KEYS + qpos) * 192 + d) = (u32x4){cvt_pk(v0[0], v0[1]), cvt_pk(v0[2], v0[3]), cvt_pk(v1[0], v1[1]), cvt_pk(v1[2], v1[3])}; }
                __builtin_amdgcn_sched_barrier(0); }
    } };
struct EpiKV { static constexpr bool PERM = true; bf16_t* Kb; bf16_t* Vb; const float* rs;
    DEVI void operator()(const f32x4 (&acc)[2][2][4][2], const pg8::Unit& u, int wr, int wc, int fr, int fq) const {
#pragma unroll
        for (int ai = 0; ai < 2; ++ai)
#pragma unroll
            for (int m = 0; m < 4; ++m) { const int rl = ai * 128 + wr * 64 + m * 16 + fr, row = u.pm * 256 + rl; const float sc = rs[u.ord * 256 + rl];
                const bool lat = row < NLAT; const int b = lat ? (row >> 11) : ((row - NLAT) >> 8); const int t = lat ? (row & 2047) : ((row - NLAT) & 255);
                const int kpos = lat ? (CL + t) : t; const int d = wc * 32 + 8 * fq;
                { const f32x4 v0 = acc[ai][0][m][0] * sc, v1 = acc[ai][0][m][1] * sc;
                  *(u32x4*)(Kb + ((size_t)(b * 8 + u.pn) * KEYS + kpos) * 192 + d) = (u32x4){cvt_pk(v0[0], v0[1]), cvt_pk(v0[2], v0[3]), cvt_pk(v1[0], v1[1]), cvt_pk(v1[2], v1[3])}; }
                { const f32x4 v0 = acc[ai][1][m][0] * sc, v1 = acc[ai][1][m][1] * sc;
                  *(u32x4*)(Vb + ((size_t)(b * 8 + u.pn) * KEYS + kpos) * 128 + d) = (u32x4){cvt_pk(v0[0], v0[1]), cvt_pk(v0[2], v0[3]), cvt_pk(v1[0], v1[1]), cvt_pk(v1[2], v1[3])}; } }
    } };

DEVI void phase_l2(const Params& p, int l, char* smem) {
    const bf16_t* P = (const bf16_t*)(p.ws + WS_P);
    float* rsq = (float*)(smem + 131072); float* rskv = rsq + 4 * 256;
    const float* rax = (const float*)(p.ws + WS_RAX);
    const int nqm = (l == 0) ? 36 : 32, nq = nqm * 6, nkv = 36 * 8, nsc = 2 * 16 * NCH;
    const pg8::PlainSched Sq{P, (const bf16_t*)(p.ws + WS_WUQ) + (size_t)l * 1536 * 512, INC, C_CQ, 512, nqm, 6, nq};
    const pg8::PlainSched Skv{P, (const bf16_t*)(p.ws + WS_WUKV) + (size_t)l * 2048 * 256, INC, C_CKV, 256, 36, 8, nkv};
    for (int i = 0; i < 4; ++i) { pg8::Unit u; if (Sq.next(i, u)) rstd_table<512>(P, u.pm * 256, C_CQ, rsq + i * 256); }
    for (int i = 0; i < 4; ++i) { pg8::Unit u; if (Skv.next(i, u)) rstd_table<256>(P, u.pm * 256, C_CKV, rskv + i * 256); }
#ifndef L2_GEMM_REP
#define L2_GEMM_REP 1
#endif
#ifndef L2_SCAN_REP
#define L2_SCAN_REP 1
#endif
#pragma nounroll
    for (int rep = 0; rep < L2_GEMM_REP; ++rep) {
    SUB(0) { pg8::gemm_phase((LAS unsigned char*)smem, 512, Sq, EpiQ{(bf16_t*)(p.ws + WS_Q), rsq, rax}); }
    SUB(1) { pg8::gemm_phase((LAS unsigned char*)smem, 256, Skv, EpiKV{(bf16_t*)(p.ws + WS_K), (bf16_t*)(p.ws + WS_V), rskv}); }
    }
    for (int i = 0; i < 4; ++i) {
        pg8::Unit uk; if (!Skv.next(i, uk)) break;
        const int pm = uk.pm, pn = uk.pn;
        bf16_t* Kb = (bf16_t*)(p.ws + WS_K);
        const int tid = opaque_tid(), rl = tid >> 1, half = tid & 1, row = pm * 256 + rl;
        const bool lat = row < NLAT; const int b = lat ? (row >> 11) : ((row - NLAT) >> 8); const int t = lat ? (row & 2047) : ((row - NLAT) & 255);
        const int kpos = lat ? (CL + t) : t;
        bf16_t* dst = Kb + ((size_t)(b * 8 + pn) * KEYS + kpos) * 192 + 128 + half * 32;
#pragma unroll
        for (int q = 0; q < 4; ++q) {
            float f[8]; unpack8(*(const bf16x8*)(P + (size_t)row * INC + C_KR + half * 32 + q * 8), f);
            if (lat) {
#pragma unroll
                for (int e = 0; e < 4; ++e) { const int pi = half * 16 + q * 4 + e; const int pos = (pi < 16) ? (t >> 6) : (t & 63);
                    const f32x2 cs = *(const f32x2*)(rax + (pos * 16 + (pi & 15)) * 2);
                    const float x1 = f[2 * e], x2 = f[2 * e + 1]; f[2 * e] = x1 * cs[0] - x2 * cs[1]; f[2 * e + 1] = x1 * cs[1] + x2 * cs[0]; }
            }
            *(bf16x8*)(dst + q * 8) = pack8(f);
        }
    }
    __syncthreads();
    {
        const int G = gridDim.x, nG = 16 * NCH;
        int u = (obid() + (G >> 1)) % G;
        {   GlaIn cur; bool have = u < nG;
            if (have) gla_load(p, l, (u / NCH) >> 2, (u / NCH) & 3, u % NCH, false, cur);
            while (have) { const int un = u + G; const bool hn = un < nG; GlaIn nxt;
                if (hn) gla_load(p, l, (un / NCH) >> 2, (un / NCH) & 3, un % NCH, false, nxt);
                CvtIn ci; cvt8_load(p, l, (l == 0 ? TS0A : TS1A) + u, ci);
                SUB(2) scan_a_gla(p, l, (u / NCH) >> 2, (u / NCH) & 3, u % NCH, cur, smem);
                cvt8_finish(p, l, (l == 0 ? TS0A : TS1A) + u, ci, smem);
                cur = nxt; u = un; have = hn; } }
        {   RetIn cur; bool have = u < nsc;
            if (have) { const int r = u - nG; ret_load(p, (r / NCH) >> 2, (r / NCH) & 3, r % NCH, false, cur); }
            while (have) { const int un = u + G; const bool hn = un < nsc; RetIn nxt; const int r = u - nG, rn = un - nG;
                if (hn) ret_load(p, (rn / NCH) >> 2, (rn / NCH) & 3, rn % NCH, false, nxt);
                CvtIn ci; cvt8_load(p, l, (l == 0 ? TS0A : TS1A) + u, ci);
                SUB(3) scan_a_ret(p, l, (r / NCH) >> 2, (r / NCH) & 3, r % NCH, cur, smem);
                cvt8_finish(p, l, (l == 0 ? TS0A : TS1A) + u, ci, smem);
                cur = nxt; u = un; have = hn; } }
    }
}

DEVI void phase_l4(const Params& p, int l, char* smem) {
    const bf16_t* Q = (const bf16_t*)(p.ws + WS_Q); const bf16_t* Kb = (const bf16_t*)(p.ws + WS_K); const bf16_t* Vb = (const bf16_t*)(p.ws + WS_V);
    bf16_t* ymix = (bf16_t*)(p.ws + WS_YMIX);
    const int nal = 256, nac = (l == 0) ? 32 : 0, ncs = (l == 0) ? NCH : 32, nsc = 2 * 16 * ncs;
#ifndef L4_ATT_REP
#define L4_ATT_REP 1
#endif
#ifndef L4_SCAN_REP
#define L4_SCAN_REP 1
#endif
    phase_prefix(p, smem);
    asm volatile("s_waitcnt vmcnt(0)" ::: "memory");
    __syncthreads();
    if (threadIdx.x == 0) { __builtin_amdgcn_fence(__ATOMIC_RELEASE, "agent"); asm volatile("s_waitcnt vmcnt(0)" ::: "memory");
        __hip_atomic_fetch_add((unsigned*)(p.ws + WS_BAR) + PFXCNT_WORD + 64 * l, 1u, __ATOMIC_RELAXED, __HIP_MEMORY_SCOPE_AGENT); }
#pragma nounroll
    for (int rep = 0; rep < L4_ATT_REP; ++rep)
    for (int u = obid(); u < nal + nac; u += gridDim.x) {
        if (u < nal) { SUB(4) {
            const int bh = u >> 3, qb = u & 7, b = bh >> 3, h = bh & 7;
            att::attn_body(Q + ((size_t)bh * KEYS + CL + qb * 256) * 192, Kb + (size_t)bh * KEYS * 192, Vb + (size_t)bh * KEYS * 128,
                           ymix + (size_t)(b * SEQ + qb * 256) * DM + h * 128, KEYS, smem);
        } } else { SUB(4) {
            const int bh = u - nal, b = bh >> 3, h = bh & 7;
            att::attn_body(Q + (size_t)bh * KEYS * 192, Kb + (size_t)bh * KEYS * 192, Vb + (size_t)bh * KEYS * 128,
                           ymix + (size_t)(NLAT + b * CL) * DM + h * 128, CL, smem);
        } }
    }
    if (threadIdx.x == 0) {
        unsigned* c = (unsigned*)(p.ws + WS_BAR) + PFXCNT_WORD + 64 * l; unsigned sp = 0;
        while (__hip_atomic_load(c, __ATOMIC_RELAXED, __HIP_MEMORY_SCOPE_AGENT) < gridDim.x) { __builtin_amdgcn_s_sleep(2); if (++sp > (1u << 22)) break; }
        __builtin_amdgcn_fence(__ATOMIC_ACQUIRE, "agent");
        asm volatile("s_waitcnt vmcnt(0)" ::: "memory");
    }
    __syncthreads();
    {
        const int G = gridDim.x, nG = 16 * ncs, c0 = NCH - ncs;
        int u = (obid() + G - (nal + nac) % G) % G;
        {   GlaIn cur; bool have = u < nG;
            if (have) gla_load(p, l, (u / ncs) >> 2, (u / ncs) & 3, u % ncs + c0, true, cur);
            while (have) { const int un = u + G; const bool hn = un < nG; GlaIn nxt;
                if (hn) gla_load(p, l, (un / ncs) >> 2, (un / ncs) & 3, un % ncs + c0, true, nxt);
                CvtIn ci; cvt8_load(p, l, (l == 0 ? TS0C : TS1C) + u, ci);
                SUB(5) scan_c_gla(p, l, (u / ncs) >> 2, (u / ncs) & 3, u % ncs + c0, cur, smem);
                cvt8_finish(p, l, (l == 0 ? TS0C : TS1C) + u, ci, smem);
                cur = nxt; u = un; have = hn; } }
        {   RetIn cur; bool have = u < nsc;
            if (have) { const int r = u - nG; ret_load(p, (r / ncs) >> 2, (r / ncs) & 3, r % ncs + c0, true, cur); }
            while (have) { const int un = u + G; const bool hn = un < nsc; RetIn nxt; const int r = u - nG, rn = un - nG;
                if (hn) ret_load(p, (rn / ncs) >> 2, (rn / ncs) & 3, rn % ncs + c0, true, nxt);
                CvtIn ci; cvt8_load(p, l, (l == 0 ? TS0C : TS1C) + u, ci);
                SUB(6) scan_c_ret(p, l, (r / ncs) >> 2, (r / ncs) & 3, r % ncs + c0, cur, smem);
                cvt8_finish(p, l, (l == 0 ? TS0C : TS1C) + u, ci, smem);
                cur = nxt; u = un; have = hn; } }
    }
}

struct EpiOut { static constexpr bool PERM = false; const Params* pp; int l;
    DEVI void operator()(const f32x4 (&acc)[2][2][4][2], const pg8::Unit& u, int wr, int wc, int fr, int fq) const {
        const Params& p = *pp; float* xres = (float*)(p.ws + WS_XRES);
        const float* mod = (const float*)(p.ws + WS_MOD) + (size_t)l * 5 * 12288;
#pragma unroll
        for (int ai = 0; ai < 2; ++ai)
#pragma unroll
            for (int m = 0; m < 4; ++m) { const int row = u.pm * 256 + ai * 128 + wr * 64 + m * 16 + fr;
                const bool lat = row < NLAT; const int b = lat ? (row >> 11) : 4;
                const float* xin = (l == 0) ? (lat ? p.x + (size_t)row * DM : p.ctx + (size_t)(row - NLAT) * DM) : xres + (size_t)row * DM;
                const float* ga = mod + (size_t)b * 12288 + 4096;
#pragma unroll
                for (int bj = 0; bj < 2; ++bj)
#pragma unroll
                    for (int n = 0; n < 2; ++n) { const int col = u.pn * 256 + bj * 128 + wc * 32 + n * 16 + 4 * fq;
                        const f32x4 xo = *(const f32x4*)(xin + col); const f32x4 g = *(const f32x4*)(ga + col);
                        *(f32x4*)(xres + (size_t)row * DM + col) = xo + g * acc[ai][bj][m][n]; }
                __builtin_amdgcn_sched_barrier(0); }
    } };
DEVI void phase_wout(const Params& p, int l, char* smem) {
    const int nm = (l == 0) ? 36 : 32;
    pg8::PlainSched S{(const bf16_t*)(p.ws + WS_YMIX), (const bf16_t*)(p.ws + WS_WOUT) + (size_t)l * 2048 * 2048, DM, 0, 2048, nm, 8, nm * 8};
    pg8::gemm_phase((LAS unsigned char*)smem, 2048, S, EpiOut{&p, l});
    if (l == 0) tail_convert(p, 0, TAIL_WOUT_B0, T0A, TAILT_WOUT, smem);
}

template <int N>
DEVI void bitonic_desc(unsigned long long* key, int tid) {
    for (int k = 2; k <= N; k <<= 1)
        for (int j = k >> 1; j > 0; j >>= 1) {
            for (int t = tid; t < N / 2; t += 512) {
                const int i = ((t & ~(j - 1)) << 1) | (t & (j - 1)), q = i | j;
                const unsigned long long a = key[i], b = key[q];
                const bool desc = (i & k) == 0;
                if (desc ? (a < b) : (a > b)) { key[i] = b; key[q] = a; }
            }
            __syncthreads();
        }
}
DEVI void phase_rank(const Params& p, int l, char* smem) {
    unsigned long long* key = (unsigned long long*)smem;
    const float* aff = (const float*)(p.ws + WS_AFF);
    int* rank = (int*)(p.ws + WS_RANK); int* selrow = (int*)(p.ws + WS_SELROW); float* selgate = (float*)(p.ws + WS_SELGATE);
    const int tid = opaque_tid();
    const int nl = 64, nc = (l == 0) ? 64 : 0;
#ifndef RANK_REP
#define RANK_REP 1
#endif
#pragma nounroll
    for (int rep = 0; rep < RANK_REP; ++rep)
    for (int u = obid(); u < nl + nc; u += (gridDim.x == 256 ? 64 : gridDim.x)) {
        if (gridDim.x == 256 && obid() >= 64) break;
        if (u < nl) {
            const int be = u, b = be >> 4, e = be & 15;
            const float* a = aff + (size_t)be * KEYS;
            for (int i = tid; i < 2048; i += 512) key[i] = ((unsigned long long)__float_as_uint(a[i]) << 32) | (unsigned)(2047 - i);
            __syncthreads();
            bitonic_desc<2048>(key, tid);
            for (int pos = tid; pos < 2048; pos += 512) { const unsigned long long kv = key[pos]; const int i = 2047 - (int)(unsigned)(kv & 0xffffffffull);
                rank[(size_t)be * KEYS + i] = pos;
                if (pos < 256) { selrow[e * MSLOT + b * 256 + pos] = b * SEQ + i; selgate[e * MSLOT + b * 256 + pos] = __uint_as_float((unsigned)(kv >> 32)); } }
            __syncthreads();
        } else {
            const int be = u - nl, b = be >> 4, e = be & 15;
            const float* a = aff + (size_t)be * KEYS + SEQ;
            if (tid < 256) key[tid] = ((unsigned long long)__float_as_uint(a[tid]) << 32) | (unsigned)(255 - tid);
            __syncthreads();
            bitonic_desc<256>(key, tid);
            if (tid < 256) { const int pos = tid; const unsigned long long kv = key[pos]; const int i = 255 - (int)(unsigned)(kv & 0xffffffffull);
                rank[(size_t)be * KEYS + SEQ + i] = pos;
                if (pos < 32) { selrow[e * MSLOT + 1024 + b * 32 + pos] = NLAT + b * CL + i; selgate[e * MSLOT + 1024 + b * 32 + pos] = __uint_as_float((unsigned)(kv >> 32)); } }
            __syncthreads();
        }
    }
    if (gridDim.x == 256) {
        const int first = 64, bid = obid();
        const int nt = (l == 0) ? RANKT0 : RANKT1;
        if (bid >= first) cvt8_stream3(p, l, ((l == 0) ? T0B : T1B) + (bid - first), 256 - first, nt, smem);
    }
}

struct MoeGuSched { const bf16_t* hbuf; const bf16_t* Wgu; const int* selrow; int mvalid, nmt, units;
    DEVI bool next(int i, pg8::Unit& u) const {
        const int g = obid() + i * gridDim.x; if (g >= units) return false;
        int e, pm, pn;
        if (gridDim.x == 256) {
            const int c = g & 255, q = (g >> 8) * 32 + (c >> 3), per = nmt * 16, r = q % per, rr = r % (nmt * 4);
            e = 2 * (c & 7) + q / per; pm = rr % nmt; pn = (r / (nmt * 4)) * 4 + rr / nmt;
        } else { e = g / (nmt * 16); const int r = g % (nmt * 16); pm = r / 16; pn = r % 16; }
        u.e = e; u.pm = pm; u.pn = pn; u.ord = i; u.half = (nmt == 5 && pm == 4) ? 1 : 0;
        u.A = (const char*)hbuf; u.B = (const char*)Wgu + ((size_t)e * 4096 + u.pn * 256) * 2048; return true; }
    DEVI unsigned one(const pg8::Unit& u, int R, int C) const { const int slot = u.pm * 256 + R; const int row = (slot < mvalid) ? selrow[u.e * MSLOT + slot] : 0; return (unsigned)(row * (DM / 2) + C) * 2u; }
    DEVI void aoff(const pg8::Unit& u, int R0, int C0, int R1, int C1, unsigned (&o)[4]) const { o[0] = one(u, R0, C0); o[1] = one(u, R1, C1); o[2] = one(u, 128 + R0, C0); o[3] = one(u, 128 + R1, C1); }
};
struct EpiGU { static constexpr bool PERM = true; bf16_t* actb; int mvalid;
    DEVI void operator()(const f32x4 (&acc)[2][2][4][2], const pg8::Unit& u, int wr, int wc, int fr, int fq) const {
#pragma unroll
        for (int ai = 0; ai < 2; ++ai)
#pragma unroll
            for (int m = 0; m < 4; ++m) { const int slot = u.pm * 256 + ai * 128 + wr * 64 + m * 16 + fr;
                if (slot < mvalid) { const int col = u.pn * 128 + wc * 32 + 8 * fq;
                    constexpr float is = 1.f / W8_SCALE, us = ACT8_SCALE / W8_SCALE;
                    const f32x4 g0 = acc[ai][0][m][0] * is, g1 = acc[ai][0][m][1] * is, u0 = acc[ai][1][m][0] * us, u1 = acc[ai][1][m][1] * us;
                    *(u32x2*)((unsigned char*)actb + ((size_t)u.e * MSLOT + slot) * DM + col) = (u32x2){cvt4_fp8c(silu_f(g0[0]) * u0[0], silu_f(g0[1]) * u0[1], silu_f(g0[2]) * u0[2], silu_f(g0[3]) * u0[3]),
                                                                                                    cvt4_fp8c(silu_f(g1[0]) * u1[0], silu_f(g1[1]) * u1[1], silu_f(g1[2]) * u1[2], silu_f(g1[3]) * u1[3])}; } }
    } };
DEVI void phase_moe_gu(const Params& p, int l, char* smem) {
    const int mvalid = (l == 0) ? 1152 : 1024, nmt = (l == 0) ? 5 : 4;
    MoeGuSched S{(const bf16_t*)(p.ws + WS_H), (const bf16_t*)((const char*)(p.ws + WS_WGU) + (size_t)l * 16 * 4096 * 2048), (const int*)(p.ws + WS_SELROW), mvalid, nmt, 16 * nmt * 16};
    pg8::gemm_phase<MoeGuSched, EpiGU, true>((LAS unsigned char*)smem, 1024, S, EpiGU{(bf16_t*)(p.ws + WS_ACT), mvalid});
}
struct MoeDnSched { const bf16_t* actb; const bf16_t* Wdn; int nmt, units;
    DEVI bool next(int i, pg8::Unit& u) const {
        const int g = obid() + i * gridDim.x; if (g >= units) return false;
        int e, pm, pn;
        if (gridDim.x == 256 && nmt == 4) {
            const int c = g & 255, q = (g >> 8) * 32 + (c >> 3), per = nmt * 8, r = q % per, rr = r % (nmt * 4);
            e = 2 * (c & 7) + q / per; pm = rr % nmt; pn = (r / (nmt * 4)) * 4 + rr / nmt;
        } else { e = g / (nmt * 8); const int r = g % (nmt * 8); pm = r / 8; pn = r % 8; }
        u.e = e; u.pm = pm; u.pn = pn; u.ord = i; u.half = (nmt == 5 && pm == 4) ? 1 : 0;
        u.A = (const char*)actb + ((size_t)e * MSLOT + u.pm * 256) * DM; u.B = (const char*)Wdn + ((size_t)e * 2048 + u.pn * 256) * 2048; return true; }
    DEVI void aoff(const pg8::Unit&, int R0, int C0, int R1, int C1, unsigned (&o)[4]) const {
        o[0] = (unsigned)(R0 * (DM / 2) + C0) * 2u; o[1] = (unsigned)(R1 * (DM / 2) + C1) * 2u; o[2] = (unsigned)((128 + R0) * (DM / 2) + C0) * 2u; o[3] = (unsigned)((128 + R1) * (DM / 2) + C1) * 2u; }
};
struct EpiDN { static constexpr bool PERM = true; bf16_t* ydn; const float* selgate; int mvalid;
    DEVI void operator()(const f32x4 (&acc)[2][2][4][2], const pg8::Unit& u, int wr, int wc, int fr, int fq) const {
#pragma unroll
        for (int ai = 0; ai < 2; ++ai)
#pragma unroll
            for (int m = 0; m < 4; ++m) { const int slot = u.pm * 256 + ai * 128 + wr * 64 + m * 16 + fr;
                if (slot < mvalid) { const float gt = selgate[u.e * MSLOT + slot] * (1.f / (W8_SCALE * ACT8_SCALE));
#pragma unroll
                    for (int bj = 0; bj < 2; ++bj) { const int col = u.pn * 256 + bj * 128 + wc * 32 + 8 * fq; const f32x4 v0 = acc[ai][bj][m][0] * gt, v1 = acc[ai][bj][m][1] * gt;
                        *(u32x4*)(ydn + ((size_t)u.e * MSLOT + slot) * DM + col) = (u32x4){cvt_pk(v0[0], v0[1]), cvt_pk(v0[2], v0[3]), cvt_pk(v1[0], v1[1]), cvt_pk(v1[2], v1[3])}; } } }
    } };
DEVI void phase_moe_dn(const Params& p, int l, char* smem) {
    const int mvalid = (l == 0) ? 1152 : 1024, nmt = (l == 0) ? 5 : 4;
    MoeDnSched S{(const bf16_t*)(p.ws + WS_ACT), (const bf16_t*)((const char*)(p.ws + WS_WDN) + (size_t)l * 16 * 2048 * 2048), nmt, 16 * nmt * 8};
    pg8::gemm_phase<MoeDnSched, EpiDN, true>((LAS unsigned char*)smem, 1024, S, EpiDN{(bf16_t*)(p.ws + WS_YDN), (const float*)(p.ws + WS_SELGATE), mvalid});
    if (l == 0) tail_convert(p, 1, TAIL_DN_B0, 0, TAILT_DN, smem);
}

constexpr int NPHASE = 2 + 2 * 10;
__global__ void __launch_bounds__(512, 2) mega(Params p) {
    extern __shared__ __attribute__((aligned(1024))) char smem[];
    if (threadIdx.x == 0) *(uint4*)(smem + LDS_XB) = make_uint4(0u, 0u, 0u, 0u);
    __syncthreads();
    XcdBarrier bar = xcd_barrier_post((unsigned*)(p.ws + WS_BAR), (volatile LAS unsigned*)(smem + LDS_XB));
#ifndef PHMASK
#define PHMASK 0xFFFF
#endif
#ifndef PROBE_DUP
#define PROBE_DUP 0
#endif
#define RUN(bit, k, call) do { if constexpr ((PHMASK >> (bit)) & 1) { if ((k) >= p.ph_lo && (k) < p.ph_hi) { call; \
    if constexpr ((PROBE_DUP >> (bit)) & 1) { if ((bit) != 6 || l_probe == 0) { xcd_barrier(bar); call; } } \
    if ((k) + 1 < p.ph_hi) xcd_barrier(bar); } } } while (0)
    int l_probe = 0;
    RUN(0, 0, (phase_p0(p, smem), wait_mod(p), phase_rows<0>(p, 0, smem)));
#ifdef PROBE_XBAR
    for (int i = 0; i < PROBE_XBAR; ++i) xcd_barrier(bar);
#endif
    for (int l = 0; l < 2; ++l) {
        const int k0 = 2 + l * 10; l_probe = l;
        RUN(2, k0 + 0, phase_win(p, l, smem));
        RUN(3, k0 + 1, phase_l2(p, l, smem));
        RUN(5, k0 + 3, phase_l4(p, l, smem));
        RUN(6, k0 + 4, phase_wout(p, l, smem));
        RUN(7, k0 + 5, phase_rows<1>(p, l, smem));
        RUN(8, k0 + 6, phase_rank(p, l, smem));
        RUN(9, k0 + 7, phase_moe_gu(p, l, smem));
        RUN(10, k0 + 8, phase_moe_dn(p, l, smem));
        if (l == 0) RUN(11, k0 + 9, phase_rows<2>(p, 0, smem)); else RUN(12, k0 + 9, phase_rows<3>(p, 1, smem));
    }
#undef RUN
}

extern "C" void kernel_launch(void* const* d_in, const int* in_sizes, int n_in, void* d_out, int out_size, void* d_ws, size_t ws_size, hipStream_t stream) {
    static int grid = 0;
    if (!grid) {
        if (ws_size < WS_END) { fprintf(stderr, "kernel_launch: workspace too small: %zu < %zu\n", ws_size, (size_t)WS_END); return; }
        if (hipFuncSetAttribute((const void*)mega, hipFuncAttributeMaxDynamicSharedMemorySize, LDS_BYTES) != hipSuccess) { fprintf(stderr, "kernel_launch: LDS attribute failed\n"); return; }
        int dev = 0, cus = 0, per_cu = 0;
        hipGetDevice(&dev);
        hipDeviceGetAttribute(&cus, hipDeviceAttributeMultiprocessorCount, dev);
        hipOccupancyMaxActiveBlocksPerMultiprocessor(&per_cu, (const void*)mega, 512, LDS_BYTES);
        if (per_cu < 1) { fprintf(stderr, "kernel_launch: occupancy query says 0\n"); return; }
        grid = cus;
    }
    Params p{};
    p.x = (const float*)d_in[0]; p.c = (const float*)d_in[1]; p.ctx = (const float*)d_in[2]; p.c_ctx = (const float*)d_in[3];
    p.ada_w = (const float*)d_in[4]; p.ada_b = (const float*)d_in[5]; p.w_in = (const float*)d_in[6]; p.q_norm = (const float*)d_in[7];
    p.w_uq = (const float*)d_in[8]; p.kv_norm = (const float*)d_in[9]; p.w_ukv = (const float*)d_in[10]; p.gla_w2 = (const float*)d_in[11];
    p.gla_b = (const float*)d_in[12]; p.w_out = (const float*)d_in[13]; p.router_w = (const float*)d_in[14]; p.w_gate = (const float*)d_in[15];
    p.w_up = (const float*)d_in[16]; p.w_down = (const float*)d_in[17]; p.final_norm = (const float*)d_in[18];
    p.out = (float*)d_out; p.ws = (char*)d_ws;
    hipMemsetAsync((char*)d_ws + WS_BAR, 0, 16384, stream);
#if MK_ONE_LAUNCH
    p.ph_lo = 0; p.ph_hi = NPHASE;
    hipLaunchKernelGGL(mega, dim3(grid), dim3(512), LDS_BYTES, stream, p);
#else
    for (int k = 0; k < NPHASE; ++k) { p.ph_lo = k; p.ph_hi = k + 1; hipLaunchKernelGGL(mega, dim3(grid), dim3(512), LDS_BYTES, stream, p); }
#endif
    const hipError_t le = hipPeekAtLastError();
    if (le != hipSuccess) fprintf(stderr, "kernel_launch: launch failed: %s\n", hipGetErrorName(le));
}
```

```cpp
#include <hip/hip_runtime.h>
#include <stdint.h>
#include <stdio.h>

#ifndef MK_ONE_LAUNCH
#define MK_ONE_LAUNCH 1
#endif

#define DEVI __device__ __forceinline__
typedef unsigned short bf16_t;
typedef short bf16x8 __attribute__((ext_vector_type(8)));
typedef short s16x4 __attribute__((ext_vector_type(4)));
typedef float f32x2 __attribute__((ext_vector_type(2)));
typedef float f32x4 __attribute__((ext_vector_type(4)));
typedef float f32x8 __attribute__((ext_vector_type(8)));
typedef float f32x16 __attribute__((ext_vector_type(16)));
typedef unsigned u32x2 __attribute__((ext_vector_type(2)));
typedef unsigned u32x4 __attribute__((ext_vector_type(4)));
typedef int i32x4 __attribute__((ext_vector_type(4)));
typedef __bf16 bf16x2_t __attribute__((ext_vector_type(2)));

constexpr int DM = 2048, NB = 4, SEQ = 2048, CL = 256, NLAT = NB * SEQ, NCTX = NB * CL, NROW = NLAT + NCTX;
constexpr int INC = 4448, INCP = 4608;
constexpr int C_CQ = 0, C_CKV = 512, C_KR = 768, C_GQ = 832, C_GK = 1088, C_GV = 1344, C_GZ = 1856, C_GOG = 1888, C_RQ = 2400, C_RK = 2912, C_RV = 3424, C_RG = 3936;
constexpr int KEYS = SEQ + CL;
constexpr int NCH = 36;
constexpr int MSLOT = 1280;
constexpr float QSCALE = 0.07216878364870322f;
constexpr float EPS = 1e-6f;

constexpr size_t al256(size_t x) { return (x + 255) / 256 * 256; }
constexpr size_t WS_BAR = 0;
constexpr size_t WS_MOD = 16384;
constexpr size_t WS_RAX = WS_MOD + al256((size_t)2 * 5 * 12288 * 4);
constexpr size_t WS_RRET = WS_RAX + al256((size_t)64 * 16 * 2 * 4);
constexpr size_t WS_WIN = WS_RRET + al256((size_t)2048 * 64 * 2 * 4);
constexpr size_t WS_WUQ = WS_WIN + al256((size_t)2 * INCP * 2048 * 2);
constexpr size_t WS_WUKV = WS_WUQ + al256((size_t)2 * 1536 * 512 * 2);
constexpr size_t WS_WOUT = WS_WUKV + al256((size_t)2 * 2048 * 256 * 2);
constexpr size_t WS_WGU = WS_WOUT + al256((size_t)2 * 2048 * 2048 * 2);
constexpr size_t WS_WDN = WS_WGU + al256((size_t)2 * 16 * 4096 * 2048 * 2);
constexpr size_t WS_XRES = WS_WDN + al256((size_t)2 * 16 * 2048 * 2048 * 2);
constexpr size_t WS_H = WS_XRES + al256((size_t)NROW * DM * 4);
constexpr size_t WS_P = WS_H + al256((size_t)NROW * DM * 2);
constexpr size_t WS_Q = WS_P + al256((size_t)NROW * INC * 2);
constexpr size_t WS_K = WS_Q + al256((size_t)NB * 8 * KEYS * 192 * 2);
constexpr size_t WS_V = WS_K + al256((size_t)NB * 8 * KEYS * 192 * 2);
constexpr size_t WS_YMIX = WS_V + al256((size_t)NB * 8 * KEYS * 128 * 2);
constexpr size_t WS_UTG = WS_YMIX + al256((size_t)NROW * DM * 2);
constexpr size_t WS_UTR = WS_UTG + al256((size_t)32 * NCH * 128 * 64 * 4);
constexpr size_t WS_STG = WS_UTR + al256((size_t)32 * NCH * 128 * 128 * 4);
constexpr size_t WS_STR = WS_STG + al256((size_t)32 * NCH * 128 * 64 * 2);
constexpr size_t WS_DECG = WS_STR + al256((size_t)32 * NCH * 128 * 128 * 2);
constexpr size_t WS_AFF = WS_DECG + al256((size_t)32 * NCH * 64 * 4);
constexpr size_t WS_RANK = WS_AFF + al256((size_t)NB * 16 * KEYS * 4);
constexpr size_t WS_SELROW = WS_RANK + al256((size_t)NB * 16 * KEYS * 4);
constexpr size_t WS_SELGATE = WS_SELROW + al256((size_t)16 * MSLOT * 4);
constexpr size_t WS_ACT = WS_SELGATE + al256((size_t)16 * MSLOT * 4);
constexpr size_t WS_YDN = WS_ACT + al256((size_t)16 * MSLOT * 2048 * 2);
constexpr size_t WS_END = WS_YDN + al256((size_t)16 * MSLOT * 2048 * 2);

constexpr int MODCNT_WORD = 3584, P0_N_MOD_ITEMS = 512, PFXCNT_WORD = 3648;
constexpr int LDS_RS = 131072, LDS_XB = 131072 + 8192, LDS_BYTES = 131072 + 8192 + 64;
#ifndef SUBMASK
#define SUBMASK 0xFF
#endif
#define SUB(n) if constexpr ((SUBMASK >> (n)) & 1)

struct Params {
    const float *x, *c, *ctx, *c_ctx, *ada_w, *ada_b, *w_in, *q_norm, *w_uq, *kv_norm, *w_ukv, *gla_w2, *gla_b, *w_out, *router_w, *w_gate, *w_up, *w_down, *final_norm;
    float* out; char* ws; int ph_lo, ph_hi;
};

DEVI unsigned cvt_pk(float lo, float hi) { f32x2 v = {lo, hi}; bf16x2_t b = __builtin_convertvector(v, bf16x2_t); return __builtin_bit_cast(unsigned, b); }
DEVI bf16_t f2bf(float x) { return (bf16_t)(cvt_pk(x, 0.f) & 0xffffu); }
DEVI float bf2f(bf16_t b) { return __uint_as_float(((unsigned)b) << 16); }
DEVI float bflo(unsigned w) { return __uint_as_float(w << 16); }
DEVI float bfhi(unsigned w) { return __uint_as_float(w & 0xffff0000u); }
DEVI int obid() { int b = blockIdx.x; asm volatile("" : "+s"(b)); return b; }
DEVI int opaque_tid() { int t = threadIdx.x; asm volatile("" : "+v"(t)); return t; }
typedef int i32x8 __attribute__((ext_vector_type(8)));
DEVI float clamp8(float x) { return __builtin_amdgcn_fmed3f(x, -448.f, 448.f); }
DEVI unsigned cvt4_fp8(float a, float b, float c, float d) { int w = 0; w = __builtin_amdgcn_cvt_pk_fp8_f32(a, b, w, false); w = __builtin_amdgcn_cvt_pk_fp8_f32(c, d, w, true); return (unsigned)w; }
DEVI unsigned cvt4_fp8c(float a, float b, float c, float d) { return cvt4_fp8(clamp8(a), clamp8(b), clamp8(c), clamp8(d)); }
constexpr float W8_SCALE = 64.f, ACT8_SCALE = 4.f;
DEVI float silu_f(float x) { return x / (1.f + __expf(-x)); }
DEVI float wave_sum(float s) {
#pragma unroll
    for (int off = 32; off >= 1; off >>= 1) s += __shfl_xor(s, off);
    return s;
}
DEVI void unpack8(bf16x8 v, float (&f)[8]) {
    u32x4 w = __builtin_bit_cast(u32x4, v);
#pragma unroll
    for (int i = 0; i < 4; ++i) { f[2 * i] = bflo(w[i]); f[2 * i + 1] = bfhi(w[i]); }
}
DEVI bf16x8 pack8(const float (&f)[8]) {
    u32x4 w = {cvt_pk(f[0], f[1]), cvt_pk(f[2], f[3]), cvt_pk(f[4], f[5]), cvt_pk(f[6], f[7])};
    return __builtin_bit_cast(bf16x8, w);
}

#define XB_TMO      128
#define XB_XCNT(j)  (256  + 64 * (j))
#define XB_XSUB(j)  (1280 + 64 * (j))
#define XB_XGEN(j)  (2304 + 64 * (j))
#define XB_TOP      3328
#define XB_TOPGEN   3392
#define XCD_BAR_WORDS 3456
#define XB_SPIN_CAP (1u << 18)
#define LAS __attribute__((address_space(3)))
DEVI unsigned xb_ld(unsigned* p)              { return __hip_atomic_load(p, __ATOMIC_RELAXED, __HIP_MEMORY_SCOPE_AGENT); }
DEVI unsigned xb_add(unsigned* p, unsigned v) { return __hip_atomic_fetch_add(p, v, __ATOMIC_RELAXED, __HIP_MEMORY_SCOPE_AGENT); }
DEVI unsigned xb_xcc_id() { return (unsigned)__builtin_amdgcn_s_getreg((3 << 11) | 20) & 0xFu; }
#define XB_SPIN(cond, bar) do { unsigned _sp = 0; while (cond) { __builtin_amdgcn_s_sleep(1); \
    if ((++_sp & 255u) == 0u) { if (xb_ld(&(bar)[XB_TMO])) break; if (_sp > XB_SPIN_CAP) { atomicAdd(&(bar)[XB_TMO], 1u); break; } } } } while (0)
struct XcdBarrier { unsigned* bar; unsigned x; volatile LAS unsigned* st; };
DEVI XcdBarrier xcd_barrier_post(unsigned* bar, volatile LAS unsigned* st) {
    XcdBarrier b; b.bar = bar; b.x = xb_xcc_id(); b.st = st;
    if (threadIdx.x == 0) (void)xb_add(&bar[XB_XCNT(b.x)], 1u);
    return b;
}
DEVI void xcd_barrier_complete(unsigned* bar, unsigned x, unsigned& nloc, unsigned& nx) {
    const unsigned G = gridDim.x * gridDim.y * gridDim.z;
    unsigned sum, cnt, mine, sp = 0u;
    for (;;) {
        sum = 0u; cnt = 0u; mine = 0u;
#pragma unroll
        for (unsigned j = 0; j < 16; ++j) { const unsigned c = xb_ld(&bar[XB_XCNT(j)]); sum += c; cnt += (c > 0u) ? 1u : 0u; mine = (j == x) ? c : mine; }
        if (sum == G) break;
        __builtin_amdgcn_s_sleep(1);
        if ((++sp & 255u) == 0u) { if (xb_ld(&bar[XB_TMO])) break; if (sp > XB_SPIN_CAP) { atomicAdd(&bar[XB_TMO], 1u); break; } }
    }
    nloc = mine > 0u ? mine : 1u; nx = cnt > 0u ? cnt : 1u;
}
DEVI void xcd_barrier(const XcdBarrier& b) {
    asm volatile("s_waitcnt vmcnt(0)" ::: "memory");
    __syncthreads();
    if (threadIdx.x == 0) {
        unsigned* bar = b.bar;
        __builtin_amdgcn_s_waitcnt(0);
        unsigned nloc = b.st[0], nx = b.st[1];
        if (nloc == 0u) { xcd_barrier_complete(bar, b.x, nloc, nx); b.st[0] = nloc; b.st[1] = nx; }
        const unsigned old = xb_add(&bar[XB_XSUB(b.x)], 1u);
        const unsigned gen = old / nloc;
        if (old + 1u == (gen + 1u) * nloc) {
            __builtin_amdgcn_fence(__ATOMIC_RELEASE, "agent");
            asm volatile("s_waitcnt vmcnt(0)" ::: "memory");
            const unsigned og = xb_add(&bar[XB_TOP], 1u);
            const unsigned tg = og / nx;
            if (og + 1u == (tg + 1u) * nx) xb_add(&bar[XB_TOPGEN], 1u);
            else XB_SPIN(xb_ld(&bar[XB_TOPGEN]) == tg, bar);
            __builtin_amdgcn_fence(__ATOMIC_ACQUIRE, "agent");
            xb_add(&bar[XB_XGEN(b.x)], 1u);
            asm volatile("s_waitcnt vmcnt(0)" ::: "memory");
        } else {
            XB_SPIN(xb_ld(&bar[XB_XGEN(b.x)]) == gen, bar);
            __builtin_amdgcn_fence(__ATOMIC_ACQUIRE, "agent");
            asm volatile("s_waitcnt vmcnt(0)" ::: "memory");
        }
    }
    __syncthreads();
}

namespace pg8 {
constexpr int BM = 256, BK = 64, HALF = 128, HTB = HALF * BK * 2, STAGE_BYTES = 8 * HTB;
DEVI int lds_byte(int r, int c) { const int st = (r >> 4) * 2 + (c >> 5), rr = r & 15, cc = c & 31, ob = rr * 64 + cc * 2; return st * 1024 + (ob ^ (((ob >> 9) & 1) << 5)); }
DEVI void stage_rc(int b, int& R, int& C) { const int st = b / 1024, sb = b % 1024, swz = sb ^ (((sb >> 9) & 1) << 5); R = (st >> 1) * 16 + swz / 64; C = (st & 1) * 32 + (swz % 64) / 2; }
DEVI int perm32(int rho) { const int n = rho >> 4, i = rho & 15; return 8 * (i >> 2) + 4 * n + (i & 3); }
struct Unit { const char* A; const char* B; int pm, pn, e, ord, half; };

template <class Sched, class Epi, bool FP8 = false>
DEVI void gemm_phase(LAS unsigned char* lds, const int K, const Sched& S, const Epi& E) {
    const int tid = opaque_tid(), wid = __builtin_amdgcn_readfirstlane(tid >> 6), lane = tid & 63, wr = wid >> 2, wc = wid & 3, fr = lane & 15, fq = lane >> 4;
    const int nt = K / BK;
    int R0, C0, R1, C1; stage_rc(tid * 16, R0, C0); stage_rc(tid * 16 + 8192, R1, C1);
    unsigned voffB[2];
    { const int Rb0 = Epi::PERM ? ((R0 & ~31) + perm32(R0 & 31)) : R0, Rb1 = Epi::PERM ? ((R1 & ~31) + perm32(R1 & 31)) : R1;
      voffB[0] = (unsigned)(Rb0 * K + C0) * 2u; voffB[1] = (unsigned)(Rb1 * K + C1) * 2u; }
    const size_t kstep = (size_t)(BK * 2);
    const size_t hstepB = (size_t)HALF * K * 2;
    const unsigned ldsw = (unsigned)wid * 1024u;
    const int aoff = lds_byte(wr * 64 + fr, fq * 8), boff = lds_byte(wc * 32 + fr, fq * 8);
#define PG8_SA(b, h) (((b) * 2 + (h)) * HTB)
#define PG8_SB(b, h) ((4 + (b) * 2 + (h)) * HTB)
#define PG8_STAGE2(bufoff, gbase, v0, v1) do { \
        __builtin_amdgcn_global_load_lds((const unsigned*)((const char*)(gbase) + (v0)), (LAS unsigned*)(lds + (bufoff) + ldsw), 16, 0, 0); \
        __builtin_amdgcn_global_load_lds((const unsigned*)((const char*)(gbase) + (v1)), (LAS unsigned*)(lds + (bufoff) + ldsw + 8192), 16, 0, 0); } while (0)
#define PG8_STAGEB(bufoff, gbase) PG8_STAGE2(bufoff, gbase, voffB[0], voffB[1])
#define PG8_RD8(addr) __builtin_shufflevector(*(const LAS i32x4*)(addr), *(const LAS i32x4*)((addr) + 1024), 0, 1, 2, 3, 4, 5, 6, 7)
#define PG8_LDA(dst, b, h) do { if constexpr (FP8) { _Pragma("unroll") for (int m = 0; m < 4; ++m) dst##8[m] = PG8_RD8(lds + PG8_SA(b, h) + aoff + m * 2048); } \
        else { _Pragma("unroll") for (int m = 0; m < 4; ++m) _Pragma("unroll") for (int k = 0; k < 2; ++k) dst[m][k] = *(const LAS bf16x8*)(lds + PG8_SA(b, h) + aoff + m * 2048 + k * 1024); } } while (0)
#define PG8_LDB(dst, b, h) do { if constexpr (FP8) { _Pragma("unroll") for (int n = 0; n < 2; ++n) dst##8[n] = PG8_RD8(lds + PG8_SB(b, h) + boff + n * 2048); } \
        else { _Pragma("unroll") for (int n = 0; n < 2; ++n) _Pragma("unroll") for (int k = 0; k < 2; ++k) dst[n][k] = *(const LAS bf16x8*)(lds + PG8_SB(b, h) + boff + n * 2048 + k * 1024); } } while (0)
#define PG8_MMA(ai, bj, At, Bt) do { __builtin_amdgcn_s_setprio(1); _Pragma("unroll") for (int m = 0; m < 4; ++m) _Pragma("unroll") for (int n = 0; n < 2; ++n) { \
        if constexpr (FP8) asm volatile("v_mfma_scale_f32_16x16x128_f8f6f4 %0, %1, %2, %0, %3, %3 op_sel_hi:[0,0,0]" : "+v"(acc[ai][bj][m][n]) : "v"(Bt##8[n]), "v"(At##8[m]), "v"(mx_one));   \
        else { _Pragma("unroll") for (int k = 0; k < 2; ++k) acc[ai][bj][m][n] = __builtin_amdgcn_mfma_f32_16x16x32_bf16(Bt[n][k], At[m][k], acc[ai][bj][m][n], 0, 0, 0); } } \
        __builtin_amdgcn_s_setprio(0); } while (0)
#define PG8_WAIT_V(n) asm volatile("s_waitcnt vmcnt(" #n ")" ::: "memory")
#define PG8_WAIT_L(n) asm volatile("s_waitcnt lgkmcnt(" #n ")" ::: "memory")
#define PG8_BAR __builtin_amdgcn_s_barrier()
#define PG8_SCHED __builtin_amdgcn_sched_barrier(0)
    Unit cur, nxt; int ui = 0;
    if (!S.next(0, cur)) return;
    f32x4 acc[2][2][4][2];
#pragma unroll
    for (int a = 0; a < 2; ++a)
#pragma unroll
        for (int b = 0; b < 2; ++b)
#pragma unroll
            for (int m = 0; m < 4; ++m)
#pragma unroll
                for (int n = 0; n < 2; ++n) acc[a][b][m][n] = (f32x4){0.f, 0.f, 0.f, 0.f};
    bf16x8 At[4][2], B0[2][2], B1[2][2];
    i32x8 At8[4], B08[2], B18[2];
    const int mx_one = 0x7f7f7f7f;
    unsigned vc[4], vn[4];
    S.aoff(cur, R0, C0, R1, C1, vc);
    const char* cA = cur.A; const char* cB = cur.B;
    PG8_STAGEB(PG8_SB(0, 0), cB); PG8_STAGEB(PG8_SB(0, 1), cB + hstepB); PG8_STAGE2(PG8_SA(0, 0), cA, vc[0], vc[1]); PG8_STAGE2(PG8_SA(0, 1), cA, vc[2], vc[3]);
    if (wr == 1) PG8_BAR;
    PG8_WAIT_V(2); PG8_BAR;
    PG8_STAGEB(PG8_SB(1, 0), cB + kstep); PG8_STAGE2(PG8_SA(1, 0), cA + kstep, vc[0], vc[1]); PG8_STAGEB(PG8_SB(1, 1), cB + hstepB + kstep);
    PG8_WAIT_V(6); PG8_BAR;
    for (;;) {
        const bool has_next = S.next(ui + 1, nxt);
        if (has_next) S.aoff(nxt, R0, C0, R1, C1, vn);
        else { vn[0] = vc[0]; vn[1] = vc[1]; vn[2] = vc[2]; vn[3] = vc[3]; }
        const char* nA = has_next ? nxt.A : cA; const char* nB = has_next ? nxt.B : cB;
        const bool chalf = cur.half != 0;
#pragma nounroll
        for (int t = 0; t < nt; t += 2) {
            const bool last = (t == nt - 2);
            const char* a1 = cA + (size_t)(t + 1) * kstep;
            const char* a2 = last ? nA : cA + (size_t)(t + 2) * kstep; const char* b2 = last ? nB : cB + (size_t)(t + 2) * kstep;
            const char* a3 = a2 + kstep; const char* b3 = b2 + kstep;
            const unsigned w0 = last ? vn[0] : vc[0], w1 = last ? vn[1] : vc[1], w2 = last ? vn[2] : vc[2], w3 = last ? vn[3] : vc[3];
            PG8_LDB(B0, 0, 0); PG8_LDB(B1, 0, 1); PG8_SCHED; PG8_LDA(At, 0, 0); PG8_STAGE2(PG8_SA(1, 1), a1, vc[2], vc[3]);
            PG8_WAIT_V(8); PG8_WAIT_L(0); PG8_BAR; PG8_MMA(0, 0, At, B0); PG8_MMA(0, 1, At, B1); PG8_BAR; PG8_SCHED;
            PG8_LDA(At, 0, 1); PG8_STAGEB(PG8_SB(0, 0), b2); PG8_STAGEB(PG8_SB(0, 1), b2 + hstepB); PG8_STAGE2(PG8_SA(0, 0), a2, w0, w1);
            PG8_WAIT_V(8); PG8_WAIT_L(0); PG8_BAR; if (!chalf) { PG8_MMA(1, 0, At, B0); PG8_MMA(1, 1, At, B1); } PG8_BAR; PG8_SCHED;
            PG8_LDB(B0, 1, 0); PG8_LDB(B1, 1, 1); PG8_SCHED; PG8_LDA(At, 1, 0); PG8_STAGE2(PG8_SA(0, 1), a2, w2, w3);
            PG8_WAIT_V(8); PG8_WAIT_L(0); PG8_BAR; PG8_MMA(0, 0, At, B0); PG8_MMA(0, 1, At, B1); PG8_BAR; PG8_SCHED;
            PG8_LDA(At, 1, 1); PG8_STAGEB(PG8_SB(1, 0), b3); PG8_STAGEB(PG8_SB(1, 1), b3 + hstepB); PG8_STAGE2(PG8_SA(1, 0), a3, w0, w1);
            PG8_WAIT_V(8); PG8_WAIT_L(0); PG8_BAR; if (!chalf) { PG8_MMA(1, 0, At, B0); PG8_MMA(1, 1, At, B1); } PG8_BAR; PG8_SCHED;
        }
        if (wr == 0) PG8_BAR;
        E(acc, cur, wr, wc, fr, fq);
        if (!has_next) break;
#pragma unroll
        for (int a = 0; a < 2; ++a)
#pragma unroll
            for (int b = 0; b < 2; ++b)
#pragma unroll
                for (int m = 0; m < 4; ++m)
#pragma unroll
                    for (int n = 0; n < 2; ++n) acc[a][b][m][n] = (f32x4){0.f, 0.f, 0.f, 0.f};
        cur = nxt; cA = nA; cB = nB; ++ui; vc[0] = vn[0]; vc[1] = vn[1]; vc[2] = vn[2]; vc[3] = vn[3];
        if (wr == 1) PG8_BAR;
    }
    PG8_WAIT_V(0);
    PG8_BAR;
#undef PG8_SA
#undef PG8_SB
#undef PG8_STAGE2
#undef PG8_STAGEB
#undef PG8_LDA
#undef PG8_LDB
#undef PG8_MMA
#undef PG8_RD8
#undef PG8_WAIT_V
#undef PG8_WAIT_L
#undef PG8_BAR
#undef PG8_SCHED
}
struct PlainSched {
    const bf16_t* A; const bf16_t* Bt; int lda, acol0, K, nM, nN, units;
    DEVI bool next(int i, Unit& u) const {
        const int g = obid() + i * gridDim.x; if (g >= units) return false;
        int wgid = g; { const int q = units / 8, r = units % 8, xcd = wgid % 8, off = wgid / 8; wgid = (xcd < r ? xcd * (q + 1) : r * (q + 1) + (xcd - r) * q) + off; }
        const int nig = 8 * nN, gid = wgid / nig, fm = gid * 8, gsz = (nM - fm) < 8 ? (nM - fm) : 8;
        u.pm = fm + ((wgid % nig) % gsz); u.pn = (wgid % nig) / gsz; u.e = 0; u.ord = i; u.half = 0;
        u.A = (const char*)(A + (size_t)u.pm * 256 * lda + acol0); u.B = (const char*)(Bt + (size_t)u.pn * 256 * K); return true; }
    DEVI void aoff(const Unit&, int R0, int C0, int R1, int C1, unsigned (&o)[4]) const {
        o[0] = (unsigned)(R0 * lda + C0) * 2u; o[1] = (unsigned)(R1 * lda + C1) * 2u; o[2] = (unsigned)((128 + R0) * lda + C0) * 2u; o[3] = (unsigned)((128 + R1) * lda + C1) * 2u; }
};
}

DEVI void p0_mod_item(const Params& p, int item, char* smem) {
    const int l = item / 256, cb = item % 256, n0 = cb * 48;
    float* sv = (float*)smem;
    float* red = (float*)(smem + 65536);
    const int tid = opaque_tid(), wid = tid >> 6, lane = tid & 63;
    for (int idx = tid; idx < 2048; idx += 512) {
#pragma unroll
        for (int b = 0; b < 4; ++b) sv[idx * 8 + b] = silu_f(p.c[b * 2048 + idx]);
        sv[idx * 8 + 4] = silu_f(p.c_ctx[idx]);
    }
    __syncthreads();
    const int ln_c = lane < 48 ? lane : 47;
    const float* W = p.ada_w + (size_t)l * 2048 * 12288 + n0 + ln_c;
    float a0 = 0.f, a1 = 0.f, a2 = 0.f, a3 = 0.f, a4 = 0.f;
#pragma unroll 32
    for (int kk = 0; kk < 256; ++kk) {
        const int k = wid * 256 + kk;
        const float w = W[(size_t)k * 12288];
        const f32x4 s = *(const f32x4*)(sv + k * 8); const float s4 = sv[k * 8 + 4];
        a0 += s[0] * w; a1 += s[1] * w; a2 += s[2] * w; a3 += s[3] * w; a4 += s4 * w;
    }
    red[(wid * 5 + 0) * 64 + lane] = a0; red[(wid * 5 + 1) * 64 + lane] = a1; red[(wid * 5 + 2) * 64 + lane] = a2;
    red[(wid * 5 + 3) * 64 + lane] = a3; red[(wid * 5 + 4) * 64 + lane] = a4;
    __syncthreads();
    if (tid < 320 && (tid & 63) < 48) {
        const int i = tid >> 6, ln = tid & 63; float s = 0.f;
#pragma unroll
        for (int w = 0; w < 8; ++w) s += red[(w * 5 + i) * 64 + ln];
        float* mod = (float*)(p.ws + WS_MOD);
        __hip_atomic_store(&mod[(size_t)(l * 5 + i) * 12288 + n0 + ln], s + p.ada_b[l * 12288 + n0 + ln], __ATOMIC_RELAXED, __HIP_MEMORY_SCOPE_AGENT);
    }
    asm volatile("s_waitcnt vmcnt(0)" ::: "memory");
    __syncthreads();
    if (tid == 0) __hip_atomic_fetch_add((unsigned*)(p.ws + WS_BAR) + MODCNT_WORD, 1u, __ATOMIC_RELAXED, __HIP_MEMORY_SCOPE_AGENT);
}
DEVI void wait_mod(const Params& p) {
    if (threadIdx.x == 0) {
        unsigned* c = (unsigned*)(p.ws + WS_BAR) + MODCNT_WORD; unsigned sp = 0;
        while (__hip_atomic_load(c, __ATOMIC_RELAXED, __HIP_MEMORY_SCOPE_AGENT) < (unsigned)P0_N_MOD_ITEMS) { __builtin_amdgcn_s_sleep(2); if (++sp > (1u << 22)) break; }
        __builtin_amdgcn_fence(__ATOMIC_ACQUIRE, "agent");
        asm volatile("s_waitcnt vmcnt(0)" ::: "memory");
    }
    __syncthreads();
}

struct CvtD { const float* src; const float* scale; bf16_t* dst; int ldn, nvalid, K, k0, n0, d0; };
DEVI CvtD p0_bf16_desc(const Params& p, int j) {
    CvtD d;
    if (j < 1152) { const int l = j / 576, r = j % 576, kt = r / 36, nt = r % 36;
        d = CvtD{p.w_in + (size_t)l * 2048 * INC, nullptr, (bf16_t*)(p.ws + WS_WIN) + (size_t)l * INCP * 2048, INC, INC, 2048, kt * 128, nt * 128, nt * 128}; return d; }
    j -= 1152;
    if (j < 96) { const int l = j / 48, r = j % 48, kt = r / 12, nt = r % 12;
        d = CvtD{p.w_uq + (size_t)l * 512 * 1536, p.q_norm + l * 512, (bf16_t*)(p.ws + WS_WUQ) + (size_t)l * 1536 * 512, 1536, 1536, 512, kt * 128, nt * 128, nt * 128}; return d; }
    j -= 96;
    if (j < 64) { const int l = j / 32, r = j % 32, kt = r / 16, nt = r % 16;
        d = CvtD{p.w_ukv + (size_t)l * 256 * 2048, p.kv_norm + l * 256, (bf16_t*)(p.ws + WS_WUKV) + (size_t)l * 2048 * 256, 2048, 2048, 256, kt * 128, nt * 128, nt * 128}; return d; }
    j -= 64;
    { const int l = j / 256, r = j % 256, kt = r / 16, nt = r % 16;
        d = CvtD{p.w_out + (size_t)l * 2048 * 2048, nullptr, (bf16_t*)(p.ws + WS_WOUT) + (size_t)l * 2048 * 2048, 2048, 2048, 2048, kt * 128, nt * 128, nt * 128}; return d; }
}
struct CvtRegs { f32x4 v[8]; };
DEVI void cvt_tile_load(const CvtD& d, CvtRegs& rg) {
    const int tid = opaque_tid(), nq = tid & 31, kq0 = tid >> 5;
#pragma unroll
    for (int it = 0; it < 2; ++it)
#pragma unroll
        for (int kk = 0; kk < 4; ++kk) { const int k = d.k0 + (kq0 + it * 16) * 4 + kk, n = d.n0 + nq * 4;
            f32x4 v = (n < d.nvalid) ? *(const f32x4*)(d.src + (size_t)k * d.ldn + n) : (f32x4){0.f, 0.f, 0.f, 0.f};
            if (d.scale) v *= d.scale[k];
            rg.v[it * 4 + kk] = v; }
}
DEVI void cvt_tile_finish(const CvtD& d, const CvtRegs& rg, char* smem) {
    bf16_t* T = (bf16_t*)smem;
    const int tid = opaque_tid(), nq = tid & 31, kq0 = tid >> 5;
#pragma unroll
    for (int it = 0; it < 2; ++it) { const int kq = kq0 + it * 16;
#pragma unroll
        for (int j = 0; j < 4; ++j) { u32x2 w = {cvt_pk(rg.v[it * 4][j], rg.v[it * 4 + 1][j]), cvt_pk(rg.v[it * 4 + 2][j], rg.v[it * 4 + 3][j])};
            *(u32x2*)(T + (nq * 4 + j) * 132 + kq * 4) = w; } }
    __syncthreads();
#pragma unroll
    for (int i = 0; i < 8; ++i) { const int nl = (tid >> 5) + 16 * i, kc = (tid & 31) * 4;
        *(u32x2*)(d.dst + (size_t)(d.d0 + nl) * d.K + d.k0 + kc) = *(const u32x2*)(T + nl * 132 + kc); }
    __syncthreads();
}

struct CvtIn { f32x4 v[8]; };
DEVI void cvt8_load(const Params& p, int L, int t, CvtIn& in) {
    const int which = t / 4096, r = t % 4096, le = L * 16 + r / 256, kt = (r % 256) / 16, nt = r % 16;
    const float* src = (which == 2 ? p.w_down : (which == 0 ? p.w_gate : p.w_up)) + (size_t)le * 2048 * 2048;
    const int tid = opaque_tid(), nq = tid & 31, kq0 = tid >> 5;
#pragma unroll
    for (int it = 0; it < 2; ++it)
#pragma unroll
        for (int kk = 0; kk < 4; ++kk) in.v[it * 4 + kk] = __builtin_nontemporal_load((const f32x4*)(src + (size_t)(kt * 128 + (kq0 + it * 16) * 4 + kk) * 2048 + nt * 128 + nq * 4));
}
DEVI void cvt8_finish(const Params& p, int L, int t, const CvtIn& in, char* smem) {
    const int which = t / 4096, r = t % 4096, le = L * 16 + r / 256, kt = (r % 256) / 16, nt = r % 16;
    unsigned char* dst = (which == 2) ? (unsigned char*)(p.ws + WS_WDN) + (size_t)le * 2048 * 2048 + (size_t)(nt * 128) * 2048
                                      : (unsigned char*)(p.ws + WS_WGU) + (size_t)le * 4096 * 2048 + (size_t)(nt * 256 + which * 128) * 2048;
    unsigned char* T = (unsigned char*)smem;
    const int tid = opaque_tid(), nq = tid & 31, kq0 = tid >> 5;
#pragma unroll
    for (int it = 0; it < 2; ++it) { const int kq = kq0 + it * 16;
#pragma unroll
        for (int j = 0; j < 4; ++j) *(unsigned*)(T + (nq * 4 + j) * 144 + kq * 4) =
            cvt4_fp8(in.v[it * 4][j] * W8_SCALE, in.v[it * 4 + 1][j] * W8_SCALE, in.v[it * 4 + 2][j] * W8_SCALE, in.v[it * 4 + 3][j] * W8_SCALE); }
    __syncthreads();
#pragma unroll
    for (int i = 0; i < 2; ++i) { const int nl = (tid >> 3) + 64 * i, kc = (tid & 7) * 16;
        *(u32x4*)(dst + (size_t)nl * 2048 + kt * 128 + kc) = *(const u32x4*)(T + nl * 144 + kc); }
    __syncthreads();
}
DEVI void cvt8_stream(const Params& p, int L, int t0, int step, int count, char* smem) {
    if (count <= 0) return;
    CvtIn cur; cvt8_load(p, L, t0, cur);
    for (int i = 0; i < count; ++i) { const int t = t0 + i * step; CvtIn nxt;
        if (i + 1 < count) cvt8_load(p, L, t + step, nxt);
        cvt8_finish(p, L, t, cur, smem);
        cur = nxt; }
}
DEVI void cvt8_stream3(const Params& p, int L, int t0, int step, int count, char* smem) {
    if (count <= 0) return;
    CvtIn a, b; cvt8_load(p, L, t0, a);
    if (count > 1) cvt8_load(p, L, t0 + step, b);
#pragma nounroll
    for (int i = 0; i < count; ++i) { CvtIn c;
        if (i + 2 < count) cvt8_load(p, L, t0 + (i + 2) * step, c);
        cvt8_finish(p, L, t0 + i * step, a, smem);
        a = b; b = c; }
}
#ifndef TAILT_WIN
#define TAILT_WIN 18
#endif
#ifndef TAILT_WOUT
#define TAILT_WOUT 14
#endif
#ifndef TAILT_DN
#define TAILT_DN 10
#endif
constexpr int TAIL_WIN_B0 = 648 - 2 * 256, TAIL_WOUT_B0 = 288 - 256, TAIL_DN_B0 = 640 - 2 * 256;
constexpr int T0A = (256 - TAIL_WIN_B0) * TAILT_WIN, T0B = T0A + (256 - TAIL_WOUT_B0) * TAILT_WOUT, T1A = (256 - TAIL_DN_B0) * TAILT_DN, T1B = T1A + (256 - TAIL_WIN_B0) * TAILT_WIN;
static_assert(T0B <= 12288 && T1B <= 12288, "tail tiles");
DEVI void tail_convert(const Params& p, int L, int first_block, int base, int ntile, char* smem) {
    if (gridDim.x != 256 || obid() < first_block) return;
    cvt8_stream3(p, L, base + (obid() - first_block), 256 - first_block, ntile, smem);
}
#ifndef RANKT0
#define RANKT0 14
#endif
#ifndef RANKT1
#define RANKT1 14
#endif
constexpr int T0C = T0B + 192 * RANKT0, T1C = T1B + 192 * RANKT1;
static_assert(T0C <= 12288 && T1C <= 12288, "tail tiles");
constexpr int SCAN_A_UNITS = 2 * 16 * NCH, SCAN_C0_UNITS = 2 * 16 * NCH, SCAN_C1_UNITS = 2 * 16 * 32;
constexpr int TS0A = 12288 - SCAN_A_UNITS - SCAN_C0_UNITS, TS0C = 12288 - SCAN_C0_UNITS;
constexpr int TS1A = 12288 - SCAN_A_UNITS - SCAN_C1_UNITS, TS1C = 12288 - SCAN_C1_UNITS;
#ifndef L4C0_PER
#define L4C0_PER 62
#endif
#ifndef L4C1_PER
#define L4C1_PER 34
#endif
constexpr int L4NC = 32, T0D = T0C + L4NC * L4C0_PER, T1D = T1C + L4NC * L4C1_PER;
static_assert(T0D <= TS0A && T1D <= TS1A, "scan tiles");
constexpr int P0_N_MOD = 512, P0_N_WIN = 2 * 16 * 36, P0_N_WUQ = 2 * 4 * 12, P0_N_WUKV = 2 * 2 * 16, P0_N_WOUT = 2 * 16 * 16, P0_N_EXP0 = TS0A - T0D, P0_N_EXP = (TS0A - T0D) + (TS1A - T1D), P0_N_TAB = (1024 + 2048 * 64) / 512;
constexpr int P0_ITEMS = P0_N_MOD + P0_N_WIN + P0_N_WUQ + P0_N_WUKV + P0_N_WOUT + P0_N_EXP + P0_N_TAB;

DEVI void phase_p0(const Params& p, char* smem) {
    if (gridDim.x != 256) {
        { const int b0 = obid(), G = gridDim.x; if (b0 < T0D) cvt8_stream(p, 0, b0, G, (T0D - b0 + G - 1) / G, smem); if (b0 < T1D) cvt8_stream(p, 1, b0, G, (T1D - b0 + G - 1) / G, smem); }
    }
    for (int item = obid(); item < P0_ITEMS; item += gridDim.x) {
        int j = item;
        if (j < P0_N_MOD) { p0_mod_item(p, j, smem); continue; }
        j -= P0_N_MOD;
        if (j < P0_N_WIN + P0_N_WUQ + P0_N_WUKV + P0_N_WOUT) continue;
        j -= P0_N_WIN + P0_N_WUQ + P0_N_WUKV + P0_N_WOUT;
        if (j < P0_N_EXP) continue;
        j -= P0_N_EXP;
        {
            const int idx = j * 512 + threadIdx.x;
            if (idx < 1024) { const int pos = idx >> 4, f = idx & 15;
                const float inv = (float)pow(10000.0, -(double)f / 16.0); const float ang = (float)pos * inv;
                float* t = (float*)(p.ws + WS_RAX); t[idx * 2] = (float)cos((double)ang); t[idx * 2 + 1] = (float)sin((double)ang);
            } else { const int q = idx - 1024, tt = q >> 6, pp = q & 63;
                const float inv = (float)(1.0 / pow(10000.0, (double)pp / 63.0)); const float ang = (float)tt * inv;
                float* t = (float*)(p.ws + WS_RRET); t[q * 2] = (float)cos((double)ang); t[q * 2 + 1] = (float)sin((double)ang);
            }
        }
    }
    {
        const int G = gridDim.x, NB16 = P0_N_WIN + P0_N_WUQ + P0_N_WUKV + P0_N_WOUT;
        int first = obid() - P0_N_MOD % G; if (first < 0) first += G;
        if (first < NB16) { CvtD dc = p0_bf16_desc(p, first); CvtRegs rc; cvt_tile_load(dc, rc);
            for (int jj = first; jj < NB16; jj += G) { CvtD dn = dc; CvtRegs rn;
                if (jj + G < NB16) { dn = p0_bf16_desc(p, jj + G); cvt_tile_load(dn, rn); }
                cvt_tile_finish(dc, rc, smem);
                dc = dn; rc = rn; } }
    }
    {
        const int G = gridDim.x, EXP_BASE = P0_N_MOD + P0_N_WIN + P0_N_WUQ + P0_N_WUKV + P0_N_WOUT;
        int first = obid() - EXP_BASE % G; if (first < 0) first += G;
        if (first < P0_N_EXP0) cvt8_stream3(p, 0, T0D + first, G, (P0_N_EXP0 - first + G - 1) / G, smem);
        int f1 = first; if (f1 < P0_N_EXP0) f1 += ((P0_N_EXP0 - f1 + G - 1) / G) * G;
        if (f1 < P0_N_EXP) cvt8_stream3(p, 1, T1D + (f1 - P0_N_EXP0), G, (P0_N_EXP - f1 + G - 1) / G, smem);
    }
}

template <int MODE>
DEVI void phase_rows(const Params& p, int l, char* smem) {
    const int tid = opaque_tid(), wid = tid >> 6, lane = tid & 63;
    float* xres = (float*)(p.ws + WS_XRES);
    bf16_t* hbuf = (bf16_t*)(p.ws + WS_H);
    const float* mod = (const float*)(p.ws + WS_MOD);
    float* wT = (float*)smem;
    if (MODE == 1) {
        const float* rw = p.router_w + (size_t)l * 2048 * 16;
        f32x4 rwv[16];
#pragma unroll
        for (int it = 0; it < 16; ++it) { const int i = tid + it * 512; rwv[it] = *(const f32x4*)(rw + (i >> 2) * 16 + (i & 3) * 4); }
#pragma unroll
        for (int it = 0; it < 16; ++it) { const int i = tid + it * 512, k = i >> 2, e4 = (i & 3) * 4; const f32x4 v = rwv[it];
            wT[(e4 + 0) * 2048 + k] = v[0]; wT[(e4 + 1) * 2048 + k] = v[1]; wT[(e4 + 2) * 2048 + k] = v[2]; wT[(e4 + 3) * 2048 + k] = v[3]; }
        __syncthreads();
    }
    const int nrows = (MODE == 3 || (MODE == 1 && l == 1)) ? NLAT : NROW;
    for (int row = obid() * 8 + wid; row < nrows; row += gridDim.x * 8) {
        const bool lat = row < NLAT;
        const int b = lat ? (row >> 11) : ((row - NLAT) >> 8);
        const int tok = lat ? (row & 2047) : (SEQ + ((row - NLAT) & 255));
        const float* src = (MODE == 0) ? (lat ? p.x + (size_t)row * DM : p.ctx + (size_t)(row - NLAT) * DM) : xres + (size_t)row * DM;
        float v[32];
#pragma unroll
        for (int i = 0; i < 8; ++i) { const f32x4 t = *(const f32x4*)(src + i * 256 + lane * 4); v[i * 4] = t[0]; v[i * 4 + 1] = t[1]; v[i * 4 + 2] = t[2]; v[i * 4 + 3] = t[3]; }
        const float* mrow = mod + (size_t)(((MODE == 2) ? l : l) * 5 + (lat ? b : 4)) * 12288;
        if (MODE == 2 || MODE == 3) {
            float cacc[32];
#pragma unroll
            for (int i = 0; i < 32; ++i) cacc[i] = 0.f;
            const int* rk = (const int*)(p.ws + WS_RANK) + (size_t)b * 16 * KEYS + tok;
            const bf16_t* ydn = (const bf16_t*)(p.ws + WS_YDN);
            const int cap = lat ? 256 : 32;
            int rke[16];
#pragma unroll
            for (int e = 0; e < 16; ++e) rke[e] = rk[e * KEYS];
#pragma unroll
            for (int e = 0; e < 16; ++e) {
                const int r = rke[e];
                if (r < cap) {
                    const int slot = lat ? (b * 256 + r) : (1024 + b * 32 + r);
                    const bf16_t* yr = ydn + ((size_t)e * MSLOT + slot) * DM;
#pragma unroll
                    for (int i = 0; i < 8; ++i) { const u32x2 w = *(const u32x2*)(yr + i * 256 + lane * 4);
                        cacc[i * 4] += bflo(w[0]); cacc[i * 4 + 1] += bfhi(w[0]); cacc[i * 4 + 2] += bflo(w[1]); cacc[i * 4 + 3] += bfhi(w[1]); }
                }
            }
            const float* gf = mrow + 10240;
#pragma unroll
            for (int i = 0; i < 8; ++i) { const f32x4 g = *(const f32x4*)(gf + i * 256 + lane * 4);
                v[i * 4] += g[0] * cacc[i * 4]; v[i * 4 + 1] += g[1] * cacc[i * 4 + 1]; v[i * 4 + 2] += g[2] * cacc[i * 4 + 2]; v[i * 4 + 3] += g[3] * cacc[i * 4 + 3]; }
            if (MODE == 2) {
#pragma unroll
                for (int i = 0; i < 8; ++i) *(f32x4*)(xres + (size_t)row * DM + i * 256 + lane * 4) = (f32x4){v[i * 4], v[i * 4 + 1], v[i * 4 + 2], v[i * 4 + 3]};
            }
        }
        float ss = 0.f;
#pragma unroll
        for (int i = 0; i < 32; ++i) ss += v[i] * v[i];
        ss = wave_sum(ss);
        const float rstd = rsqrtf(ss * (1.f / DM) + EPS);
        if (MODE == 3) {
#pragma unroll
            for (int i = 0; i < 8; ++i) { const f32x4 g = *(const f32x4*)(p.final_norm + i * 256 + lane * 4);
                __builtin_nontemporal_store((f32x4){v[i * 4] * rstd * g[0], v[i * 4 + 1] * rstd * g[1], v[i * 4 + 2] * rstd * g[2], v[i * 4 + 3] * rstd * g[3]}, (f32x4*)(p.out + (size_t)row * DM + i * 256 + lane * 4)); }
            continue;
        }
        const float* mr2 = (MODE == 2) ? mrow + (size_t)5 * 12288 : mrow;
        const float* sh = mr2 + ((MODE == 1) ? 6144 : 0);
        const float* sc = mr2 + ((MODE == 1) ? 8192 : 2048);
#pragma unroll
        for (int i = 0; i < 8; ++i) { const f32x4 a = *(const f32x4*)(sh + i * 256 + lane * 4); const f32x4 s = *(const f32x4*)(sc + i * 256 + lane * 4);
#pragma unroll
            for (int j = 0; j < 4; ++j) v[i * 4 + j] = v[i * 4 + j] * rstd * (1.f + s[j]) + a[j];
            if (MODE == 1) *(unsigned*)((unsigned char*)hbuf + (size_t)row * DM + i * 256 + lane * 4) = cvt4_fp8c(v[i * 4], v[i * 4 + 1], v[i * 4 + 2], v[i * 4 + 3]);
            else *(u32x2*)(hbuf + (size_t)row * DM + i * 256 + lane * 4) = (u32x2){cvt_pk(v[i * 4], v[i * 4 + 1]), cvt_pk(v[i * 4 + 2], v[i * 4 + 3])}; }
        if (MODE == 1) {
            float a[16];
#pragma unroll
            for (int e = 0; e < 16; ++e) { float t = 0.f;
#pragma unroll
                for (int i = 0; i < 8; ++i) { const f32x4 w = *(const f32x4*)(wT + e * 2048 + i * 256 + lane * 4);
                    t += v[i * 4] * w[0] + v[i * 4 + 1] * w[1] + v[i * 4 + 2] * w[2] + v[i * 4 + 3] * w[3]; }
                a[e] = t; if ((e & 3) == 3) __builtin_amdgcn_sched_barrier(0); }
            const bool b5 = (lane & 32) != 0, b4 = (lane & 16) != 0, b3 = (lane & 8) != 0, b2 = (lane & 4) != 0;
            float s8[8], s4[4], s2[2], s1;
#pragma unroll
            for (int i = 0; i < 8; ++i) { const float keep = b5 ? a[8 + i] : a[i], give = b5 ? a[i] : a[8 + i]; s8[i] = keep + __shfl_xor(give, 32); }
#pragma unroll
            for (int i = 0; i < 4; ++i) { const float keep = b4 ? s8[4 + i] : s8[i], give = b4 ? s8[i] : s8[4 + i]; s4[i] = keep + __shfl_xor(give, 16); }
#pragma unroll
            for (int i = 0; i < 2; ++i) { const float keep = b3 ? s4[2 + i] : s4[i], give = b3 ? s4[i] : s4[2 + i]; s2[i] = keep + __shfl_xor(give, 8); }
            { const float keep = b2 ? s2[1] : s2[0], give = b2 ? s2[0] : s2[1]; s1 = keep + __shfl_xor(give, 4); }
            s1 += __shfl_xor(s1, 2); s1 += __shfl_xor(s1, 1);
            float mx = s1;
#pragma unroll
            for (int off = 32; off >= 4; off >>= 1) mx = fmaxf(mx, __shfl_xor(mx, off));
            const float ex = expf(s1 - mx); float den = ex;
#pragma unroll
            for (int off = 32; off >= 4; off >>= 1) den += __shfl_xor(den, off);
            const int eidx = (b5 ? 8 : 0) + (b4 ? 4 : 0) + (b3 ? 2 : 0) + (b2 ? 1 : 0);
            if ((lane & 3) == 0) ((float*)(p.ws + WS_AFF))[((size_t)b * 16 + eidx) * KEYS + tok] = ex / den;
        }
    }
    if (MODE == 1) __syncthreads();
}

struct EpiWin { static constexpr bool PERM = true; bf16_t* P;
    DEVI void operator()(const f32x4 (&acc)[2][2][4][2], const pg8::Unit& u, int wr, int wc, int fr, int fq) const {
#pragma unroll
        for (int ai = 0; ai < 2; ++ai)
#pragma unroll
            for (int m = 0; m < 4; ++m) { const int row = u.pm * 256 + ai * 128 + wr * 64 + m * 16 + fr;
#pragma unroll
                for (int bj = 0; bj < 2; ++bj) { const int col = u.pn * 256 + bj * 128 + wc * 32 + 8 * fq;
                    if (col < INC) { const f32x4 a = acc[ai][bj][m][0], b = acc[ai][bj][m][1];
                        *(u32x4*)(P + (size_t)row * INC + col) = (u32x4){cvt_pk(a[0], a[1]), cvt_pk(a[2], a[3]), cvt_pk(b[0], b[1]), cvt_pk(b[2], b[3])}; } } }
    } };
DEVI void phase_win(const Params& p, int l, char* smem) {
    pg8::PlainSched S{(const bf16_t*)(p.ws + WS_H), (const bf16_t*)(p.ws + WS_WIN) + (size_t)l * INCP * 2048, DM, 0, 2048, 36, 18, 36 * 18};
    pg8::gemm_phase((LAS unsigned char*)smem, 2048, S, EpiWin{(bf16_t*)(p.ws + WS_P)});
    if (l == 0) tail_convert(p, 0, TAIL_WIN_B0, 0, TAILT_WIN, smem); else tail_convert(p, 1, TAIL_WIN_B0, T1A, TAILT_WIN, smem);
}

DEVI float log_sigmoid_f(float x) { return fminf(x, 0.f) - __logf(1.f + __expf(-fabsf(x))); }
DEVI bf16x8 ldfrag(const bf16_t* base, int ld, int row0, int k0, int fr, int fq) { return *(const bf16x8*)(base + (row0 + fr) * ld + k0 + fq * 8); }
DEVI int chunk_row0(int b, int c) { return (c < 4) ? (NLAT + b * CL + c * 64) : (b * SEQ + (c - 4) * 64); }
DEVI int order_idx(int dir, int c) { return dir == 0 ? c : ((c < 4) ? (3 - c) : (4 + 35 - c)); }

struct GlaIn { bf16x8 q, k, v0, v1, g0, g1, z0, z1, z2, z3, bw; float bias; };
DEVI void gla_load(const Params& p, int l, int b, int h, int c, bool need_qg, GlaIn& in) {
    const bf16_t* P = (const bf16_t*)(p.ws + WS_P);
    const int tid = opaque_tid(), wid = tid >> 6, lane = tid & 63, fr = lane & 15, fq = lane >> 4, d = wid >> 2, kf = wid & 3, kk = kf * 16 + fr;
    const int row0 = chunk_row0(b, c), tk = tid >> 3, c8 = (tid & 7) * 8;
    in.k = *(const bf16x8*)(P + (size_t)(row0 + tk) * INC + C_GK + h * 64 + c8);
    in.v0 = *(const bf16x8*)(P + (size_t)(row0 + tk) * INC + C_GV + h * 128 + c8);
    in.v1 = *(const bf16x8*)(P + (size_t)(row0 + tk) * INC + C_GV + h * 128 + 64 + c8);
    if (need_qg) {
        in.q = *(const bf16x8*)(P + (size_t)(row0 + tk) * INC + C_GQ + h * 64 + c8);
        in.g0 = *(const bf16x8*)(P + (size_t)(row0 + tk) * INC + C_GOG + h * 128 + (tid & 7) * 16);
        in.g1 = *(const bf16x8*)(P + (size_t)(row0 + tk) * INC + C_GOG + h * 128 + (tid & 7) * 16 + 8);
    }
    const bf16x8 zero = {0, 0, 0, 0, 0, 0, 0, 0};
    in.z0 = zero; in.z1 = zero; in.z2 = zero; in.z3 = zero; in.bw = zero;
    if (fq < 2) {
        const bf16_t* zp = P + (size_t)(row0 + fr) * INC + C_GZ + d * 16 + fq * 8;
        in.z0 = *(const bf16x8*)(zp); in.z1 = *(const bf16x8*)(zp + (size_t)16 * INC); in.z2 = *(const bf16x8*)(zp + (size_t)32 * INC); in.z3 = *(const bf16x8*)(zp + (size_t)48 * INC);
        float wv[8];
#pragma unroll
        for (int j = 0; j < 8; ++j) wv[j] = p.gla_w2[((size_t)(l * 2 + d) * 16 + fq * 8 + j) * 256 + h * 64 + kk];
        in.bw = pack8(wv);
    }
    in.bias = p.gla_b[(size_t)(l * 2 + d) * 256 + h * 64 + kk];
}
DEVI void gla_cum(const GlaIn& in, float* cum) {
    const int tid = opaque_tid(), wid = tid >> 6, lane = tid & 63, fr = lane & 15, fq = lane >> 4, d = wid >> 2, kf = wid & 3;
    const int kk = kf * 16 + fr;
    float la[4][4];
#pragma unroll
    for (int f = 0; f < 4; ++f) {
        const bf16x8 az = (f == 0) ? in.z0 : (f == 1) ? in.z1 : (f == 2) ? in.z2 : in.z3;
        f32x4 acc = {0.f, 0.f, 0.f, 0.f};
        acc = __builtin_amdgcn_mfma_f32_16x16x32_bf16(az, in.bw, acc, 0, 0, 0);
#pragma unroll
        for (int r = 0; r < 4; ++r) la[f][r] = log_sigmoid_f(acc[r] + in.bias) * (1.f / 16.f);
    }
    if (d == 0) {
        float carry = 0.f;
#pragma unroll
        for (int f = 0; f < 4; ++f) {
            la[f][1] += la[f][0]; la[f][2] += la[f][1]; la[f][3] += la[f][2];
            float x = la[f][3]; const float own = x;
            float y = __shfl_up(x, 16); if (fq >= 1) x += y;
            y = __shfl_up(x, 32); if (fq >= 2) x += y;
            const float excl = x - own + carry;
            carry += __shfl(x, 48 + fr);
#pragma unroll
            for (int r = 0; r < 4; ++r) la[f][r] += excl;
        }
    } else {
        float carry = 0.f;
#pragma unroll
        for (int f = 3; f >= 0; --f) {
            la[f][2] += la[f][3]; la[f][1] += la[f][2]; la[f][0] += la[f][1];
            float x = la[f][0]; const float own = x;
            float y = __shfl_down(x, 16); if (fq <= 2) x += y;
            y = __shfl_down(x, 32); if (fq <= 1) x += y;
            const float excl = x - own + carry;
            carry += __shfl(x, fr);
#pragma unroll
            for (int r = 0; r < 4; ++r) la[f][r] += excl;
        }
    }
#pragma unroll
    for (int f = 0; f < 4; ++f)
#pragma unroll
        for (int r = 0; r < 4; ++r) cum[(d * 64 + f * 16 + fq * 4 + r) * 64 + kk] = la[f][r];
    __syncthreads();
}

DEVI void scan_a_gla(const Params& p, int l, int b, int h, int c, const GlaIn& in, char* smem) {
    float* cum = (float*)(smem + 18432);
    bf16_t* kTf = (bf16_t*)(smem + 51200); bf16_t* kTb = kTf + 64 * 72; bf16_t* vT = kTb + 64 * 72;
    const int tid = opaque_tid(), wid = tid >> 6, lane = tid & 63, fr = lane & 15, fq = lane >> 4;
    const int tk = tid >> 3, c8 = (tid & 7) * 8;
    const bf16x8 kreg = in.k, v0 = in.v0, v1 = in.v1;
    gla_cum(in, cum);
    {   float kf[8]; unpack8(kreg, kf);
#pragma unroll
        for (int e = 0; e < 8; ++e) { const int kk = c8 + e;
            kTf[kk * 72 + tk] = f2bf(kf[e] * __expf(cum[(0 * 64 + 63) * 64 + kk] - cum[(0 * 64 + tk) * 64 + kk]));
            kTb[kk * 72 + tk] = f2bf(kf[e] * __expf(cum[(1 * 64 + 0) * 64 + kk] - cum[(1 * 64 + tk) * 64 + kk])); }
#pragma unroll
        for (int e = 0; e < 8; ++e) { vT[(c8 + e) * 72 + tk] = (bf16_t)v0[e]; vT[(64 + c8 + e) * 72 + tk] = (bf16_t)v1[e]; }
    }
    if (tid < 128) { const int d = tid >> 6, kk = tid & 63;
        ((float*)(p.ws + WS_DECG))[((size_t)((b * 4 + h) * 2 + d) * NCH + order_idx(d, c)) * 64 + kk] = __expf(d == 0 ? cum[(0 * 64 + 63) * 64 + kk] : cum[(1 * 64 + 0) * 64 + kk]); }
    __syncthreads();
    {   const int dir = wid >> 2, kkf = wid & 3;
        const bf16_t* kT = dir ? kTb : kTf;
        const bf16x8 a0 = ldfrag(kT, 72, kkf * 16, 0, fr, fq), a1 = ldfrag(kT, 72, kkf * 16, 32, fr, fq);
        bf16_t* UT = (bf16_t*)(p.ws + WS_UTG) + ((size_t)((b * 4 + h) * 2 + dir) * NCH + order_idx(dir, c)) * (128 * 64);
#pragma unroll
        for (int vf = 0; vf < 8; ++vf) {
            f32x4 acc = {0.f, 0.f, 0.f, 0.f};
            acc = __builtin_amdgcn_mfma_f32_16x16x32_bf16(a0, ldfrag(vT, 72, vf * 16, 0, fr, fq), acc, 0, 0, 0);
            acc = __builtin_amdgcn_mfma_f32_16x16x32_bf16(a1, ldfrag(vT, 72, vf * 16, 32, fr, fq), acc, 0, 0, 0);
            *(u32x2*)(UT + (vf * 16 + fr) * 64 + kkf * 16 + fq * 4) = (u32x2){cvt_pk(acc[0], acc[1]), cvt_pk(acc[2], acc[3])};
        }
    }
    __syncthreads();
}

DEVI void ret_decays(int h, float& ldf, float& ldb) { ldf = log1pf(-exp2f(-(5.f + 2.f * h))); ldb = log1pf(-exp2f(-(6.f + 2.f * h))); }

struct RetIn { bf16x8 q0, q1, k0, k1, v0, v1, g0, g1; f32x4 cs0, cs1, cs2, cs3; };
DEVI void ret_load(const Params& p, int b, int h, int c, bool need_qg, RetIn& in) {
    const bf16_t* P = (const bf16_t*)(p.ws + WS_P);
    const float* rret = (const float*)(p.ws + WS_RRET);
    const int tid = opaque_tid(), tk = tid >> 3, kk16 = (tid & 7) * 16;
    const size_t rb = (size_t)(chunk_row0(b, c) + tk) * INC;
    in.k0 = *(const bf16x8*)(P + rb + C_RK + h * 128 + kk16); in.k1 = *(const bf16x8*)(P + rb + C_RK + h * 128 + kk16 + 8);
    in.v0 = *(const bf16x8*)(P + rb + C_RV + h * 128 + kk16); in.v1 = *(const bf16x8*)(P + rb + C_RV + h * 128 + kk16 + 8);
    if (need_qg) {
        in.q0 = *(const bf16x8*)(P + rb + C_RQ + h * 128 + kk16); in.q1 = *(const bf16x8*)(P + rb + C_RQ + h * 128 + kk16 + 8);
        in.g0 = *(const bf16x8*)(P + rb + C_RG + h * 128 + kk16); in.g1 = *(const bf16x8*)(P + rb + C_RG + h * 128 + kk16 + 8);
    }
    if (c >= 4) { const float* tb = rret + ((size_t)((c - 4) * 64 + tk) * 64 + (kk16 >> 1)) * 2;
        in.cs0 = *(const f32x4*)(tb); in.cs1 = *(const f32x4*)(tb + 4); in.cs2 = *(const f32x4*)(tb + 8); in.cs3 = *(const f32x4*)(tb + 12); }
}
DEVI void ret_rot(const bf16x8 r0, const bf16x8 r1, const RetIn& in, bool lat, float scale, float (&o)[16]) {
    float a[8], c[8]; unpack8(r0, a); unpack8(r1, c);
#pragma unroll
    for (int i = 0; i < 8; ++i) { o[i] = a[i]; o[8 + i] = c[i]; }
    if (lat) {
#pragma unroll
        for (int q = 0; q < 4; ++q) { const f32x4 cs = (q == 0) ? in.cs0 : (q == 1) ? in.cs1 : (q == 2) ? in.cs2 : in.cs3;
            const float x1 = o[4 * q], x2 = o[4 * q + 1], y1 = o[4 * q + 2], y2 = o[4 * q + 3];
            o[4 * q] = x1 * cs[0] - x2 * cs[1]; o[4 * q + 1] = x1 * cs[1] + x2 * cs[0];
            o[4 * q + 2] = y1 * cs[2] - y2 * cs[3]; o[4 * q + 3] = y1 * cs[3] + y2 * cs[2]; }
    }
#pragma unroll
    for (int i = 0; i < 16; ++i) o[i] *= scale;
}

DEVI void scan_a_ret(const Params& p, int l, int b, int h, int c, const RetIn& in, char* smem) {
    bf16_t* kTf = (bf16_t*)smem; bf16_t* kTb = kTf + 128 * 72; bf16_t* vT = kTb + 128 * 72;
    const int tid = opaque_tid(), wid = tid >> 6, lane = tid & 63, fr = lane & 15, fq = lane >> 4;
    const bool lat = c >= 4;
    const int tk = tid >> 3, kk16 = (tid & 7) * 16;
    float ldf, ldb; ret_decays(h, ldf, ldb);
    float kf[16];
    ret_rot(in.k0, in.k1, in, lat, 0.08838834764831845f, kf);
    const float ef = __expf(ldf * (float)(63 - tk)), eb = __expf(ldb * (float)tk);
#pragma unroll
    for (int e = 0; e < 16; ++e) { kTf[(kk16 + e) * 72 + tk] = f2bf(kf[e] * ef); kTb[(kk16 + e) * 72 + tk] = f2bf(kf[e] * eb); }
    {   const bf16x8 v0 = in.v0, v1 = in.v1;
#pragma unroll
        for (int e = 0; e < 8; ++e) { vT[(kk16 + e) * 72 + tk] = (bf16_t)v0[e]; vT[(kk16 + 8 + e) * 72 + tk] = (bf16_t)v1[e]; } }
    __syncthreads();
    {   const int dir = wid >> 2;
        const bf16_t* kT = dir ? kTb : kTf;
        bf16_t* UT = (bf16_t*)(p.ws + WS_UTR) + ((size_t)((b * 4 + h) * 2 + dir) * NCH + order_idx(dir, c)) * (128 * 128);
#pragma unroll
        for (int q = 0; q < 2; ++q) { const int kkf = (wid & 3) * 2 + q;
            const bf16x8 a0 = ldfrag(kT, 72, kkf * 16, 0, fr, fq), a1 = ldfrag(kT, 72, kkf * 16, 32, fr, fq);
#pragma unroll
            for (int vf = 0; vf < 8; ++vf) {
                f32x4 acc = {0.f, 0.f, 0.f, 0.f};
                acc = __builtin_amdgcn_mfma_f32_16x16x32_bf16(a0, ldfrag(vT, 72, vf * 16, 0, fr, fq), acc, 0, 0, 0);
                acc = __builtin_amdgcn_mfma_f32_16x16x32_bf16(a1, ldfrag(vT, 72, vf * 16, 32, fr, fq), acc, 0, 0, 0);
                *(u32x2*)(UT + (vf * 16 + fr) * 128 + kkf * 16 + fq * 4) = (u32x2){cvt_pk(acc[0], acc[1]), cvt_pk(acc[2], acc[3])};
            } }
    }
    __syncthreads();
}

DEVI void phase_prefix(const Params& p, char* smem) {
    const int NT_G = 32 * 2048, NT_R = 32 * 4096;
    for (int g = obid() * 512 + threadIdx.x; g < NT_G + NT_R; g += gridDim.x * 512) {
        if (g < NT_G) {
            const int seq = g >> 11, e4 = (g & 2047) * 4, kk = e4 & 63;
            const bf16_t* U = (const bf16_t*)(p.ws + WS_UTG) + (size_t)seq * NCH * 8192 + e4;
            bf16_t* S = (bf16_t*)(p.ws + WS_STG) + (size_t)seq * NCH * 8192 + e4;
            const float* dec = (const float*)(p.ws + WS_DECG) + (size_t)seq * NCH * 64 + kk;
            f32x4 st = {0.f, 0.f, 0.f, 0.f};
#pragma unroll 12
            for (int o = 0; o < NCH; ++o) {
                const u32x2 uw = *(const u32x2*)(U + (size_t)o * 8192); const f32x4 u = {bflo(uw[0]), bfhi(uw[0]), bflo(uw[1]), bfhi(uw[1])}; const f32x4 dd = *(const f32x4*)(dec + o * 64);
                *(u32x2*)(S + (size_t)o * 8192) = (u32x2){cvt_pk(st[0], st[1]), cvt_pk(st[2], st[3])};
                st = dd * st + u;
            }
        } else {
            const int g2 = g - NT_G, seq = g2 >> 12, e4 = (g2 & 4095) * 4;
            const int h = (seq >> 1) & 3, dir = seq & 1;
            float ldf, ldb; ret_decays(h, ldf, ldb);
            const float dd = __expf(64.f * (dir ? ldb : ldf));
            const bf16_t* U = (const bf16_t*)(p.ws + WS_UTR) + (size_t)seq * NCH * 16384 + e4;
            bf16_t* S = (bf16_t*)(p.ws + WS_STR) + (size_t)seq * NCH * 16384 + e4;
            f32x4 st = {0.f, 0.f, 0.f, 0.f};
#pragma unroll 12
            for (int o = 0; o < NCH; ++o) {
                const u32x2 uw = *(const u32x2*)(U + (size_t)o * 16384); const f32x4 u = {bflo(uw[0]), bfhi(uw[0]), bflo(uw[1]), bfhi(uw[1])};
                *(u32x2*)(S + (size_t)o * 16384) = (u32x2){cvt_pk(st[0], st[1]), cvt_pk(st[2], st[3])};
                st = dd * st + u;
            }
        }
    }
}

DEVI void scan_c_tail(const float* o, int tid, const bf16x8 g0, const bf16x8 g1, int row0, bf16_t* ymix, int ycol) {
    const int tk = tid >> 3, v16 = (tid & 7) * 16;
    float ov[16]; float ss = 0.f;
#pragma unroll
    for (int q = 0; q < 4; ++q) { const f32x4 t = *(const f32x4*)(o + tk * 128 + v16 + q * 4); ov[q * 4] = t[0]; ov[q * 4 + 1] = t[1]; ov[q * 4 + 2] = t[2]; ov[q * 4 + 3] = t[3]; }
#pragma unroll
    for (int i = 0; i < 16; ++i) ss += ov[i] * ov[i];
    ss += __shfl_xor(ss, 1); ss += __shfl_xor(ss, 2); ss += __shfl_xor(ss, 4);
    const float rstd = rsqrtf(ss * (1.f / 128.f) + EPS);
    float ga[8], gb[8]; unpack8(g0, ga); unpack8(g1, gb);
    float y0[8], y1[8];
#pragma unroll
    for (int i = 0; i < 8; ++i) { y0[i] = ov[i] * rstd * silu_f(ga[i]); y1[i] = ov[8 + i] * rstd * silu_f(gb[i]); }
    *(bf16x8*)(ymix + (size_t)(row0 + tk) * DM + ycol + v16) = pack8(y0);
    *(bf16x8*)(ymix + (size_t)(row0 + tk) * DM + ycol + v16 + 8) = pack8(y1);
}

DEVI void scan_c_gla(const Params& p, int l, int b, int h, int c, const GlaIn& in, char* smem) {
    float* cum = (float*)(smem + 18432);
    float* obuf = cum;
    bf16_t* qdf = (bf16_t*)(smem + 51200); bf16_t* qdb = qdf + 64 * 72; bf16_t* kif = qdb + 64 * 72; bf16_t* kib = kif + 64 * 72;
    bf16_t* vT = kib + 64 * 72; bf16_t* att = vT + 128 * 72;
    const int tid = opaque_tid(), wid = tid >> 6, lane = tid & 63, fr = lane & 15, fq = lane >> 4;
    const int row0 = chunk_row0(b, c);
    const int tk = tid >> 3, c8 = (tid & 7) * 8;
    const bf16x8 qreg = in.q, kreg = in.k, v0 = in.v0, v1 = in.v1, gt0 = in.g0, gt1 = in.g1;
    const bf16_t* SF = (const bf16_t*)(p.ws + WS_STG) + ((size_t)((b * 4 + h) * 2 + 0) * NCH + order_idx(0, c)) * 8192;
    const bf16_t* SB = (const bf16_t*)(p.ws + WS_STG) + ((size_t)((b * 4 + h) * 2 + 1) * NCH + order_idx(1, c)) * 8192;
    const bf16x8 sf0 = *(const bf16x8*)(SF + (wid * 16 + fr) * 64 + fq * 8), sf1 = *(const bf16x8*)(SF + (wid * 16 + fr) * 64 + 32 + fq * 8);
    const bf16x8 sb0 = *(const bf16x8*)(SB + (wid * 16 + fr) * 64 + fq * 8), sb1 = *(const bf16x8*)(SB + (wid * 16 + fr) * 64 + 32 + fq * 8);
    gla_cum(in, cum);
    {   float qf[8], kf[8]; unpack8(qreg, qf); unpack8(kreg, kf);
        float a[8], bq[8], cc[8], dq[8];
#pragma unroll
        for (int e = 0; e < 8; ++e) { const float cf = cum[(0 * 64 + tk) * 64 + c8 + e], cb = cum[(1 * 64 + tk) * 64 + c8 + e];
            a[e] = qf[e] * 0.125f * __expf(cf); bq[e] = qf[e] * 0.125f * __expf(cb); cc[e] = kf[e] * __expf(-cf); dq[e] = kf[e] * __expf(-cb); }
        *(bf16x8*)(qdf + tk * 72 + c8) = pack8(a); *(bf16x8*)(qdb + tk * 72 + c8) = pack8(bq);
        *(bf16x8*)(kif + tk * 72 + c8) = pack8(cc); *(bf16x8*)(kib + tk * 72 + c8) = pack8(dq);
#pragma unroll
        for (int e = 0; e < 8; ++e) { vT[(c8 + e) * 72 + tk] = (bf16_t)v0[e]; vT[(64 + c8 + e) * 72 + tk] = (bf16_t)v1[e]; }
    }
    __syncthreads();
    {
        const int jf = wid & 3;
#pragma unroll
        for (int q = 0; q < 2; ++q) { const int iff = (wid >> 2) * 2 + q;
            f32x4 af = {0.f, 0.f, 0.f, 0.f}, ab = {0.f, 0.f, 0.f, 0.f};
            if (iff >= jf) {
                af = __builtin_amdgcn_mfma_f32_16x16x32_bf16(ldfrag(kif, 72, jf * 16, 0, fr, fq), ldfrag(qdf, 72, iff * 16, 0, fr, fq), af, 0, 0, 0);
                af = __builtin_amdgcn_mfma_f32_16x16x32_bf16(ldfrag(kif, 72, jf * 16, 32, fr, fq), ldfrag(qdf, 72, iff * 16, 32, fr, fq), af, 0, 0, 0); }
            if (iff <= jf) {
                ab = __builtin_amdgcn_mfma_f32_16x16x32_bf16(ldfrag(kib, 72, jf * 16, 0, fr, fq), ldfrag(qdb, 72, iff * 16, 0, fr, fq), ab, 0, 0, 0);
                ab = __builtin_amdgcn_mfma_f32_16x16x32_bf16(ldfrag(kib, 72, jf * 16, 32, fr, fq), ldfrag(qdb, 72, iff * 16, 32, fr, fq), ab, 0, 0, 0); }
            const int i = iff * 16 + fr, j0 = jf * 16 + fq * 4;
            float r[4];
#pragma unroll
            for (int e = 0; e < 4; ++e) r[e] = (j0 + e <= i) ? af[e] : ab[e];
            *(u32x2*)(att + i * 72 + j0) = (u32x2){cvt_pk(r[0], r[1]), cvt_pk(r[2], r[3])};
        }
    }
    __syncthreads();
    {   const int vf = wid;
        const bf16x8 vt0 = ldfrag(vT, 72, vf * 16, 0, fr, fq), vt1 = ldfrag(vT, 72, vf * 16, 32, fr, fq);
#pragma unroll
        for (int iff = 0; iff < 4; ++iff) {
            f32x4 acc = {0.f, 0.f, 0.f, 0.f};
            acc = __builtin_amdgcn_mfma_f32_16x16x32_bf16(vt0, ldfrag(att, 72, iff * 16, 0, fr, fq), acc, 0, 0, 0);
            acc = __builtin_amdgcn_mfma_f32_16x16x32_bf16(vt1, ldfrag(att, 72, iff * 16, 32, fr, fq), acc, 0, 0, 0);
            acc = __builtin_amdgcn_mfma_f32_16x16x32_bf16(sf0, ldfrag(qdf, 72, iff * 16, 0, fr, fq), acc, 0, 0, 0);
            acc = __builtin_amdgcn_mfma_f32_16x16x32_bf16(sf1, ldfrag(qdf, 72, iff * 16, 32, fr, fq), acc, 0, 0, 0);
            acc = __builtin_amdgcn_mfma_f32_16x16x32_bf16(sb0, ldfrag(qdb, 72, iff * 16, 0, fr, fq), acc, 0, 0, 0);
            acc = __builtin_amdgcn_mfma_f32_16x16x32_bf16(sb1, ldfrag(qdb, 72, iff * 16, 32, fr, fq), acc, 0, 0, 0);
            *(f32x4*)(obuf + (iff * 16 + fr) * 128 + vf * 16 + fq * 4) = acc;
        }
    }
    __syncthreads();
    scan_c_tail(obuf, tid, gt0, gt1, row0, (bf16_t*)(p.ws + WS_YMIX), 1024 + h * 128);
    __syncthreads();
}

DEVI void scan_c_ret(const Params& p, int l, int b, int h, int c, const RetIn& in, char* smem) {
    float* obuf = (float*)smem;
    bf16_t* qs = (bf16_t*)(smem + 32768); bf16_t* ks = qs + 64 * 136; bf16_t* vT = ks + 64 * 136; bf16_t* att = vT + 128 * 72;
    const int tid = opaque_tid(), wid = tid >> 6, lane = tid & 63, fr = lane & 15, fq = lane >> 4;
    const int row0 = chunk_row0(b, c); const bool lat = c >= 4;
    const int tk = tid >> 3, kk16 = (tid & 7) * 16;
    float ldf, ldb; ret_decays(h, ldf, ldb);
    const bf16x8 gt0 = in.g0, gt1 = in.g1;
    const bf16_t* SF = (const bf16_t*)(p.ws + WS_STR) + ((size_t)((b * 4 + h) * 2 + 0) * NCH + order_idx(0, c)) * 16384;
    const bf16_t* SB = (const bf16_t*)(p.ws + WS_STR) + ((size_t)((b * 4 + h) * 2 + 1) * NCH + order_idx(1, c)) * 16384;
    bf16x8 sff[4], sbf[4];
#pragma unroll
    for (int ksx = 0; ksx < 4; ++ksx) { sff[ksx] = *(const bf16x8*)(SF + (wid * 16 + fr) * 128 + ksx * 32 + fq * 8); sbf[ksx] = *(const bf16x8*)(SB + (wid * 16 + fr) * 128 + ksx * 32 + fq * 8); }
    {   float qf[16], kf[16];
        ret_rot(in.q0, in.q1, in, lat, 1.f, qf);
        ret_rot(in.k0, in.k1, in, lat, 0.08838834764831845f, kf);
        float t0[8], t1[8];
#pragma unroll
        for (int e = 0; e < 8; ++e) { t0[e] = qf[e]; t1[e] = qf[8 + e]; }
        *(bf16x8*)(qs + tk * 136 + kk16) = pack8(t0); *(bf16x8*)(qs + tk * 136 + kk16 + 8) = pack8(t1);
#pragma unroll
        for (int e = 0; e < 8; ++e) { t0[e] = kf[e]; t1[e] = kf[8 + e]; }
        *(bf16x8*)(ks + tk * 136 + kk16) = pack8(t0); *(bf16x8*)(ks + tk * 136 + kk16 + 8) = pack8(t1);
        const bf16x8 v0 = in.v0, v1 = in.v1;
#pragma unroll
        for (int e = 0; e < 8; ++e) { vT[(kk16 + e) * 72 + tk] = (bf16_t)v0[e]; vT[(kk16 + 8 + e) * 72 + tk] = (bf16_t)v1[e]; }
    }
    __syncthreads();
    {   const int jf = wid & 3;
#pragma unroll
        for (int q = 0; q < 2; ++q) { const int iff = (wid >> 2) * 2 + q;
            f32x4 a = {0.f, 0.f, 0.f, 0.f};
#pragma unroll
            for (int ksx = 0; ksx < 4; ++ksx) a = __builtin_amdgcn_mfma_f32_16x16x32_bf16(ldfrag(ks, 136, jf * 16, ksx * 32, fr, fq), ldfrag(qs, 136, iff * 16, ksx * 32, fr, fq), a, 0, 0, 0);
            const int i = iff * 16 + fr, j0 = jf * 16 + fq * 4;
            float r[4];
#pragma unroll
            for (int e = 0; e < 4; ++e) { const int j = j0 + e; r[e] = a[e] * ((j <= i) ? __expf(ldf * (float)(i - j)) : __expf(ldb * (float)(j - i))); }
            *(u32x2*)(att + i * 72 + j0) = (u32x2){cvt_pk(r[0], r[1]), cvt_pk(r[2], r[3])};
        }
    }
    __syncthreads();
    {   const int vf = wid;
        const bf16x8 vt0 = ldfrag(vT, 72, vf * 16, 0, fr, fq), vt1 = ldfrag(vT, 72, vf * 16, 32, fr, fq);
#pragma unroll
        for (int iff = 0; iff < 4; ++iff) {
            const int i = iff * 16 + fr;
            const float sf = __expf(ldf * (float)(i + 1)), sb = __expf(ldb * (float)(64 - i));
            f32x4 acc = {0.f, 0.f, 0.f, 0.f}, accf = {0.f, 0.f, 0.f, 0.f}, accb = {0.f, 0.f, 0.f, 0.f};
            acc = __builtin_amdgcn_mfma_f32_16x16x32_bf16(vt0, ldfrag(att, 72, iff * 16, 0, fr, fq), acc, 0, 0, 0);
            acc = __builtin_amdgcn_mfma_f32_16x16x32_bf16(vt1, ldfrag(att, 72, iff * 16, 32, fr, fq), acc, 0, 0, 0);
#pragma unroll
            for (int ksx = 0; ksx < 4; ++ksx) { const bf16x8 qv = ldfrag(qs, 136, iff * 16, ksx * 32, fr, fq);
                accf = __builtin_amdgcn_mfma_f32_16x16x32_bf16(sff[ksx], qv, accf, 0, 0, 0);
                accb = __builtin_amdgcn_mfma_f32_16x16x32_bf16(sbf[ksx], qv, accb, 0, 0, 0); }
            *(f32x4*)(obuf + i * 128 + vf * 16 + fq * 4) = acc + sf * accf + sb * accb;
        }
    }
    __syncthreads();
    scan_c_tail(obuf, tid, gt0, gt1, row0, (bf16_t*)(p.ws + WS_YMIX), 1536 + h * 128);
    __syncthreads();
}

namespace att {
constexpr int DQ = 192, DV = 128, NW = 8, QBLK = 32, KVBLK = 64;
constexpr int SHM_V = KVBLK * DV * 2, SHM_K = KVBLK * 400;
constexpr float THR = 8.f;
#define KSWZ(row, colB) ((row) * 400 + (colB))
#define SBAR() __builtin_amdgcn_sched_barrier(0)
DEVI int crow(int r, int hi) { return (r & 3) + 8 * (r >> 2) + 4 * hi; }
DEVI unsigned cvtpk(float lo, float hi) { unsigned r; asm volatile("v_cvt_pk_bf16_f32 %0, %1, %2" : "=v"(r) : "v"(lo), "v"(hi)); return r; }
DEVI void partialSM(f32x16& p0, f32x16& p1, float& m_reg, float& mn, float& alpha) {
    constexpr float C = 1.4426950408889634f;
    float pmax = p0[0];
#pragma unroll
    for (int r = 1; r < 16; ++r) pmax = fmaxf(pmax, p0[r]);
#pragma unroll
    for (int r = 0; r < 16; ++r) pmax = fmaxf(pmax, p1[r]);
    { auto rr = __builtin_amdgcn_permlane32_swap(__float_as_uint(pmax), __float_as_uint(pmax), false, false);
      pmax = fmaxf(__uint_as_float(rr[0]), __uint_as_float(rr[1])); }
    if (__builtin_expect(__all(pmax - m_reg <= THR), 1)) { mn = m_reg; alpha = 1.f; }
    else { mn = fmaxf(m_reg, pmax); alpha = __builtin_amdgcn_exp2f((m_reg - mn) * C); m_reg = mn; }
    const float mnC = -mn * C;
#pragma unroll
    for (int r = 0; r < 16; ++r) p0[r] = fmaf(p0[r], C, mnC);
#pragma unroll
    for (int r = 0; r < 16; ++r) p1[r] = fmaf(p1[r], C, mnC);
#pragma unroll
    for (int r = 0; r < 16; ++r) p0[r] = __builtin_amdgcn_exp2f(p0[r]);
}
DEVI void finishSM(f32x16& p0, f32x16& p1, float alpha, float& l_reg, bf16x8& pa0, bf16x8& pa1, bf16x8& pa2, bf16x8& pa3) {
#pragma unroll
    for (int r = 0; r < 16; ++r) p1[r] = __builtin_amdgcn_exp2f(p1[r]);
    float ps = 0;
#pragma unroll
    for (int r = 0; r < 16; ++r) ps += p0[r];
#pragma unroll
    for (int r = 0; r < 16; ++r) ps += p1[r];
    { auto rr = __builtin_amdgcn_permlane32_swap(__float_as_uint(ps), __float_as_uint(ps), false, false);
      ps = __uint_as_float(rr[0]) + __uint_as_float(rr[1]); }
    l_reg = l_reg * alpha + ps;
#define PK4(P, BASE, OUT) do { unsigned a0 = cvtpk(P[BASE + 0], P[BASE + 1]), a1 = cvtpk(P[BASE + 2], P[BASE + 3]);   \
    unsigned b0 = cvtpk(P[BASE + 4], P[BASE + 5]), b1 = cvtpk(P[BASE + 6], P[BASE + 7]);                              \
    auto r0 = __builtin_amdgcn_permlane32_swap(a0, b0, false, false); auto r1 = __builtin_amdgcn_permlane32_swap(a1, b1, false, false); \
    u32x4 w = {r0[0], r1[0], r0[1], r1[1]}; OUT = __builtin_bit_cast(bf16x8, w); } while (0)
    PK4(p0, 0, pa0); PK4(p0, 8, pa1); PK4(p1, 0, pa2); PK4(p1, 8, pa3);
#undef PK4
}
DEVI void qkt(f32x16& p0, f32x16& p1, const char* Ks, const bf16x8* qr, const char* qL, int r32, int hi) {
    p0 = (f32x16){0.f, 0.f, 0.f, 0.f, 0.f, 0.f, 0.f, 0.f, 0.f, 0.f, 0.f, 0.f, 0.f, 0.f, 0.f, 0.f}; p1 = p0;
#pragma unroll
    for (int d0 = 0; d0 < 12; ++d0) { const int cb = (d0 * 16 + hi * 8) * 2;
        const bf16x8 b0 = *(const bf16x8*)(Ks + KSWZ(r32, cb));
        const bf16x8 b1 = *(const bf16x8*)(Ks + KSWZ(32 + r32, cb));
        const bf16x8 qv = (d0 < 8) ? qr[d0 < 8 ? d0 : 0] : *(const bf16x8*)(qL + (d0 - 8) * 1024);
        p0 = __builtin_amdgcn_mfma_f32_32x32x16_bf16(b0, qv, p0, 0, 0, 0);
        p1 = __builtin_amdgcn_mfma_f32_32x32x16_bf16(b1, qv, p1, 0, 0, 0); }
}
DEVI int v_st(int k, int c) { const int kk = (k & ~0xC) | ((k & 4) << 1) | ((k & 8) >> 1); return ((kk >> 3) * 4 + (c >> 5)) * 512 + ((kk & 7) * 32 + (c & 31)) * 2; }
DEVI int v_rd_base(int lane) { return ((lane & 3) << 3) | (((lane >> 2) & 3) << 6) | (((lane >> 4) & 1) << 5) | (((lane >> 5) & 1) << 8); }
constexpr int v_rd_off(int d0, int ks, int half) { return d0 * 512 + ks * 4096 + half * 2048; }
template <int OFF> DEVI s16x4 tr_read(int vb) { s16x4 r; asm volatile("ds_read_b64_tr_b16 %0, %1 offset:%2" : "=&v"(r) : "v"(vb), "i"(OFF) : "memory"); return r; }
template <int D0> DEVI void pv_one(f32x16& od, int vb, bf16x8 pa0, bf16x8 pa1, bf16x8 pa2, bf16x8 pa3) {
    const s16x4 l0 = tr_read<v_rd_off(D0, 0, 0)>(vb), h0 = tr_read<v_rd_off(D0, 0, 1)>(vb), l1 = tr_read<v_rd_off(D0, 1, 0)>(vb), h1 = tr_read<v_rd_off(D0, 1, 1)>(vb);
    const s16x4 l2 = tr_read<v_rd_off(D0, 2, 0)>(vb), h2 = tr_read<v_rd_off(D0, 2, 1)>(vb), l3 = tr_read<v_rd_off(D0, 3, 0)>(vb), h3 = tr_read<v_rd_off(D0, 3, 1)>(vb);
    asm volatile("s_waitcnt lgkmcnt(0)" ::: "memory"); SBAR();
#define PKV(L, H) (bf16x8){L[0], L[1], L[2], L[3], H[0], H[1], H[2], H[3]}
    od = __builtin_amdgcn_mfma_f32_32x32x16_bf16(pa0, PKV(l0, h0), od, 0, 0, 0);
    od = __builtin_amdgcn_mfma_f32_32x32x16_bf16(pa1, PKV(l1, h1), od, 0, 0, 0);
    od = __builtin_amdgcn_mfma_f32_32x32x16_bf16(pa2, PKV(l2, h2), od, 0, 0, 0);
    od = __builtin_amdgcn_mfma_f32_32x32x16_bf16(pa3, PKV(l3, h3), od, 0, 0, 0);
#undef PKV
}
DEVI void pv_d0(f32x16* o, int vb, bf16x8 pa0, bf16x8 pa1, bf16x8 pa2, bf16x8 pa3) {
    pv_one<0>(o[0], vb, pa0, pa1, pa2, pa3); pv_one<1>(o[1], vb, pa0, pa1, pa2, pa3); pv_one<2>(o[2], vb, pa0, pa1, pa2, pa3); pv_one<3>(o[3], vb, pa0, pa1, pa2, pa3);
}
DEVI void attn_body(const bf16_t* __restrict__ Qb, const bf16_t* __restrict__ Kh, const bf16_t* __restrict__ Vh, bf16_t* __restrict__ Ob, int seq, char* lds) {
    const int tid = opaque_tid(), wid = tid >> 6, lane = tid & 63, r32 = lane & 31, hi = lane >> 5;
    char* V_lds = lds; char* K_lds = lds + 2 * SHM_V;
    float* wsf = (float*)(lds + 2 * SHM_V + 2 * SHM_K) + wid * 64; float* li_l = wsf; float* al_l = wsf + 32;
    float m_reg = -1e30f, l_reg = 0;
    f32x16 o[4];
#pragma unroll
    for (int d = 0; d < 4; ++d) o[d] = (f32x16){0.f, 0.f, 0.f, 0.f, 0.f, 0.f, 0.f, 0.f, 0.f, 0.f, 0.f, 0.f, 0.f, 0.f, 0.f, 0.f};
    bf16x8 qr[8];
    const bf16_t* Qw = Qb + (size_t)(wid * QBLK + r32) * DQ + hi * 8;
    char* qL = lds + 2 * SHM_V + 2 * SHM_K + NW * 64 * 4 + wid * 4096 + lane * 16;
#pragma unroll
    for (int d0 = 0; d0 < 8; ++d0) qr[d0] = *(const bf16x8*)(Qw + d0 * 16);
#pragma unroll
    for (int d0 = 8; d0 < 12; ++d0) *(bf16x8*)(qL + (d0 - 8) * 1024) = *(const bf16x8*)(Qw + d0 * 16);
    const int sr = tid >> 4, sc = (tid & 15) * 8, vst0 = v_st(sr, sc), vst1 = v_st(32 + sr, sc);
    const int kr0 = tid / 24, kc0 = (tid % 24) * 8, kr1 = (tid + 512) / 24, kc1 = ((tid + 512) % 24) * 8, kr2 = (tid + 1024) / 24, kc2 = ((tid + 1024) % 24) * 8;
    const int kst0 = KSWZ(kr0, kc0 * 2), kst1 = KSWZ(kr1, kc1 * 2), kst2 = KSWZ(kr2, kc2 * 2);
    const int vb0 = (int)(uintptr_t)V_lds + v_rd_base(lane);
    bf16x8 sv0, sv1, sk0, sk1, sk2;
#define SLOAD(k0) do { sv0 = *(const bf16x8*)(Vh + (size_t)((k0) + sr) * DV + sc); sv1 = *(const bf16x8*)(Vh + (size_t)((k0) + 32 + sr) * DV + sc); \
    sk0 = *(const bf16x8*)(Kh + (size_t)((k0) + kr0) * DQ + kc0); sk1 = *(const bf16x8*)(Kh + (size_t)((k0) + kr1) * DQ + kc1); sk2 = *(const bf16x8*)(Kh + (size_t)((k0) + kr2) * DQ + kc2); } while (0)
#define SWRITE(b) do { *(bf16x8*)(V_lds + (b) * SHM_V + vst0) = sv0; *(bf16x8*)(V_lds + (b) * SHM_V + vst1) = sv1; \
    *(bf16x8*)(K_lds + (b) * SHM_K + kst0) = sk0; *(bf16x8*)(K_lds + (b) * SHM_K + kst1) = sk1; *(bf16x8*)(K_lds + (b) * SHM_K + kst2) = sk2; } while (0)
#define RESC(a) do { if (__any((a) < 1.f)) { if (hi == 0) al_l[r32] = (a); asm volatile("s_waitcnt lgkmcnt(0)" ::: "memory"); \
    _Pragma("unroll") for (int d = 0; d < 4; ++d) _Pragma("unroll") for (int r = 0; r < 16; ++r) o[d][r] *= al_l[crow(r, hi)]; } } while (0)
    f32x16 pA0, pA1, pB0, pB1; float mnA, mnB, alA, alB; bf16x8 pa0, pa1, pa2, pa3; const int NT = seq / KVBLK;
    SLOAD(0); SWRITE(0); __syncthreads();
    qkt(pA0, pA1, K_lds, qr, qL, r32, hi); partialSM(pA0, pA1, m_reg, mnA, alA);
    SLOAD(KVBLK); SWRITE(1); __syncthreads();
    for (int j = 1; j + 1 < NT; j += 2) {
        SBAR(); qkt(pB0, pB1, K_lds + SHM_K, qr, qL, r32, hi);
        finishSM(pA0, pA1, alA, l_reg, pa0, pa1, pa2, pa3); SBAR();
        SLOAD((j + 1) * KVBLK); SBAR();
        pv_d0(o, vb0, pa0, pa1, pa2, pa3); partialSM(pB0, pB1, m_reg, mnB, alB);
        __syncthreads(); SWRITE(0);
        RESC(alB); __syncthreads();
        SBAR(); qkt(pA0, pA1, K_lds, qr, qL, r32, hi);
        finishSM(pB0, pB1, alB, l_reg, pa0, pa1, pa2, pa3); SBAR();
        SLOAD((j + 2) * KVBLK); SBAR();
        pv_d0(o, vb0 + SHM_V, pa0, pa1, pa2, pa3); partialSM(pA0, pA1, m_reg, mnA, alA);
        __syncthreads(); SWRITE(1);
        RESC(alA); __syncthreads();
    }
    SBAR(); qkt(pB0, pB1, K_lds + SHM_K, qr, qL, r32, hi);
    finishSM(pA0, pA1, alA, l_reg, pa0, pa1, pa2, pa3); SBAR();
    pv_d0(o, vb0, pa0, pa1, pa2, pa3); partialSM(pB0, pB1, m_reg, mnB, alB);
    __syncthreads(); RESC(alB);
    finishSM(pB0, pB1, alB, l_reg, pa0, pa1, pa2, pa3); SBAR();
    pv_d0(o, vb0 + SHM_V, pa0, pa1, pa2, pa3);
    if (hi == 0) li_l[r32] = l_reg; asm volatile("s_waitcnt lgkmcnt(0)" ::: "memory");
    float rli[16];
#pragma unroll
    for (int r = 0; r < 16; ++r) rli[r] = __builtin_amdgcn_rcpf(li_l[crow(r, hi)]);
    bf16_t* Ow = Ob + (size_t)(wid * QBLK) * DM;
#pragma unroll
    for (int r = 0; r < 16; ++r) { const int orow = crow(r, hi);
#pragma unroll
        for (int d0 = 0; d0 < 4; ++d0) Ow[(size_t)orow * DM + d0 * 32 + r32] = f2bf(o[d0][r] * rli[r]); }
    __syncthreads();
#undef SLOAD
#undef SWRITE
#undef RESC
}
}

template <int WIDTH>
DEVI void rstd_table(const bf16_t* P, int row0, int col0, float* rs) {
    constexpr int hw = WIDTH >> 1;
    const int tid = opaque_tid(), r = tid >> 1, half = tid & 1;
    const bf16_t* src = P + (size_t)(row0 + r) * INC + col0 + half * hw;
    float ss = 0.f;
#pragma unroll
    for (int i0 = 0; i0 < hw; i0 += 128) {
        bf16x8 t[16];
#pragma unroll
        for (int i = 0; i < 16; ++i) t[i] = *(const bf16x8*)(src + i0 + i * 8);
#pragma unroll
        for (int i = 0; i < 16; ++i) { float f[8]; unpack8(t[i], f);
#pragma unroll
            for (int e = 0; e < 8; ++e) ss += f[e] * f[e]; }
    }
    ss += __shfl_xor(ss, 1);
    if (half == 0) rs[r] = rsqrtf(ss / (float)WIDTH + EPS);
    __syncthreads();
}
struct EpiQ { static constexpr bool PERM = true; bf16_t* Q; const float* rs; const float* rax;
    DEVI void operator()(const f32x4 (&acc)[2][2][4][2], const pg8::Unit& u, int wr, int wc, int fr, int fq) const {
#pragma unroll
        for (int ai = 0; ai < 2; ++ai)
#pragma unroll
            for (int m = 0; m < 4; ++m) { const int rl = ai * 128 + wr * 64 + m * 16 + fr, row = u.pm * 256 + rl; const float sc = rs[u.ord * 256 + rl] * QSCALE;
                const bool lat = row < NLAT; const int b = lat ? (row >> 11) : ((row - NLAT) >> 8); const int t = lat ? (row & 2047) : ((row - NLAT) & 255);
                const int qpos = lat ? (CL + t) : t;
#pragma unroll
                for (int bj = 0; bj < 2; ++bj) { const int col = u.pn * 256 + bj * 128 + wc * 32 + 8 * fq; const int head = col / 192, d = col - head * 192;
                    f32x4 v0 = acc[ai][bj][m][0] * sc, v1 = acc[ai][bj][m][1] * sc;
                    if (lat && d >= 128) { const int pi = (d - 128) >> 1; const int pos = (pi < 16) ? (t >> 6) : (t & 63);
                        const f32x4 c0 = *(const f32x4*)(rax + (pos * 16 + (pi & 15)) * 2), c1 = *(const f32x4*)(rax + (pos * 16 + (pi & 15)) * 2 + 4);
                        v0 = (f32x4){v0[0] * c0[0] - v0[1] * c0[1], v0[0] * c0[1] + v0[1] * c0[0], v0[2] * c0[2] - v0[3] * c0[3], v0[2] * c0[3] + v0[3] * c0[2]};
                        v1 = (f32x4){v1[0] * c1[0] - v1[1] * c1[1], v1[0] * c1[1] + v1[1] * c1[0], v1[2] * c1[2] - v1[3] * c1[3], v1[2] * c1[3] + v1[3] * c1[2]}; }
                    *(u32x4*)(Q + ((size_t)(b * 8 + head) * KEYS + qpos) * 192 + d) = (u32x4){cvt_pk(v0[0], v0[1]), cvt_pk(v0[2], v0[3]), cvt_pk(v1[0], v1[1]), cvt_pk(v1[2], v1[3])}; }
                __builtin_amdgcn_sched_barrier(0); }
    } };
struct EpiKV { static constexpr bool PERM = true; bf16_t* Kb; bf16_t* Vb; const float* rs;
    DEVI void operator()(const f32x4 (&acc)[2][2][4][2], const pg8::Unit& u, int wr, int wc, int fr, int fq) const {
#pragma unroll
        for (int ai = 0; ai < 2; ++ai)
#pragma unroll
            for (int m = 0; m < 4; ++m) { const int rl = ai * 128 + wr * 64 + m * 16 + fr, row = u.pm * 256 + rl; const float sc = rs[u.ord * 256 + rl];
                const bool lat = row < NLAT; const int b = lat ? (row >> 11) : ((row - NLAT) >> 8); const int t = lat ? (row & 2047) : ((row - NLAT) & 255);
                const int kpos = lat ? (CL + t) : t; const int d = wc * 32 + 8 * fq;
                { const f32x4 v0 = acc[ai][0][m][0] * sc, v1 = acc[ai][0][m][1] * sc;
                  *(u32x4*)(Kb + ((size_t)(b * 8 + u.pn) * KEYS + kpos) * 192 + d) = (u32x4){cvt_pk(v0[0], v0[1]), cvt_pk(v0[2], v0[3]), cvt_pk(v1[0], v1[1]), cvt_pk(v1[2], v1[3])}; }
                { const f32x4 v0 = acc[ai][1][m][0] * sc, v1 = acc[ai][1][m][1] * sc;
                  *(u32x4*)(Vb + ((size_t)(b * 8 + u.pn) * KEYS + kpos) * 128 + d) = (u32x4){cvt_pk(v0[0], v0[1]), cvt_pk(v0[2], v0[3]), cvt_pk(v1[0], v1[1]), cvt_pk(v1[2], v1[3])}; } }
    } };

DEVI void phase_l2(const Params& p, int l, char* smem) {
    const bf16_t* P = (const bf16_t*)(p.ws + WS_P);
    float* rsq = (float*)(smem + 131072); float* rskv = rsq + 4 * 256;
    const float* rax = (const float*)(p.ws + WS_RAX);
    const int nqm = (l == 0) ? 36 : 32, nq = nqm * 6, nkv = 36 * 8, nsc = 2 * 16 * NCH;
    const pg8::PlainSched Sq{P, (const bf16_t*)(p.ws + WS_WUQ) + (size_t)l * 1536 * 512, INC, C_CQ, 512, nqm, 6, nq};
    const pg8::PlainSched Skv{P, (const bf16_t*)(p.ws + WS_WUKV) + (size_t)l * 2048 * 256, INC, C_CKV, 256, 36, 8, nkv};
    for (int i = 0; i < 4; ++i) { pg8::Unit u; if (Sq.next(i, u)) rstd_table<512>(P, u.pm * 256, C_CQ, rsq + i * 256); }
    for (int i = 0; i < 4; ++i) { pg8::Unit u; if (Skv.next(i, u)) rstd_table<256>(P, u.pm * 256, C_CKV, rskv + i * 256); }
#ifndef L2_GEMM_REP
#define L2_GEMM_REP 1
#endif
#ifndef L2_SCAN_REP
#define L2_SCAN_REP 1
#endif
#pragma nounroll
    for (int rep = 0; rep < L2_GEMM_REP; ++rep) {
    SUB(0) { pg8::gemm_phase((LAS unsigned char*)smem, 512, Sq, EpiQ{(bf16_t*)(p.ws + WS_Q), rsq, rax}); }
    SUB(1) { pg8::gemm_phase((LAS unsigned char*)smem, 256, Skv, EpiKV{(bf16_t*)(p.ws + WS_K), (bf16_t*)(p.ws + WS_V), rskv}); }
    }
    for (int i = 0; i < 4; ++i) {
        pg8::Unit uk; if (!Skv.next(i, uk)) break;
        const int pm = uk.pm, pn = uk.pn;
        bf16_t* Kb = (bf16_t*)(p.ws + WS_K);
        const int tid = opaque_tid(), rl = tid >> 1, half = tid & 1, row = pm * 256 + rl;
        const bool lat = row < NLAT; const int b = lat ? (row >> 11) : ((row - NLAT) >> 8); const int t = lat ? (row & 2047) : ((row - NLAT) & 255);
        const int kpos = lat ? (CL + t) : t;
        bf16_t* dst = Kb + ((size_t)(b * 8 + pn) * KEYS + kpos) * 192 + 128 + half * 32;
#pragma unroll
        for (int q = 0; q < 4; ++q) {
            float f[8]; unpack8(*(const bf16x8*)(P + (size_t)row * INC + C_KR + half * 32 + q * 8), f);
            if (lat) {
#pragma unroll
                for (int e = 0; e < 4; ++e) { const int pi = half * 16 + q * 4 + e; const int pos = (pi < 16) ? (t >> 6) : (t & 63);
                    const f32x2 cs = *(const f32x2*)(rax + (pos * 16 + (pi & 15)) * 2);
                    const float x1 = f[2 * e], x2 = f[2 * e + 1]; f[2 * e] = x1 * cs[0] - x2 * cs[1]; f[2 * e + 1] = x1 * cs[1] + x2 * cs[0]; }
            }
            *(bf16x8*)(dst + q * 8) = pack8(f);
        }
    }
    __syncthreads();
    {
        const int G = gridDim.x, nG = 16 * NCH;
        int u = (obid() + (G >> 1)) % G;
        {   GlaIn cur; bool have = u < nG;
            if (have) gla_load(p, l, (u / NCH) >> 2, (u / NCH) & 3, u % NCH, false, cur);
            while (have) { const int un = u + G; const bool hn = un < nG; GlaIn nxt;
                if (hn) gla_load(p, l, (un / NCH) >> 2, (un / NCH) & 3, un % NCH, false, nxt);
                CvtIn ci; cvt8_load(p, l, (l == 0 ? TS0A : TS1A) + u, ci);
                SUB(2) scan_a_gla(p, l, (u / NCH) >> 2, (u / NCH) & 3, u % NCH, cur, smem);
                cvt8_finish(p, l, (l == 0 ? TS0A : TS1A) + u, ci, smem);
                cur = nxt; u = un; have = hn; } }
        {   RetIn cur; bool have = u < nsc;
            if (have) { const int r = u - nG; ret_load(p, (r / NCH) >> 2, (r / NCH) & 3, r % NCH, false, cur); }
            while (have) { const int un = u + G; const bool hn = un < nsc; RetIn nxt; const int r = u - nG, rn = un - nG;
                if (hn) ret_load(p, (rn / NCH) >> 2, (rn / NCH) & 3, rn % NCH, false, nxt);
                CvtIn ci; cvt8_load(p, l, (l == 0 ? TS0A : TS1A) + u, ci);
                SUB(3) scan_a_ret(p, l, (r / NCH) >> 2, (r / NCH) & 3, r % NCH, cur, smem);
                cvt8_finish(p, l, (l == 0 ? TS0A : TS1A) + u, ci, smem);
                cur = nxt; u = un; have = hn; } }
    }
}

DEVI void phase_l4(const Params& p, int l, char* smem) {
    const bf16_t* Q = (const bf16_t*)(p.ws + WS_Q); const bf16_t* Kb = (const bf16_t*)(p.ws + WS_K); const bf16_t* Vb = (const bf16_t*)(p.ws + WS_V);
    bf16_t* ymix = (bf16_t*)(p.ws + WS_YMIX);
    const int nal = 256, nac = (l == 0) ? 32 : 0, ncs = (l == 0) ? NCH : 32, nsc = 2 * 16 * ncs;
#ifndef L4_ATT_REP
#define L4_ATT_REP 1
#endif
#ifndef L4_SCAN_REP
#define L4_SCAN_REP 1
#endif
    phase_prefix(p, smem);
    asm volatile("s_waitcnt vmcnt(0)" ::: "memory");
    __syncthreads();
    if (threadIdx.x == 0) { __builtin_amdgcn_fence(__ATOMIC_RELEASE, "agent"); asm volatile("s_waitcnt vmcnt(0)" ::: "memory");
        __hip_atomic_fetch_add((unsigned*)(p.ws + WS_BAR) + PFXCNT_WORD + 64 * l, 1u, __ATOMIC_RELAXED, __HIP_MEMORY_SCOPE_AGENT); }
    const bool spec = (l == 0) && gridDim.x == 256;
    const bool conv = spec && obid() >= 256 - L4NC, dbl = spec && !conv && obid() >= 256 - 2 * L4NC;
    if (conv) { cvt8_stream3(p, 0, T0C + (obid() - (256 - L4NC)), L4NC, L4C0_PER, smem); cvt8_stream3(p, 1, T1C + (obid() - (256 - L4NC)), L4NC, L4C1_PER, smem); return; }
#pragma nounroll
    for (int rep = 0; rep < L4_ATT_REP; ++rep)
#pragma nounroll
    for (int it = 0; ; ++it) {
        int u;
        if (!spec) { u = obid() + it * gridDim.x; if (u >= nal + nac) break; }
        else { if (it >= 2) break; u = (it == 0) ? obid() : (obid() < nac ? nal + obid() : (dbl ? obid() + L4NC : -1)); if (u < 0) break; }
        if (u < nal) { SUB(4) {
            const int bh = u >> 3, qb = u & 7, b = bh >> 3, h = bh & 7;
            att::attn_body(Q + ((size_t)bh * KEYS + CL + qb * 256) * 192, Kb + (size_t)bh * KEYS * 192, Vb + (size_t)bh * KEYS * 128,
                           ymix + (size_t)(b * SEQ + qb * 256) * DM + h * 128, KEYS, smem);
        } } else { SUB(4) {
            const int bh = u - nal, b = bh >> 3, h = bh & 7;
            att::attn_body(Q + (size_t)bh * KEYS * 192, Kb + (size_t)bh * KEYS * 192, Vb + (size_t)bh * KEYS * 128,
                           ymix + (size_t)(NLAT + b * CL) * DM + h * 128, CL, smem);
        } }
    }
    if (dbl) return;
    if (threadIdx.x == 0) {
        unsigned* c = (unsigned*)(p.ws + WS_BAR) + PFXCNT_WORD + 64 * l; unsigned sp = 0;
        while (__hip_atomic_load(c, __ATOMIC_RELAXED, __HIP_MEMORY_SCOPE_AGENT) < gridDim.x) { __builtin_amdgcn_s_sleep(2); if (++sp > (1u << 22)) break; }
        __builtin_amdgcn_fence(__ATOMIC_ACQUIRE, "agent");
        asm volatile("s_waitcnt vmcnt(0)" ::: "memory");
    }
    __syncthreads();
    {
        const int G = spec ? 256 - 2 * L4NC : gridDim.x, nG = 16 * ncs, c0 = NCH - ncs;
        int u = spec ? obid() : (obid() + G - (nal + nac) % G) % G;
        {   GlaIn cur; bool have = u < nG;
            if (have) gla_load(p, l, (u / ncs) >> 2, (u / ncs) & 3, u % ncs + c0, true, cur);
            while (have) { const int un = u + G; const bool hn = un < nG; GlaIn nxt;
                if (hn) gla_load(p, l, (un / ncs) >> 2, (un / ncs) & 3, un % ncs + c0, true, nxt);
                CvtIn ci; cvt8_load(p, l, (l == 0 ? TS0C : TS1C) + u, ci);
                SUB(5) scan_c_gla(p, l, (u / ncs) >> 2, (u / ncs) & 3, u % ncs + c0, cur, smem);
                cvt8_finish(p, l, (l == 0 ? TS0C : TS1C) + u, ci, smem);
                cur = nxt; u = un; have = hn; } }
        {   RetIn cur; bool have = u < nsc;
            if (have) { const int r = u - nG; ret_load(p, (r / ncs) >> 2, (r / ncs) & 3, r % ncs + c0, true, cur); }
            while (have) { const int un = u + G; const bool hn = un < nsc; RetIn nxt; const int r = u - nG, rn = un - nG;
                if (hn) ret_load(p, (rn / ncs) >> 2, (rn / ncs) & 3, rn % ncs + c0, true, nxt);
                CvtIn ci; cvt8_load(p, l, (l == 0 ? TS0C : TS1C) + u, ci);
                SUB(6) scan_c_ret(p, l, (r / ncs) >> 2, (r / ncs) & 3, r % ncs + c0, cur, smem);
                cvt8_finish(p, l, (l == 0 ? TS0C : TS1C) + u, ci, smem);
                cur = nxt; u = un; have = hn; } }
    }
}

struct EpiOut { static constexpr bool PERM = false; const Params* pp; int l;
    DEVI void operator()(const f32x4 (&acc)[2][2][4][2], const pg8::Unit& u, int wr, int wc, int fr, int fq) const {
        const Params& p = *pp; float* xres = (float*)(p.ws + WS_XRES);
        const float* mod = (const float*)(p.ws + WS_MOD) + (size_t)l * 5 * 12288;
#pragma unroll
        for (int ai = 0; ai < 2; ++ai)
#pragma unroll
            for (int m = 0; m < 4; ++m) { const int row = u.pm * 256 + ai * 128 + wr * 64 + m * 16 + fr;
                const bool lat = row < NLAT; const int b = lat ? (row >> 11) : 4;
                const float* xin = (l == 0) ? (lat ? p.x + (size_t)row * DM : p.ctx + (size_t)(row - NLAT) * DM) : xres + (size_t)row * DM;
                const float* ga = mod + (size_t)b * 12288 + 4096;
#pragma unroll
                for (int bj = 0; bj < 2; ++bj)
#pragma unroll
                    for (int n = 0; n < 2; ++n) { const int col = u.pn * 256 + bj * 128 + wc * 32 + n * 16 + 4 * fq;
                        const f32x4 xo = *(const f32x4*)(xin + col); const f32x4 g = *(const f32x4*)(ga + col);
                        *(f32x4*)(xres + (size_t)row * DM + col) = xo + g * acc[ai][bj][m][n]; }
                __builtin_amdgcn_sched_barrier(0); }
    } };
DEVI void phase_wout(const Params& p, int l, char* smem) {
    const int nm = (l == 0) ? 36 : 32;
    pg8::PlainSched S{(const bf16_t*)(p.ws + WS_YMIX), (const bf16_t*)(p.ws + WS_WOUT) + (size_t)l * 2048 * 2048, DM, 0, 2048, nm, 8, nm * 8};
    pg8::gemm_phase((LAS unsigned char*)smem, 2048, S, EpiOut{&p, l});
    if (l == 0) tail_convert(p, 0, TAIL_WOUT_B0, T0A, TAILT_WOUT, smem);
}

template <int N>
DEVI void bitonic_desc(unsigned long long* key, int tid) {
    for (int k = 2; k <= N; k <<= 1)
        for (int j = k >> 1; j > 0; j >>= 1) {
            for (int t = tid; t < N / 2; t += 512) {
                const int i = ((t & ~(j - 1)) << 1) | (t & (j - 1)), q = i | j;
                const unsigned long long a = key[i], b = key[q];
                const bool desc = (i & k) == 0;
                if (desc ? (a < b) : (a > b)) { key[i] = b; key[q] = a; }
            }
            __syncthreads();
        }
}
DEVI void phase_rank(const Params& p, int l, char* smem) {
    unsigned long long* key = (unsigned long long*)smem;
    const float* aff = (const float*)(p.ws + WS_AFF);
    int* rank = (int*)(p.ws + WS_RANK); int* selrow = (int*)(p.ws + WS_SELROW); float* selgate = (float*)(p.ws + WS_SELGATE);
    const int tid = opaque_tid();
    const int nl = 64, nc = (l == 0) ? 64 : 0;
#ifndef RANK_REP
#define RANK_REP 1
#endif
#pragma nounroll
    for (int rep = 0; rep < RANK_REP; ++rep)
    for (int u = obid(); u < nl + nc; u += (gridDim.x == 256 ? 64 : gridDim.x)) {
        if (gridDim.x == 256 && obid() >= 64) break;
        if (u < nl) {
            const int be = u, b = be >> 4, e = be & 15;
            const float* a = aff + (size_t)be * KEYS;
            for (int i = tid; i < 2048; i += 512) key[i] = ((unsigned long long)__float_as_uint(a[i]) << 32) | (unsigned)(2047 - i);
            __syncthreads();
            bitonic_desc<2048>(key, tid);
            for (int pos = tid; pos < 2048; pos += 512) { const unsigned long long kv = key[pos]; const int i = 2047 - (int)(unsigned)(kv & 0xffffffffull);
                rank[(size_t)be * KEYS + i] = pos;
                if (pos < 256) { selrow[e * MSLOT + b * 256 + pos] = b * SEQ + i; selgate[e * MSLOT + b * 256 + pos] = __uint_as_float((unsigned)(kv >> 32)); } }
            __syncthreads();
        } else {
            const int be = u - nl, b = be >> 4, e = be & 15;
            const float* a = aff + (size_t)be * KEYS + SEQ;
            if (tid < 256) key[tid] = ((unsigned long long)__float_as_uint(a[tid]) << 32) | (unsigned)(255 - tid);
            __syncthreads();
            bitonic_desc<256>(key, tid);
            if (tid < 256) { const int pos = tid; const unsigned long long kv = key[pos]; const int i = 255 - (int)(unsigned)(kv & 0xffffffffull);
                rank[(size_t)be * KEYS + SEQ + i] = pos;
                if (pos < 32) { selrow[e * MSLOT + 1024 + b * 32 + pos] = NLAT + b * CL + i; selgate[e * MSLOT + 1024 + b * 32 + pos] = __uint_as_float((unsigned)(kv >> 32)); } }
            __syncthreads();
        }
    }
    if (gridDim.x == 256) {
        const int first = 64, bid = obid();
        const int nt = (l == 0) ? RANKT0 : RANKT1;
        if (bid >= first) cvt8_stream3(p, l, ((l == 0) ? T0B : T1B) + (bid - first), 256 - first, nt, smem);
    }
}

struct MoeGuSched { const bf16_t* hbuf; const bf16_t* Wgu; const int* selrow; int mvalid, nmt, units;
    DEVI bool next(int i, pg8::Unit& u) const {
        const int g = obid() + i * gridDim.x; if (g >= units) return false;
        int e, pm, pn;
        if (gridDim.x == 256) {
            const int c = g & 255, q = (g >> 8) * 32 + (c >> 3), per = nmt * 16, r = q % per, rr = r % (nmt * 4);
            e = 2 * (c & 7) + q / per; pm = rr % nmt; pn = (r / (nmt * 4)) * 4 + rr / nmt;
        } else { e = g / (nmt * 16); const int r = g % (nmt * 16); pm = r / 16; pn = r % 16; }
        u.e = e; u.pm = pm; u.pn = pn; u.ord = i; u.half = (nmt == 5 && pm == 4) ? 1 : 0;
        u.A = (const char*)hbuf; u.B = (const char*)Wgu + ((size_t)e * 4096 + u.pn * 256) * 2048; return true; }
    DEVI unsigned one(const pg8::Unit& u, int R, int C) const { const int slot = u.pm * 256 + R; const int row = (slot < mvalid) ? selrow[u.e * MSLOT + slot] : 0; return (unsigned)(row * (DM / 2) + C) * 2u; }
    DEVI void aoff(const pg8::Unit& u, int R0, int C0, int R1, int C1, unsigned (&o)[4]) const { o[0] = one(u, R0, C0); o[1] = one(u, R1, C1); o[2] = one(u, 128 + R0, C0); o[3] = one(u, 128 + R1, C1); }
};
struct EpiGU { static constexpr bool PERM = true; bf16_t* actb; int mvalid;
    DEVI void operator()(const f32x4 (&acc)[2][2][4][2], const pg8::Unit& u, int wr, int wc, int fr, int fq) const {
#pragma unroll
        for (int ai = 0; ai < 2; ++ai)
#pragma unroll
            for (int m = 0; m < 4; ++m) { const int slot = u.pm * 256 + ai * 128 + wr * 64 + m * 16 + fr;
                if (slot < mvalid) { const int col = u.pn * 128 + wc * 32 + 8 * fq;
                    constexpr float is = 1.f / W8_SCALE, us = ACT8_SCALE / W8_SCALE;
                    const f32x4 g0 = acc[ai][0][m][0] * is, g1 = acc[ai][0][m][1] * is, u0 = acc[ai][1][m][0] * us, u1 = acc[ai][1][m][1] * us;
                    *(u32x2*)((unsigned char*)actb + ((size_t)u.e * MSLOT + slot) * DM + col) = (u32x2){cvt4_fp8c(silu_f(g0[0]) * u0[0], silu_f(g0[1]) * u0[1], silu_f(g0[2]) * u0[2], silu_f(g0[3]) * u0[3]),
                                                                                                    cvt4_fp8c(silu_f(g1[0]) * u1[0], silu_f(g1[1]) * u1[1], silu_f(g1[2]) * u1[2], silu_f(g1[3]) * u1[3])}; } }
    } };
DEVI void phase_moe_gu(const Params& p, int l, char* smem) {
    const int mvalid = (l == 0) ? 1152 : 1024, nmt = (l == 0) ? 5 : 4;
    MoeGuSched S{(const bf16_t*)(p.ws + WS_H), (const bf16_t*)((const char*)(p.ws + WS_WGU) + (size_t)l * 16 * 4096 * 2048), (const int*)(p.ws + WS_SELROW), mvalid, nmt, 16 * nmt * 16};
    pg8::gemm_phase<MoeGuSched, EpiGU, true>((LAS unsigned char*)smem, 1024, S, EpiGU{(bf16_t*)(p.ws + WS_ACT), mvalid});
}
struct MoeDnSched { const bf16_t* actb; const bf16_t* Wdn; int nmt, units;
    DEVI bool next(int i, pg8::Unit& u) const {
        const int g = obid() + i * gridDim.x; if (g >= units) return false;
        int e, pm, pn;
        if (gridDim.x == 256 && nmt == 4) {
            const int c = g & 255, q = (g >> 8) * 32 + (c >> 3), per = nmt * 8, r = q % per, rr = r % (nmt * 4);
            e = 2 * (c & 7) + q / per; pm = rr % nmt; pn = (r / (nmt * 4)) * 4 + rr / nmt;
        } else { e = g / (nmt * 8); const int r = g % (nmt * 8); pm = r / 8; pn = r % 8; }
        u.e = e; u.pm = pm; u.pn = pn; u.ord = i; u.half = (nmt == 5 && pm == 4) ? 1 : 0;
        u.A = (const char*)actb + ((size_t)e * MSLOT + u.pm * 256) * DM; u.B = (const char*)Wdn + ((size_t)e * 2048 + u.pn * 256) * 2048; return true; }
    DEVI void aoff(const pg8::Unit&, int R0, int C0, int R1, int C1, unsigned (&o)[4]) const {
        o[0] = (unsigned)(R0 * (DM / 2) + C0) * 2u; o[1] = (unsigned)(R1 * (DM / 2) + C1) * 2u; o[2] = (unsigned)((128 + R0) * (DM / 2) + C0) * 2u; o[3] = (unsigned)((128 + R1) * (DM / 2) + C1) * 2u; }
};
struct EpiDN { static constexpr bool PERM = true; bf16_t* ydn; const float* selgate; int mvalid;
    DEVI void operator()(const f32x4 (&acc)[2][2][4][2], const pg8::Unit& u, int wr, int wc, int fr, int fq) const {
#pragma unroll
        for (int ai = 0; ai < 2; ++ai)
#pragma unroll
            for (int m = 0; m < 4; ++m) { const int slot = u.pm * 256 + ai * 128 + wr * 64 + m * 16 + fr;
                if (slot < mvalid) { const float gt = selgate[u.e * MSLOT + slot] * (1.f / (W8_SCALE * ACT8_SCALE));
#pragma unroll
                    for (int bj = 0; bj < 2; ++bj) { const int col = u.pn * 256 + bj * 128 + wc * 32 + 8 * fq; const f32x4 v0 = acc[ai][bj][m][0] * gt, v1 = acc[ai][bj][m][1] * gt;
                        *(u32x4*)(ydn + ((size_t)u.e * MSLOT + slot) * DM + col) = (u32x4){cvt_pk(v0[0], v0[1]), cvt_pk(v0[2], v0[3]), cvt_pk(v1[0], v1[1]), cvt_pk(v1[2], v1[3])}; } } }
    } };
DEVI void phase_moe_dn(const Params& p, int l, char* smem) {
    const int mvalid = (l == 0) ? 1152 : 1024, nmt = (l == 0) ? 5 : 4;
    MoeDnSched S{(const bf16_t*)(p.ws + WS_ACT), (const bf16_t*)((const char*)(p.ws + WS_WDN) + (size_t)l * 16 * 2048 * 2048), nmt, 16 * nmt * 8};
    pg8::gemm_phase<MoeDnSched, EpiDN, true>((LAS unsigned char*)smem, 1024, S, EpiDN{(bf16_t*)(p.ws + WS_YDN), (const float*)(p.ws + WS_SELGATE), mvalid});
    if (l == 0) tail_convert(p, 1, TAIL_DN_B0, 0, TAILT_DN, smem);
}

constexpr int NPHASE = 2 + 2 * 10;
__global__ void __launch_bounds__(512, 2) mega(Params p) {
    extern __shared__ __attribute__((aligned(1024))) char smem[];
    if (threadIdx.x == 0) *(uint4*)(smem + LDS_XB) = make_uint4(0u, 0u, 0u, 0u);
    __syncthreads();
    XcdBarrier bar = xcd_barrier_post((unsigned*)(p.ws + WS_BAR), (volatile LAS unsigned*)(smem + LDS_XB));
#ifndef PHMASK
#define PHMASK 0xFFFF
#endif
#ifndef PROBE_DUP
#define PROBE_DUP 0
#endif
#define RUN(bit, k, call) do { if constexpr ((PHMASK >> (bit)) & 1) { if ((k) >= p.ph_lo && (k) < p.ph_hi) { call; \
    if constexpr ((PROBE_DUP >> (bit)) & 1) { if ((bit) != 6 || l_probe == 0) { xcd_barrier(bar); call; } } \
    if ((k) + 1 < p.ph_hi) xcd_barrier(bar); } } } while (0)
    int l_probe = 0;
    RUN(0, 0, (phase_p0(p, smem), wait_mod(p), phase_rows<0>(p, 0, smem)));
#ifdef PROBE_XBAR
    for (int i = 0; i < PROBE_XBAR; ++i) xcd_barrier(bar);
#endif
    for (int l = 0; l < 2; ++l) {
        const int k0 = 2 + l * 10; l_probe = l;
        RUN(2, k0 + 0, phase_win(p, l, smem));
        RUN(3, k0 + 1, phase_l2(p, l, smem));
        RUN(5, k0 + 3, phase_l4(p, l, smem));
        RUN(6, k0 + 4, phase_wout(p, l, smem));
        RUN(7, k0 + 5, phase_rows<1>(p, l, smem));
        RUN(8, k0 + 6, phase_rank(p, l, smem));
        RUN(9, k0 + 7, phase_moe_gu(p, l, smem));
        RUN(10, k0 + 8, phase_moe_dn(p, l, smem));
        if (l == 0) RUN(11, k0 + 9, phase_rows<2>(p, 0, smem)); else RUN(12, k0 + 9, phase_rows<3>(p, 1, smem));
    }
#undef RUN
}

extern "C" void kernel_launch(void* const* d_in, const int* in_sizes, int n_in, void* d_out, int out_size, void* d_ws, size_t ws_size, hipStream_t stream) {
    static int grid = 0;
    if (!grid) {
        if (ws_size < WS_END) { fprintf(stderr, "kernel_launch: workspace too small: %zu < %zu\n", ws_size, (size_t)WS_END); return; }
        if (hipFuncSetAttribute((const void*)mega, hipFuncAttributeMaxDynamicSharedMemorySize, LDS_BYTES) != hipSuccess) { fprintf(stderr, "kernel_launch: LDS attribute failed\n"); return; }
        int dev = 0, cus = 0, per_cu = 0;
        hipGetDevice(&dev);
        hipDeviceGetAttribute(&cus, hipDeviceAttributeMultiprocessorCount, dev);
        hipOccupancyMaxActiveBlocksPerMultiprocessor(&per_cu, (const void*)mega, 512, LDS_BYTES);
        if (per_cu < 1) { fprintf(stderr, "kernel_launch: occupancy query says 0\n"); return; }
        grid = cus;
    }
    Params p{};
    p.x = (const float*)d_in[0]; p.c = (const float*)d_in[1]; p.ctx = (const float*)d_in[2]; p.c_ctx = (const float*)d_in[3];
    p.ada_w = (const float*)d_in[4]; p.ada_b = (const float*)d_in[5]; p.w_in = (const float*)d_in[6]; p.q_norm = (const float*)d_in[7];
    p.w_uq = (const float*)d_in[8]; p.kv_norm = (const float*)d_in[9]; p.w_ukv = (const float*)d_in[10]; p.gla_w2 = (const float*)d_in[11];
    p.gla_b = (const float*)d_in[12]; p.w_out = (const float*)d_in[13]; p.router_w = (const float*)d_in[14]; p.w_gate = (const float*)d_in[15];
    p.w_up = (const float*)d_in[16]; p.w_down = (const float*)d_in[17]; p.final_norm = (const float*)d_in[18];
    p.out = (float*)d_out; p.ws = (char*)d_ws;
    hipMemsetAsync((char*)d_ws + WS_BAR, 0, 16384, stream);
#if MK_ONE_LAUNCH
    p.ph_lo = 0; p.ph_hi = NPHASE;
    hipLaunchKernelGGL(mega, dim3(grid), dim3(512), LDS_BYTES, stream, p);
#else
    for (int k = 0; k < NPHASE; ++k) { p.ph_lo = k; p.ph_hi = k + 1; hipLaunchKernelGGL(mega, dim3(grid), dim3(512), LDS_BYTES, stream, p); }
#endif
    const hipError_t le = hipPeekAtLastError();
    if (le != hipSuccess) fprintf(stderr, "kernel_launch: launch failed: %s\n", hipGetErrorName(le));
}
```

```cpp
#include <hip/hip_runtime.h>
#include <stdint.h>
#include <stdio.h>

#ifndef MK_ONE_LAUNCH
#define MK_ONE_LAUNCH 1
#endif

#define DEVI __device__ __forceinline__
typedef unsigned short bf16_t;
typedef short bf16x8 __attribute__((ext_vector_type(8)));
typedef short s16x4 __attribute__((ext_vector_type(4)));
typedef float f32x2 __attribute__((ext_vector_type(2)));
typedef float f32x4 __attribute__((ext_vector_type(4)));
typedef float f32x8 __attribute__((ext_vector_type(8)));
typedef float f32x16 __attribute__((ext_vector_type(16)));
typedef unsigned u32x2 __attribute__((ext_vector_type(2)));
typedef unsigned u32x4 __attribute__((ext_vector_type(4)));
typedef int i32x4 __attribute__((ext_vector_type(4)));
typedef __bf16 bf16x2_t __attribute__((ext_vector_type(2)));

constexpr int DM = 2048, NB = 4, SEQ = 2048, CL = 256, NLAT = NB * SEQ, NCTX = NB * CL, NROW = NLAT + NCTX;
constexpr int INC = 4448, INCP = 4608;
constexpr int C_CQ = 0, C_CKV = 512, C_KR = 768, C_GQ = 832, C_GK = 1088, C_GV = 1344, C_GZ = 1856, C_GOG = 1888, C_RQ = 2400, C_RK = 2912, C_RV = 3424, C_RG = 3936;
constexpr int KEYS = SEQ + CL;
constexpr int NCH = 36;
constexpr int MSLOT = 1280;
constexpr float QSCALE = 0.07216878364870322f;
constexpr float EPS = 1e-6f;

constexpr size_t al256(size_t x) { return (x + 255) / 256 * 256; }
constexpr size_t WS_BAR = 0;
constexpr size_t WS_MOD = 16384;
constexpr size_t WS_RAX = WS_MOD + al256((size_t)2 * 5 * 12288 * 4);
constexpr size_t WS_RRET = WS_RAX + al256((size_t)64 * 16 * 2 * 4);
constexpr size_t WS_WIN = WS_RRET + al256((size_t)2048 * 64 * 2 * 4);
constexpr size_t WS_WUQ = WS_WIN + al256((size_t)2 * INCP * 2048 * 2);
constexpr size_t WS_WUKV = WS_WUQ + al256((size_t)2 * 1536 * 512 * 2);
constexpr size_t WS_WOUT = WS_WUKV + al256((size_t)2 * 2048 * 256 * 2);
constexpr size_t WS_WGU = WS_WOUT + al256((size_t)2 * 2048 * 2048 * 2);
constexpr size_t WS_WDN = WS_WGU + al256((size_t)2 * 16 * 4096 * 2048 * 2);
constexpr size_t WS_XRES = WS_WDN + al256((size_t)2 * 16 * 2048 * 2048 * 2);
constexpr size_t WS_H = WS_XRES + al256((size_t)NROW * DM * 4);
constexpr size_t WS_P = WS_H + al256((size_t)NROW * DM * 2);
constexpr size_t WS_Q = WS_P + al256((size_t)NROW * INC * 2);
constexpr size_t WS_K = WS_Q + al256((size_t)NB * 8 * KEYS * 192 * 2);
constexpr size_t WS_V = WS_K + al256((size_t)NB * 8 * KEYS * 192 * 2);
constexpr size_t WS_YMIX = WS_V + al256((size_t)NB * 8 * KEYS * 128 * 2);
constexpr size_t WS_UTG = WS_YMIX + al256((size_t)NROW * DM * 2);
constexpr size_t WS_UTR = WS_UTG + al256((size_t)32 * NCH * 128 * 64 * 4);
constexpr size_t WS_STG = WS_UTR + al256((size_t)32 * NCH * 128 * 128 * 4);
constexpr size_t WS_STR = WS_STG + al256((size_t)32 * NCH * 128 * 64 * 2);
constexpr size_t WS_DECG = WS_STR + al256((size_t)32 * NCH * 128 * 128 * 2);
constexpr size_t WS_AFF = WS_DECG + al256((size_t)32 * NCH * 64 * 4);
constexpr size_t WS_RANK = WS_AFF + al256((size_t)NB * 16 * KEYS * 4);
constexpr size_t WS_SELROW = WS_RANK + al256((size_t)NB * 16 * KEYS * 4);
constexpr size_t WS_SELGATE = WS_SELROW + al256((size_t)16 * MSLOT * 4);
constexpr size_t WS_ACT = WS_SELGATE + al256((size_t)16 * MSLOT * 4);
constexpr size_t WS_YDN = WS_ACT + al256((size_t)16 * MSLOT * 2048 * 2);
constexpr size_t WS_END = WS_YDN + al256((size_t)16 * MSLOT * 2048 * 2);

constexpr int MODCNT_WORD = 3584, P0_N_MOD_ITEMS = 768, PFXCNT_WORD = 3648;
constexpr int LDS_RS = 131072, LDS_XB = 131072 + 8192, LDS_BYTES = 131072 + 8192 + 64;
#ifndef SUBMASK
#define SUBMASK 0xFF
#endif
#define SUB(n) if constexpr ((SUBMASK >> (n)) & 1)

struct Params {
    const float *x, *c, *ctx, *c_ctx, *ada_w, *ada_b, *w_in, *q_norm, *w_uq, *kv_norm, *w_ukv, *gla_w2, *gla_b, *w_out, *router_w, *w_gate, *w_up, *w_down, *final_norm;
    float* out; char* ws; int ph_lo, ph_hi;
};

DEVI unsigned cvt_pk(float lo, float hi) { f32x2 v = {lo, hi}; bf16x2_t b = __builtin_convertvector(v, bf16x2_t); return __builtin_bit_cast(unsigned, b); }
DEVI bf16_t f2bf(float x) { return (bf16_t)(cvt_pk(x, 0.f) & 0xffffu); }
DEVI float bf2f(bf16_t b) { return __uint_as_float(((unsigned)b) << 16); }
DEVI float bflo(unsigned w) { return __uint_as_float(w << 16); }
DEVI float bfhi(unsigned w) { return __uint_as_float(w & 0xffff0000u); }
DEVI int obid() { int b = blockIdx.x; asm volatile("" : "+s"(b)); return b; }
DEVI int opaque_tid() { int t = threadIdx.x; asm volatile("" : "+v"(t)); return t; }
typedef int i32x8 __attribute__((ext_vector_type(8)));
DEVI float clamp8(float x) { return __builtin_amdgcn_fmed3f(x, -448.f, 448.f); }
DEVI unsigned cvt4_fp8(float a, float b, float c, float d) { int w = 0; w = __builtin_amdgcn_cvt_pk_fp8_f32(a, b, w, false); w = __builtin_amdgcn_cvt_pk_fp8_f32(c, d, w, true); return (unsigned)w; }
DEVI unsigned cvt4_fp8c(float a, float b, float c, float d) { return cvt4_fp8(clamp8(a), clamp8(b), clamp8(c), clamp8(d)); }
constexpr float W8_SCALE = 64.f, ACT8_SCALE = 4.f;
DEVI float silu_f(float x) { return x * __builtin_amdgcn_rcpf(1.f + __expf(-x)); }
DEVI float wave_sum(float s) {
#pragma unroll
    for (int off = 32; off >= 1; off >>= 1) s += __shfl_xor(s, off);
    return s;
}
DEVI void unpack8(bf16x8 v, float (&f)[8]) {
    u32x4 w = __builtin_bit_cast(u32x4, v);
#pragma unroll
    for (int i = 0; i < 4; ++i) { f[2 * i] = bflo(w[i]); f[2 * i + 1] = bfhi(w[i]); }
}
DEVI bf16x8 pack8(const float (&f)[8]) {
    u32x4 w = {cvt_pk(f[0], f[1]), cvt_pk(f[2], f[3]), cvt_pk(f[4], f[5]), cvt_pk(f[6], f[7])};
    return __builtin_bit_cast(bf16x8, w);
}

#define XB_TMO      128
#define XB_XCNT(j)  (256  + 64 * (j))
#define XB_XSUB(j)  (1280 + 64 * (j))
#define XB_XGEN(j)  (2304 + 64 * (j))
#define XB_TOP      3328
#define XB_TOPGEN   3392
#define XCD_BAR_WORDS 3456
#define XB_SPIN_CAP (1u << 18)
#define LAS __attribute__((address_space(3)))
DEVI unsigned xb_ld(unsigned* p)              { return __hip_atomic_load(p, __ATOMIC_RELAXED, __HIP_MEMORY_SCOPE_AGENT); }
DEVI unsigned xb_add(unsigned* p, unsigned v) { return __hip_atomic_fetch_add(p, v, __ATOMIC_RELAXED, __HIP_MEMORY_SCOPE_AGENT); }
DEVI unsigned xb_xcc_id() { return (unsigned)__builtin_amdgcn_s_getreg((3 << 11) | 20) & 0xFu; }
#define XB_SPIN(cond, bar) do { unsigned _sp = 0; while (cond) { __builtin_amdgcn_s_sleep(1); \
    if ((++_sp & 255u) == 0u) { if (xb_ld(&(bar)[XB_TMO])) break; if (_sp > XB_SPIN_CAP) { atomicAdd(&(bar)[XB_TMO], 1u); break; } } } } while (0)
struct XcdBarrier { unsigned* bar; unsigned x; volatile LAS unsigned* st; };
DEVI XcdBarrier xcd_barrier_post(unsigned* bar, volatile LAS unsigned* st) {
    XcdBarrier b; b.bar = bar; b.x = xb_xcc_id(); b.st = st;
    if (threadIdx.x == 0) (void)xb_add(&bar[XB_XCNT(b.x)], 1u);
    return b;
}
DEVI void xcd_barrier_complete(unsigned* bar, unsigned x, unsigned& nloc, unsigned& nx) {
    const unsigned G = gridDim.x * gridDim.y * gridDim.z;
    unsigned sum, cnt, mine, sp = 0u;
    for (;;) {
        sum = 0u; cnt = 0u; mine = 0u;
#pragma unroll
        for (unsigned j = 0; j < 16; ++j) { const unsigned c = xb_ld(&bar[XB_XCNT(j)]); sum += c; cnt += (c > 0u) ? 1u : 0u; mine = (j == x) ? c : mine; }
        if (sum == G) break;
        __builtin_amdgcn_s_sleep(1);
        if ((++sp & 255u) == 0u) { if (xb_ld(&bar[XB_TMO])) break; if (sp > XB_SPIN_CAP) { atomicAdd(&bar[XB_TMO], 1u); break; } }
    }
    nloc = mine > 0u ? mine : 1u; nx = cnt > 0u ? cnt : 1u;
}
DEVI void xcd_barrier(const XcdBarrier& b) {
    asm volatile("s_waitcnt vmcnt(0)" ::: "memory");
    __syncthreads();
    if (threadIdx.x == 0) {
        unsigned* bar = b.bar;
        __builtin_amdgcn_s_waitcnt(0);
        unsigned nloc = b.st[0], nx = b.st[1];
        if (nloc == 0u) { xcd_barrier_complete(bar, b.x, nloc, nx); b.st[0] = nloc; b.st[1] = nx; }
        const unsigned old = xb_add(&bar[XB_XSUB(b.x)], 1u);
        const unsigned gen = old / nloc;
        if (old + 1u == (gen + 1u) * nloc) {
            __builtin_amdgcn_fence(__ATOMIC_RELEASE, "agent");
            asm volatile("s_waitcnt vmcnt(0)" ::: "memory");
            const unsigned og = xb_add(&bar[XB_TOP], 1u);
            const unsigned tg = og / nx;
            if (og + 1u == (tg + 1u) * nx) xb_add(&bar[XB_TOPGEN], 1u);
            else XB_SPIN(xb_ld(&bar[XB_TOPGEN]) == tg, bar);
            __builtin_amdgcn_fence(__ATOMIC_ACQUIRE, "agent");
            xb_add(&bar[XB_XGEN(b.x)], 1u);
            asm volatile("s_waitcnt vmcnt(0)" ::: "memory");
        } else {
            XB_SPIN(xb_ld(&bar[XB_XGEN(b.x)]) == gen, bar);
            __builtin_amdgcn_fence(__ATOMIC_ACQUIRE, "agent");
            asm volatile("s_waitcnt vmcnt(0)" ::: "memory");
        }
    }
    __syncthreads();
}

namespace pg8 {
constexpr int BM = 256, BK = 64, HALF = 128, HTB = HALF * BK * 2, STAGE_BYTES = 8 * HTB;
DEVI int lds_byte(int r, int c) { const int st = (r >> 4) * 2 + (c >> 5), rr = r & 15, cc = c & 31, ob = rr * 64 + cc * 2; return st * 1024 + (ob ^ (((ob >> 9) & 1) << 5)); }
DEVI void stage_rc(int b, int& R, int& C) { const int st = b / 1024, sb = b % 1024, swz = sb ^ (((sb >> 9) & 1) << 5); R = (st >> 1) * 16 + swz / 64; C = (st & 1) * 32 + (swz % 64) / 2; }
DEVI int perm32(int rho) { const int n = rho >> 4, i = rho & 15; return 8 * (i >> 2) + 4 * n + (i & 3); }
struct Unit { const char* A; const char* B; int pm, pn, e, ord, half; };

template <class Sched, class Epi, bool FP8 = false>
DEVI void gemm_phase(LAS unsigned char* lds, const int K, const Sched& S, const Epi& E) {
    const int tid = opaque_tid(), wid = __builtin_amdgcn_readfirstlane(tid >> 6), lane = tid & 63, wr = wid >> 2, wc = wid & 3, fr = lane & 15, fq = lane >> 4;
    const int nt = K / BK;
    int R0, C0, R1, C1; stage_rc(tid * 16, R0, C0); stage_rc(tid * 16 + 8192, R1, C1);
    unsigned voffB[2];
    { const int Rb0 = Epi::PERM ? ((R0 & ~31) + perm32(R0 & 31)) : R0, Rb1 = Epi::PERM ? ((R1 & ~31) + perm32(R1 & 31)) : R1;
      voffB[0] = (unsigned)(Rb0 * K + C0) * 2u; voffB[1] = (unsigned)(Rb1 * K + C1) * 2u; }
    const size_t kstep = (size_t)(BK * 2);
    const size_t hstepB = (size_t)HALF * K * 2;
    const unsigned ldsw = (unsigned)wid * 1024u;
    const int aoff = lds_byte(wr * 64 + fr, fq * 8), boff = lds_byte(wc * 32 + fr, fq * 8);
#define PG8_SA(b, h) (((b) * 2 + (h)) * HTB)
#define PG8_SB(b, h) ((4 + (b) * 2 + (h)) * HTB)
#define PG8_STAGE2(bufoff, gbase, v0, v1) do { \
        __builtin_amdgcn_global_load_lds((const unsigned*)((const char*)(gbase) + (v0)), (LAS unsigned*)(lds + (bufoff) + ldsw), 16, 0, 0); \
        __builtin_amdgcn_global_load_lds((const unsigned*)((const char*)(gbase) + (v1)), (LAS unsigned*)(lds + (bufoff) + ldsw + 8192), 16, 0, 0); } while (0)
#define PG8_STAGEB(bufoff, gbase) PG8_STAGE2(bufoff, gbase, voffB[0], voffB[1])
#define PG8_RD8(addr) __builtin_shufflevector(*(const LAS i32x4*)(addr), *(const LAS i32x4*)((addr) + 1024), 0, 1, 2, 3, 4, 5, 6, 7)
#define PG8_LDA(dst, b, h) do { if constexpr (FP8) { _Pragma("unroll") for (int m = 0; m < 4; ++m) dst##8[m] = PG8_RD8(lds + PG8_SA(b, h) + aoff + m * 2048); } \
        else { _Pragma("unroll") for (int m = 0; m < 4; ++m) _Pragma("unroll") for (int k = 0; k < 2; ++k) dst[m][k] = *(const LAS bf16x8*)(lds + PG8_SA(b, h) + aoff + m * 2048 + k * 1024); } } while (0)
#define PG8_LDB(dst, b, h) do { if constexpr (FP8) { _Pragma("unroll") for (int n = 0; n < 2; ++n) dst##8[n] = PG8_RD8(lds + PG8_SB(b, h) + boff + n * 2048); } \
        else { _Pragma("unroll") for (int n = 0; n < 2; ++n) _Pragma("unroll") for (int k = 0; k < 2; ++k) dst[n][k] = *(const LAS bf16x8*)(lds + PG8_SB(b, h) + boff + n * 2048 + k * 1024); } } while (0)
#define PG8_MMA(ai, bj, At, Bt) do { __builtin_amdgcn_s_setprio(1); _Pragma("unroll") for (int m = 0; m < 4; ++m) _Pragma("unroll") for (int n = 0; n < 2; ++n) { \
        if constexpr (FP8) asm volatile("v_mfma_scale_f32_16x16x128_f8f6f4 %0, %1, %2, %0, %3, %3 op_sel_hi:[0,0,0]" : "+v"(acc[ai][bj][m][n]) : "v"(Bt##8[n]), "v"(At##8[m]), "v"(mx_one));   \
        else { _Pragma("unroll") for (int k = 0; k < 2; ++k) acc[ai][bj][m][n] = __builtin_amdgcn_mfma_f32_16x16x32_bf16(Bt[n][k], At[m][k], acc[ai][bj][m][n], 0, 0, 0); } } \
        __builtin_amdgcn_s_setprio(0); } while (0)
#define PG8_WAIT_V(n) asm volatile("s_waitcnt vmcnt(" #n ")" ::: "memory")
#define PG8_WAIT_L(n) asm volatile("s_waitcnt lgkmcnt(" #n ")" ::: "memory")
#define PG8_BAR __builtin_amdgcn_s_barrier()
#define PG8_SCHED __builtin_amdgcn_sched_barrier(0)
    Unit cur, nxt; int ui = 0;
    if (!S.next(0, cur)) return;
    f32x4 acc[2][2][4][2];
#pragma unroll
    for (int a = 0; a < 2; ++a)
#pragma unroll
        for (int b = 0; b < 2; ++b)
#pragma unroll
            for (int m = 0; m < 4; ++m)
#pragma unroll
                for (int n = 0; n < 2; ++n) acc[a][b][m][n] = (f32x4){0.f, 0.f, 0.f, 0.f};
    bf16x8 At[4][2], B0[2][2], B1[2][2];
    i32x8 At8[4], B08[2], B18[2];
    const int mx_one = 0x7f7f7f7f;
    unsigned vc[4], vn[4];
    S.aoff(cur, R0, C0, R1, C1, vc);
    const char* cA = cur.A; const char* cB = cur.B;
    PG8_STAGEB(PG8_SB(0, 0), cB); PG8_STAGEB(PG8_SB(0, 1), cB + hstepB); PG8_STAGE2(PG8_SA(0, 0), cA, vc[0], vc[1]); PG8_STAGE2(PG8_SA(0, 1), cA, vc[2], vc[3]);
    if (wr == 1) PG8_BAR;
    PG8_WAIT_V(2); PG8_BAR;
    PG8_STAGEB(PG8_SB(1, 0), cB + kstep); PG8_STAGE2(PG8_SA(1, 0), cA + kstep, vc[0], vc[1]); PG8_STAGEB(PG8_SB(1, 1), cB + hstepB + kstep);
    PG8_WAIT_V(6); PG8_BAR;
    for (;;) {
        const bool has_next = S.next(ui + 1, nxt);
        if (has_next) S.aoff(nxt, R0, C0, R1, C1, vn);
        else { vn[0] = vc[0]; vn[1] = vc[1]; vn[2] = vc[2]; vn[3] = vc[3]; }
        const char* nA = has_next ? nxt.A : cA; const char* nB = has_next ? nxt.B : cB;
        const bool chalf = cur.half != 0;
#pragma nounroll
        for (int t = 0; t < nt; t += 2) {
            const bool last = (t == nt - 2);
            const char* a1 = cA + (size_t)(t + 1) * kstep;
            const char* a2 = last ? nA : cA + (size_t)(t + 2) * kstep; const char* b2 = last ? nB : cB + (size_t)(t + 2) * kstep;
            const char* a3 = a2 + kstep; const char* b3 = b2 + kstep;
            const unsigned w0 = last ? vn[0] : vc[0], w1 = last ? vn[1] : vc[1], w2 = last ? vn[2] : vc[2], w3 = last ? vn[3] : vc[3];
            PG8_LDB(B0, 0, 0); PG8_LDB(B1, 0, 1); PG8_SCHED; PG8_LDA(At, 0, 0); PG8_STAGE2(PG8_SA(1, 1), a1, vc[2], vc[3]);
            PG8_WAIT_V(8); PG8_WAIT_L(0); PG8_BAR; PG8_MMA(0, 0, At, B0); PG8_MMA(0, 1, At, B1); PG8_BAR; PG8_SCHED;
            PG8_LDA(At, 0, 1); PG8_STAGEB(PG8_SB(0, 0), b2); PG8_STAGEB(PG8_SB(0, 1), b2 + hstepB); PG8_STAGE2(PG8_SA(0, 0), a2, w0, w1);
            PG8_WAIT_V(8); PG8_WAIT_L(0); PG8_BAR; if (!chalf) { PG8_MMA(1, 0, At, B0); PG8_MMA(1, 1, At, B1); } PG8_BAR; PG8_SCHED;
            PG8_LDB(B0, 1, 0); PG8_LDB(B1, 1, 1); PG8_SCHED; PG8_LDA(At, 1, 0); PG8_STAGE2(PG8_SA(0, 1), a2, w2, w3);
            PG8_WAIT_V(8); PG8_WAIT_L(0); PG8_BAR; PG8_MMA(0, 0, At, B0); PG8_MMA(0, 1, At, B1); PG8_BAR; PG8_SCHED;
            PG8_LDA(At, 1, 1); PG8_STAGEB(PG8_SB(1, 0), b3); PG8_STAGEB(PG8_SB(1, 1), b3 + hstepB); PG8_STAGE2(PG8_SA(1, 0), a3, w0, w1);
            PG8_WAIT_V(8); PG8_WAIT_L(0); PG8_BAR; if (!chalf) { PG8_MMA(1, 0, At, B0); PG8_MMA(1, 1, At, B1); } PG8_BAR; PG8_SCHED;
        }
        if (wr == 0) PG8_BAR;
        E(acc, cur, wr, wc, fr, fq);
        if (!has_next) break;
#pragma unroll
        for (int a = 0; a < 2; ++a)
#pragma unroll
            for (int b = 0; b < 2; ++b)
#pragma unroll
                for (int m = 0; m < 4; ++m)
#pragma unroll
                    for (int n = 0; n < 2; ++n) acc[a][b][m][n] = (f32x4){0.f, 0.f, 0.f, 0.f};
        cur = nxt; cA = nA; cB = nB; ++ui; vc[0] = vn[0]; vc[1] = vn[1]; vc[2] = vn[2]; vc[3] = vn[3];
        if (wr == 1) PG8_BAR;
    }
    PG8_WAIT_V(0);
    PG8_BAR;
#undef PG8_SA
#undef PG8_SB
#undef PG8_STAGE2
#undef PG8_STAGEB
#undef PG8_LDA
#undef PG8_LDB
#undef PG8_MMA
#undef PG8_RD8
#undef PG8_WAIT_V
#undef PG8_WAIT_L
#undef PG8_BAR
#undef PG8_SCHED
}
struct PlainSched {
    const bf16_t* A; const bf16_t* Bt; int lda, acol0, K, nM, nN, units;
    DEVI bool next(int i, Unit& u) const {
        const int g = obid() + i * gridDim.x; if (g >= units) return false;
        int wgid = g; { const int q = units / 8, r = units % 8, xcd = wgid % 8, off = wgid / 8; wgid = (xcd < r ? xcd * (q + 1) : r * (q + 1) + (xcd - r) * q) + off; }
        const int nig = 8 * nN, gid = wgid / nig, fm = gid * 8, gsz = (nM - fm) < 8 ? (nM - fm) : 8;
        u.pm = fm + ((wgid % nig) % gsz); u.pn = (wgid % nig) / gsz; u.e = 0; u.ord = i; u.half = 0;
        u.A = (const char*)(A + (size_t)u.pm * 256 * lda + acol0); u.B = (const char*)(Bt + (size_t)u.pn * 256 * K); return true; }
    DEVI void aoff(const Unit&, int R0, int C0, int R1, int C1, unsigned (&o)[4]) const {
        o[0] = (unsigned)(R0 * lda + C0) * 2u; o[1] = (unsigned)(R1 * lda + C1) * 2u; o[2] = (unsigned)((128 + R0) * lda + C0) * 2u; o[3] = (unsigned)((128 + R1) * lda + C1) * 2u; }
};
}

DEVI void p0_mod_item(const Params& p, int item, char* smem) {
    const int l = item / 384, cb = item % 384, n0 = cb * 32;
    float* sv = (float*)smem;
    float* red = (float*)(smem + 65536);
    const int tid = opaque_tid(), wid = tid >> 6, lane = tid & 63;
    for (int idx = tid; idx < 2048; idx += 512) {
#pragma unroll
        for (int b = 0; b < 4; ++b) sv[idx * 8 + b] = silu_f(p.c[b * 2048 + idx]);
        sv[idx * 8 + 4] = silu_f(p.c_ctx[idx]);
    }
    __syncthreads();
    const int rsub = lane >> 5, col = lane & 31;
    const float* W = p.ada_w + (size_t)l * 2048 * 12288 + n0 + col;
    float a0 = 0.f, a1 = 0.f, a2 = 0.f, a3 = 0.f, a4 = 0.f;
#pragma unroll 32
    for (int kk = 0; kk < 128; ++kk) {
        const int k = wid * 256 + kk * 2 + rsub;
        const float w = __builtin_nontemporal_load(W + (size_t)k * 12288);
        const f32x4 s = *(const f32x4*)(sv + k * 8); const float s4 = sv[k * 8 + 4];
        a0 += s[0] * w; a1 += s[1] * w; a2 += s[2] * w; a3 += s[3] * w; a4 += s4 * w;
    }
    a0 += __shfl_xor(a0, 32); a1 += __shfl_xor(a1, 32); a2 += __shfl_xor(a2, 32); a3 += __shfl_xor(a3, 32); a4 += __shfl_xor(a4, 32);
    red[(wid * 5 + 0) * 64 + lane] = a0; red[(wid * 5 + 1) * 64 + lane] = a1; red[(wid * 5 + 2) * 64 + lane] = a2;
    red[(wid * 5 + 3) * 64 + lane] = a3; red[(wid * 5 + 4) * 64 + lane] = a4;
    __syncthreads();
    if (tid < 320 && (tid & 63) < 32) {
        const int i = tid >> 6, ln = tid & 63; float s = 0.f;
#pragma unroll
        for (int w = 0; w < 8; ++w) s += red[(w * 5 + i) * 64 + ln];
        float* mod = (float*)(p.ws + WS_MOD);
        __hip_atomic_store(&mod[(size_t)(l * 5 + i) * 12288 + n0 + ln], s + p.ada_b[l * 12288 + n0 + ln], __ATOMIC_RELAXED, __HIP_MEMORY_SCOPE_AGENT);
    }
    asm volatile("s_waitcnt vmcnt(0)" ::: "memory");
    __syncthreads();
    if (tid == 0) __hip_atomic_fetch_add((unsigned*)(p.ws + WS_BAR) + MODCNT_WORD, 1u, __ATOMIC_RELAXED, __HIP_MEMORY_SCOPE_AGENT);
}
DEVI void wait_mod(const Params& p) {
    if (threadIdx.x == 0) {
        unsigned* c = (unsigned*)(p.ws + WS_BAR) + MODCNT_WORD; unsigned sp = 0;
        while (__hip_atomic_load(c, __ATOMIC_RELAXED, __HIP_MEMORY_SCOPE_AGENT) < (unsigned)P0_N_MOD_ITEMS) { __builtin_amdgcn_s_sleep(2); if (++sp > (1u << 22)) break; }
        __builtin_amdgcn_fence(__ATOMIC_ACQUIRE, "agent");
        asm volatile("s_waitcnt vmcnt(0)" ::: "memory");
    }
    __syncthreads();
}

struct CvtD { const float* src; const float* scale; bf16_t* dst; int ldn, nvalid, K, k0, n0, d0; };
DEVI CvtD p0_bf16_desc(const Params& p, int j) {
    CvtD d;
    if (j < 1152) { const int l = j / 576, r = j % 576, kt = r / 36, nt = r % 36;
        d = CvtD{p.w_in + (size_t)l * 2048 * INC, nullptr, (bf16_t*)(p.ws + WS_WIN) + (size_t)l * INCP * 2048, INC, INC, 2048, kt * 128, nt * 128, nt * 128}; return d; }
    j -= 1152;
    if (j < 96) { const int l = j / 48, r = j % 48, kt = r / 12, nt = r % 12;
        d = CvtD{p.w_uq + (size_t)l * 512 * 1536, p.q_norm + l * 512, (bf16_t*)(p.ws + WS_WUQ) + (size_t)l * 1536 * 512, 1536, 1536, 512, kt * 128, nt * 128, nt * 128}; return d; }
    j -= 96;
    if (j < 64) { const int l = j / 32, r = j % 32, kt = r / 16, nt = r % 16;
        d = CvtD{p.w_ukv + (size_t)l * 256 * 2048, p.kv_norm + l * 256, (bf16_t*)(p.ws + WS_WUKV) + (size_t)l * 2048 * 256, 2048, 2048, 256, kt * 128, nt * 128, nt * 128}; return d; }
    j -= 64;
    { const int l = j / 256, r = j % 256, kt = r / 16, nt = r % 16;
        d = CvtD{p.w_out + (size_t)l * 2048 * 2048, nullptr, (bf16_t*)(p.ws + WS_WOUT) + (size_t)l * 2048 * 2048, 2048, 2048, 2048, kt * 128, nt * 128, nt * 128}; return d; }
}
struct CvtRegs { f32x4 v[8]; };
DEVI void cvt_tile_load(const CvtD& d, CvtRegs& rg) {
    const int tid = opaque_tid(), nq = tid & 31, kq0 = tid >> 5;
#pragma unroll
    for (int it = 0; it < 2; ++it)
#pragma unroll
        for (int kk = 0; kk < 4; ++kk) { const int k = d.k0 + (kq0 + it * 16) * 4 + kk, n = d.n0 + nq * 4;
            f32x4 v = (n < d.nvalid) ? *(const f32x4*)(d.src + (size_t)k * d.ldn + n) : (f32x4){0.f, 0.f, 0.f, 0.f};
            if (d.scale) v *= d.scale[k];
            rg.v[it * 4 + kk] = v; }
}
DEVI void cvt_tile_finish(const CvtD& d, const CvtRegs& rg, char* smem) {
    bf16_t* T = (bf16_t*)smem;
    const int tid = opaque_tid(), nq = tid & 31, kq0 = tid >> 5;
#pragma unroll
    for (int it = 0; it < 2; ++it) { const int kq = kq0 + it * 16;
#pragma unroll
        for (int j = 0; j < 4; ++j) { u32x2 w = {cvt_pk(rg.v[it * 4][j], rg.v[it * 4 + 1][j]), cvt_pk(rg.v[it * 4 + 2][j], rg.v[it * 4 + 3][j])};
            *(u32x2*)(T + (nq * 4 + j) * 132 + kq * 4) = w; } }
    __syncthreads();
#pragma unroll
    for (int i = 0; i < 8; ++i) { const int nl = (tid >> 5) + 16 * i, kc = (tid & 31) * 4;
        *(u32x2*)(d.dst + (size_t)(d.d0 + nl) * d.K + d.k0 + kc) = *(const u32x2*)(T + nl * 132 + kc); }
    __syncthreads();
}

struct CvtIn { f32x4 v[8]; };
DEVI void cvt8_load(const Params& p, int L, int t, CvtIn& in) {
    const int which = t / 4096, r = t % 4096, le = L * 16 + r / 256, kt = (r % 256) / 16, nt = r % 16;
    const float* src = (which == 2 ? p.w_down : (which == 0 ? p.w_gate : p.w_up)) + (size_t)le * 2048 * 2048;
    const int tid = opaque_tid(), nq = tid & 31, kq0 = tid >> 5;
#pragma unroll
    for (int it = 0; it < 2; ++it)
#pragma unroll
        for (int kk = 0; kk < 4; ++kk) in.v[it * 4 + kk] = __builtin_nontemporal_load((const f32x4*)(src + (size_t)(kt * 128 + (kq0 + it * 16) * 4 + kk) * 2048 + nt * 128 + nq * 4));
}
DEVI void cvt8_finish(const Params& p, int L, int t, const CvtIn& in, char* smem) {
    const int which = t / 4096, r = t % 4096, le = L * 16 + r / 256, kt = (r % 256) / 16, nt = r % 16;
    unsigned char* dst = (which == 2) ? (unsigned char*)(p.ws + WS_WDN) + (size_t)le * 2048 * 2048 + (size_t)(nt * 128) * 2048
                                      : (unsigned char*)(p.ws + WS_WGU) + (size_t)le * 4096 * 2048 + (size_t)(nt * 256 + which * 128) * 2048;
    unsigned char* T = (unsigned char*)smem;
    const int tid = opaque_tid(), nq = tid & 31, kq0 = tid >> 5;
#pragma unroll
    for (int it = 0; it < 2; ++it) { const int kq = kq0 + it * 16;
#pragma unroll
        for (int j = 0; j < 4; ++j) *(unsigned*)(T + (nq * 4 + j) * 144 + kq * 4) =
            cvt4_fp8(in.v[it * 4][j] * W8_SCALE, in.v[it * 4 + 1][j] * W8_SCALE, in.v[it * 4 + 2][j] * W8_SCALE, in.v[it * 4 + 3][j] * W8_SCALE); }
    __syncthreads();
#pragma unroll
    for (int i = 0; i < 2; ++i) { const int nl = (tid >> 3) + 64 * i, kc = (tid & 7) * 16;
        *(u32x4*)(dst + (size_t)nl * 2048 + kt * 128 + kc) = *(const u32x4*)(T + nl * 144 + kc); }
    __syncthreads();
}
DEVI void cvt8_stream(const Params& p, int L, int t0, int step, int count, char* smem) {
    if (count <= 0) return;
    CvtIn cur; cvt8_load(p, L, t0, cur);
    for (int i = 0; i < count; ++i) { const int t = t0 + i * step; CvtIn nxt;
        if (i + 1 < count) cvt8_load(p, L, t + step, nxt);
        cvt8_finish(p, L, t, cur, smem);
        cur = nxt; }
}
DEVI void cvt8_stream3(const Params& p, int L, int t0, int step, int count, char* smem) {
    if (count <= 0) return;
    CvtIn a, b; cvt8_load(p, L, t0, a);
    if (count > 1) cvt8_load(p, L, t0 + step, b);
#pragma nounroll
    for (int i = 0; i < count; ++i) { CvtIn c;
        if (i + 2 < count) cvt8_load(p, L, t0 + (i + 2) * step, c);
        cvt8_finish(p, L, t0 + i * step, a, smem);
        a = b; b = c; }
}
#ifndef TAILT_WIN
#define TAILT_WIN 18
#endif
#ifndef TAILT_WOUT
#define TAILT_WOUT 14
#endif
#ifndef TAILT_DN
#define TAILT_DN 10
#endif
constexpr int TAIL_WIN_B0 = 648 - 2 * 256, TAIL_WOUT_B0 = 288 - 256, TAIL_DN_B0 = 640 - 2 * 256;
constexpr int T0A = (256 - TAIL_WIN_B0) * TAILT_WIN, T0B = T0A + (256 - TAIL_WOUT_B0) * TAILT_WOUT, T1A = (256 - TAIL_DN_B0) * TAILT_DN, T1B = T1A + (256 - TAIL_WIN_B0) * TAILT_WIN;
static_assert(T0B <= 12288 && T1B <= 12288, "tail tiles");
DEVI void tail_convert(const Params& p, int L, int first_block, int base, int ntile, char* smem) {
    if (gridDim.x != 256 || obid() < first_block) return;
    cvt8_stream3(p, L, base + (obid() - first_block), 256 - first_block, ntile, smem);
}
#ifndef RANKT0
#define RANKT0 14
#endif
#ifndef RANKT1
#define RANKT1 14
#endif
constexpr int T0C = T0B + 192 * RANKT0, T1C = T1B + 192 * RANKT1;
static_assert(T0C <= 12288 && T1C <= 12288, "tail tiles");
constexpr int SCAN_A_UNITS = 2 * 16 * NCH, SCAN_C0_UNITS = 2 * 16 * NCH, SCAN_C1_UNITS = 2 * 16 * 32;
constexpr int TS0A = 12288 - SCAN_A_UNITS - SCAN_C0_UNITS, TS0C = 12288 - SCAN_C0_UNITS;
constexpr int TS1A = 12288 - SCAN_A_UNITS - SCAN_C1_UNITS, TS1C = 12288 - SCAN_C1_UNITS;
#ifndef L4C0_PER
#define L4C0_PER 62
#endif
#ifndef L4C1_PER
#define L4C1_PER 34
#endif
#ifndef L4C2_PER
#define L4C2_PER 90
#endif
constexpr int L4NC = 32, T0D = T0C + L4NC * L4C0_PER, T1D0 = T1C + L4NC * L4C1_PER, T1D = T1D0 + L4NC * L4C2_PER;
static_assert(T0D <= TS0A && T1D <= TS1A, "scan tiles");
constexpr int P0_N_MOD = 768, P0_N_WIN = 2 * 16 * 36, P0_N_WUQ = 2 * 4 * 12, P0_N_WUKV = 2 * 2 * 16, P0_N_WOUT = 2 * 16 * 16, P0_N_EXP0 = TS0A - T0D, P0_N_EXP = (TS0A - T0D) + (TS1A - T1D), P0_N_TAB = (1024 + 2048 * 64) / 512;
constexpr int P0_ITEMS = P0_N_MOD + P0_N_WIN + P0_N_WUQ + P0_N_WUKV + P0_N_WOUT + P0_N_EXP + P0_N_TAB;

DEVI void phase_p0(const Params& p, char* smem) {
    if (gridDim.x != 256) {
        { const int b0 = obid(), G = gridDim.x; if (b0 < T0D) cvt8_stream(p, 0, b0, G, (T0D - b0 + G - 1) / G, smem); if (b0 < T1D) cvt8_stream(p, 1, b0, G, (T1D - b0 + G - 1) / G, smem); }
    }
    for (int item = obid(); item < P0_ITEMS; item += gridDim.x) {
        int j = item;
        if (j < P0_N_MOD) { p0_mod_item(p, j, smem); continue; }
        j -= P0_N_MOD;
        if (j < P0_N_WIN + P0_N_WUQ + P0_N_WUKV + P0_N_WOUT) continue;
        j -= P0_N_WIN + P0_N_WUQ + P0_N_WUKV + P0_N_WOUT;
        if (j < P0_N_EXP) continue;
        j -= P0_N_EXP;
        {
            const int idx = j * 512 + threadIdx.x;
            if (idx < 1024) { const int pos = idx >> 4, f = idx & 15;
                const float inv = (float)pow(10000.0, -(double)f / 16.0); const float ang = (float)pos * inv;
                float* t = (float*)(p.ws + WS_RAX); t[idx * 2] = cosf(ang); t[idx * 2 + 1] = sinf(ang);
            } else { const int q = idx - 1024, tt = q >> 6, pp = q & 63;
                const float inv = (float)(1.0 / pow(10000.0, (double)pp / 63.0)); const float ang = (float)tt * inv;
                float* t = (float*)(p.ws + WS_RRET); t[q * 2] = cosf(ang); t[q * 2 + 1] = sinf(ang);
            }
        }
    }
    {
        const int G = gridDim.x, NB16 = P0_N_WIN + P0_N_WUQ + P0_N_WUKV + P0_N_WOUT;
        int first = obid() - P0_N_MOD % G; if (first < 0) first += G;
        if (first < NB16) { CvtD dc = p0_bf16_desc(p, first); CvtRegs rc; cvt_tile_load(dc, rc);
            for (int jj = first; jj < NB16; jj += G) { CvtD dn = dc; CvtRegs rn;
                if (jj + G < NB16) { dn = p0_bf16_desc(p, jj + G); cvt_tile_load(dn, rn); }
                cvt_tile_finish(dc, rc, smem);
                dc = dn; rc = rn; } }
    }
    {
        const int G = gridDim.x, EXP_BASE = P0_N_MOD + P0_N_WIN + P0_N_WUQ + P0_N_WUKV + P0_N_WOUT;
        int first = obid() - EXP_BASE % G; if (first < 0) first += G;
        if (first < P0_N_EXP0) cvt8_stream3(p, 0, T0D + first, G, (P0_N_EXP0 - first + G - 1) / G, smem);
        int f1 = first; if (f1 < P0_N_EXP0) f1 += ((P0_N_EXP0 - f1 + G - 1) / G) * G;
        if (f1 < P0_N_EXP) cvt8_stream3(p, 1, T1D + (f1 - P0_N_EXP0), G, (P0_N_EXP - f1 + G - 1) / G, smem);
    }
}

template <int MODE>
DEVI void phase_rows(const Params& p, int l, char* smem) {
    const int tid = opaque_tid(), wid = tid >> 6, lane = tid & 63;
    bf16_t* xres = (bf16_t*)(p.ws + WS_XRES);
    bf16_t* hbuf = (bf16_t*)(p.ws + WS_H);
    const float* mod = (const float*)(p.ws + WS_MOD);
    float* wT = (float*)smem;
    if (MODE == 1) {
        const float* rw = p.router_w + (size_t)l * 2048 * 16;
        f32x4 rwv[16];
#pragma unroll
        for (int it = 0; it < 16; ++it) { const int i = tid + it * 512; rwv[it] = *(const f32x4*)(rw + (i >> 2) * 16 + (i & 3) * 4); }
#pragma unroll
        for (int it = 0; it < 16; ++it) { const int i = tid + it * 512, k = i >> 2, e4 = (i & 3) * 4; const f32x4 v = rwv[it];
            wT[(e4 + 0) * 2048 + k] = v[0]; wT[(e4 + 1) * 2048 + k] = v[1]; wT[(e4 + 2) * 2048 + k] = v[2]; wT[(e4 + 3) * 2048 + k] = v[3]; }
        __syncthreads();
    }
    const int nrows = (MODE == 3 || (MODE == 1 && l == 1)) ? NLAT : NROW;
    for (int row = obid() * 8 + wid; row < nrows; row += gridDim.x * 8) {
        const bool lat = row < NLAT;
        const int b = lat ? (row >> 11) : ((row - NLAT) >> 8);
        const int tok = lat ? (row & 2047) : (SEQ + ((row - NLAT) & 255));
        float v[32];
        if (MODE == 0) { const float* src = lat ? p.x + (size_t)row * DM : p.ctx + (size_t)(row - NLAT) * DM;
#pragma unroll
            for (int i = 0; i < 8; ++i) { const f32x4 t = *(const f32x4*)(src + i * 256 + lane * 4); v[i * 4] = t[0]; v[i * 4 + 1] = t[1]; v[i * 4 + 2] = t[2]; v[i * 4 + 3] = t[3]; }
        } else { const bf16_t* src = xres + (size_t)row * DM;
#pragma unroll
            for (int i = 0; i < 8; ++i) { const u32x2 t = *(const u32x2*)(src + i * 256 + lane * 4); v[i * 4] = bflo(t[0]); v[i * 4 + 1] = bfhi(t[0]); v[i * 4 + 2] = bflo(t[1]); v[i * 4 + 3] = bfhi(t[1]); }
        }
        const float* mrow = mod + (size_t)(((MODE == 2) ? l : l) * 5 + (lat ? b : 4)) * 12288;
        if (MODE == 2 || MODE == 3) {
            float cacc[32];
#pragma unroll
            for (int i = 0; i < 32; ++i) cacc[i] = 0.f;
            const int* rk = (const int*)(p.ws + WS_RANK) + (size_t)b * 16 * KEYS + tok;
            const bf16_t* ydn = (const bf16_t*)(p.ws + WS_YDN);
            const int cap = lat ? 256 : 32;
            int rke[16];
#pragma unroll
            for (int e = 0; e < 16; ++e) rke[e] = rk[e * KEYS];
            const bf16_t* y0 = ydn; const bf16_t* y1 = ydn; const bf16_t* y2 = ydn; const bf16_t* y3 = ydn; int ny = 0;
#pragma unroll
            for (int e = 0; e < 16; ++e) {
                const int r = rke[e];
                if (r < cap) {
                    const int slot = lat ? (b * 256 + r) : (1024 + b * 32 + r);
                    const bf16_t* yr = ydn + ((size_t)e * MSLOT + slot) * DM;
                    if (ny == 0) y0 = yr; else if (ny == 1) y1 = yr; else if (ny == 2) y2 = yr; else if (ny == 3) y3 = yr;
                    else {
#pragma unroll
                        for (int i = 0; i < 8; ++i) { const u32x2 w = *(const u32x2*)(yr + i * 256 + lane * 4);
                            cacc[i * 4] += bflo(w[0]); cacc[i * 4 + 1] += bfhi(w[0]); cacc[i * 4 + 2] += bflo(w[1]); cacc[i * 4 + 3] += bfhi(w[1]); }
                    }
                    ++ny;
                }
            }
            {   u32x2 w0[8], w1[8], w2[8], w3[8];
#pragma unroll
                for (int i = 0; i < 8; ++i) { w0[i] = *(const u32x2*)(y0 + i * 256 + lane * 4); w1[i] = *(const u32x2*)(y1 + i * 256 + lane * 4);
                    w2[i] = *(const u32x2*)(y2 + i * 256 + lane * 4); w3[i] = *(const u32x2*)(y3 + i * 256 + lane * 4); }
                const float f0 = ny > 0 ? 1.f : 0.f, f1 = ny > 1 ? 1.f : 0.f, f2 = ny > 2 ? 1.f : 0.f, f3 = ny > 3 ? 1.f : 0.f;
#pragma unroll
                for (int i = 0; i < 8; ++i) {
                    cacc[i * 4] += f0 * bflo(w0[i][0]) + f1 * bflo(w1[i][0]) + f2 * bflo(w2[i][0]) + f3 * bflo(w3[i][0]);
                    cacc[i * 4 + 1] += f0 * bfhi(w0[i][0]) + f1 * bfhi(w1[i][0]) + f2 * bfhi(w2[i][0]) + f3 * bfhi(w3[i][0]);
                    cacc[i * 4 + 2] += f0 * bflo(w0[i][1]) + f1 * bflo(w1[i][1]) + f2 * bflo(w2[i][1]) + f3 * bflo(w3[i][1]);
                    cacc[i * 4 + 3] += f0 * bfhi(w0[i][1]) + f1 * bfhi(w1[i][1]) + f2 * bfhi(w2[i][1]) + f3 * bfhi(w3[i][1]); }
            }
            const float* gf = mrow + 10240;
#pragma unroll
            for (int i = 0; i < 8; ++i) { const f32x4 g = *(const f32x4*)(gf + i * 256 + lane * 4);
                v[i * 4] += g[0] * cacc[i * 4]; v[i * 4 + 1] += g[1] * cacc[i * 4 + 1]; v[i * 4 + 2] += g[2] * cacc[i * 4 + 2]; v[i * 4 + 3] += g[3] * cacc[i * 4 + 3]; }
            if (MODE == 2) {
#pragma unroll
                for (int i = 0; i < 8; ++i) *(u32x2*)(xres + (size_t)row * DM + i * 256 + lane * 4) = (u32x2){cvt_pk(v[i * 4], v[i * 4 + 1]), cvt_pk(v[i * 4 + 2], v[i * 4 + 3])};
            }
        }
        f32x4 shv[8], scv[8];
        if (MODE != 3) { const float* mr2 = (MODE == 2) ? mrow + (size_t)5 * 12288 : mrow;
            const float* sh = mr2 + ((MODE == 1) ? 6144 : 0); const float* sc = mr2 + ((MODE == 1) ? 8192 : 2048);
#pragma unroll
            for (int i = 0; i < 8; ++i) { shv[i] = *(const f32x4*)(sh + i * 256 + lane * 4); scv[i] = *(const f32x4*)(sc + i * 256 + lane * 4); } }
        float ss = 0.f;
#pragma unroll
        for (int i = 0; i < 32; ++i) ss += v[i] * v[i];
        ss = wave_sum(ss);
        const float rstd = rsqrtf(ss * (1.f / DM) + EPS);
        if (MODE == 3) {
#pragma unroll
            for (int i = 0; i < 8; ++i) { const f32x4 g = *(const f32x4*)(p.final_norm + i * 256 + lane * 4);
                __builtin_nontemporal_store((f32x4){v[i * 4] * rstd * g[0], v[i * 4 + 1] * rstd * g[1], v[i * 4 + 2] * rstd * g[2], v[i * 4 + 3] * rstd * g[3]}, (f32x4*)(p.out + (size_t)row * DM + i * 256 + lane * 4)); }
            continue;
        }
#pragma unroll
        for (int i = 0; i < 8; ++i) { const f32x4 a = shv[i]; const f32x4 s = scv[i];
#pragma unroll
            for (int j = 0; j < 4; ++j) v[i * 4 + j] = v[i * 4 + j] * rstd * (1.f + s[j]) + a[j];
            if (MODE == 1) *(unsigned*)((unsigned char*)hbuf + (size_t)row * DM + i * 256 + lane * 4) = cvt4_fp8c(v[i * 4], v[i * 4 + 1], v[i * 4 + 2], v[i * 4 + 3]);
            else *(u32x2*)(hbuf + (size_t)row * DM + i * 256 + lane * 4) = (u32x2){cvt_pk(v[i * 4], v[i * 4 + 1]), cvt_pk(v[i * 4 + 2], v[i * 4 + 3])}; }
        if (MODE == 1) {
            float a[16];
#pragma unroll
            for (int e = 0; e < 16; ++e) { float t = 0.f;
#pragma unroll
                for (int i = 0; i < 8; ++i) { const f32x4 w = *(const f32x4*)(wT + e * 2048 + i * 256 + lane * 4);
                    t += v[i * 4] * w[0] + v[i * 4 + 1] * w[1] + v[i * 4 + 2] * w[2] + v[i * 4 + 3] * w[3]; }
                a[e] = t; if ((e & 3) == 3) __builtin_amdgcn_sched_barrier(0); }
            const bool b5 = (lane & 32) != 0, b4 = (lane & 16) != 0, b3 = (lane & 8) != 0, b2 = (lane & 4) != 0;
            float s8[8], s4[4], s2[2], s1;
#pragma unroll
            for (int i = 0; i < 8; ++i) { const float keep = b5 ? a[8 + i] : a[i], give = b5 ? a[i] : a[8 + i]; s8[i] = keep + __shfl_xor(give, 32); }
#pragma unroll
            for (int i = 0; i < 4; ++i) { const float keep = b4 ? s8[4 + i] : s8[i], give = b4 ? s8[i] : s8[4 + i]; s4[i] = keep + __shfl_xor(give, 16); }
#pragma unroll
            for (int i = 0; i < 2; ++i) { const float keep = b3 ? s4[2 + i] : s4[i], give = b3 ? s4[i] : s4[2 + i]; s2[i] = keep + __shfl_xor(give, 8); }
            { const float keep = b2 ? s2[1] : s2[0], give = b2 ? s2[0] : s2[1]; s1 = keep + __shfl_xor(give, 4); }
            s1 += __shfl_xor(s1, 2); s1 += __shfl_xor(s1, 1);
            float mx = s1;
#pragma unroll
            for (int off = 32; off >= 4; off >>= 1) mx = fmaxf(mx, __shfl_xor(mx, off));
            const float ex = expf(s1 - mx); float den = ex;
#pragma unroll
            for (int off = 32; off >= 4; off >>= 1) den += __shfl_xor(den, off);
            const int eidx = (b5 ? 8 : 0) + (b4 ? 4 : 0) + (b3 ? 2 : 0) + (b2 ? 1 : 0);
            if ((lane & 3) == 0) ((float*)(p.ws + WS_AFF))[((size_t)b * 16 + eidx) * KEYS + tok] = ex / den;
        }
    }
    if (MODE == 1) __syncthreads();
}

struct EpiWin { static constexpr bool PERM = true; bf16_t* P;
    DEVI void operator()(const f32x4 (&acc)[2][2][4][2], const pg8::Unit& u, int wr, int wc, int fr, int fq) const {
#pragma unroll
        for (int ai = 0; ai < 2; ++ai)
#pragma unroll
            for (int m = 0; m < 4; ++m) { const int row = u.pm * 256 + ai * 128 + wr * 64 + m * 16 + fr;
#pragma unroll
                for (int bj = 0; bj < 2; ++bj) { const int col = u.pn * 256 + bj * 128 + wc * 32 + 8 * fq;
                    if (col < INC) { const f32x4 a = acc[ai][bj][m][0], b = acc[ai][bj][m][1];
                        *(u32x4*)(P + (size_t)row * INC + col) = (u32x4){cvt_pk(a[0], a[1]), cvt_pk(a[2], a[3]), cvt_pk(b[0], b[1]), cvt_pk(b[2], b[3])}; } } }
    } };
DEVI void phase_win(const Params& p, int l, char* smem) {
    pg8::PlainSched S{(const bf16_t*)(p.ws + WS_H), (const bf16_t*)(p.ws + WS_WIN) + (size_t)l * INCP * 2048, DM, 0, 2048, 36, 18, 36 * 18};
    pg8::gemm_phase((LAS unsigned char*)smem, 2048, S, EpiWin{(bf16_t*)(p.ws + WS_P)});
    if (l == 0) tail_convert(p, 0, TAIL_WIN_B0, 0, TAILT_WIN, smem); else tail_convert(p, 1, TAIL_WIN_B0, T1A, TAILT_WIN, smem);
}

DEVI float log_sigmoid_f(float x) { return fminf(x, 0.f) - __logf(1.f + __expf(-fabsf(x))); }
DEVI bf16x8 ldfrag(const bf16_t* base, int ld, int row0, int k0, int fr, int fq) { return *(const bf16x8*)(base + (row0 + fr) * ld + k0 + fq * 8); }
DEVI int chunk_row0(int b, int c) { return (c < 4) ? (NLAT + b * CL + c * 64) : (b * SEQ + (c - 4) * 64); }
DEVI int order_idx(int dir, int c) { return dir == 0 ? c : ((c < 4) ? (3 - c) : (4 + 35 - c)); }

struct GlaIn { bf16x8 q, k, v0, v1, g0, g1, z0, z1, z2, z3, bw; float bias; };
DEVI void gla_load(const Params& p, int l, int b, int h, int c, bool need_qg, GlaIn& in) {
    const bf16_t* P = (const bf16_t*)(p.ws + WS_P);
    const int tid = opaque_tid(), wid = tid >> 6, lane = tid & 63, fr = lane & 15, fq = lane >> 4, d = wid >> 2, kf = wid & 3, kk = kf * 16 + fr;
    const int row0 = chunk_row0(b, c), tk = tid >> 3, c8 = (tid & 7) * 8;
    in.k = *(const bf16x8*)(P + (size_t)(row0 + tk) * INC + C_GK + h * 64 + c8);
    in.v0 = *(const bf16x8*)(P + (size_t)(row0 + tk) * INC + C_GV + h * 128 + c8);
    in.v1 = *(const bf16x8*)(P + (size_t)(row0 + tk) * INC + C_GV + h * 128 + 64 + c8);
    if (need_qg) {
        in.q = *(const bf16x8*)(P + (size_t)(row0 + tk) * INC + C_GQ + h * 64 + c8);
        in.g0 = *(const bf16x8*)(P + (size_t)(row0 + tk) * INC + C_GOG + h * 128 + (tid & 7) * 16);
        in.g1 = *(const bf16x8*)(P + (size_t)(row0 + tk) * INC + C_GOG + h * 128 + (tid & 7) * 16 + 8);
    }
    const bf16x8 zero = {0, 0, 0, 0, 0, 0, 0, 0};
    in.z0 = zero; in.z1 = zero; in.z2 = zero; in.z3 = zero; in.bw = zero;
    if (fq < 2) {
        const bf16_t* zp = P + (size_t)(row0 + fr) * INC + C_GZ + d * 16 + fq * 8;
        in.z0 = *(const bf16x8*)(zp); in.z1 = *(const bf16x8*)(zp + (size_t)16 * INC); in.z2 = *(const bf16x8*)(zp + (size_t)32 * INC); in.z3 = *(const bf16x8*)(zp + (size_t)48 * INC);
        float wv[8];
#pragma unroll
        for (int j = 0; j < 8; ++j) wv[j] = p.gla_w2[((size_t)(l * 2 + d) * 16 + fq * 8 + j) * 256 + h * 64 + kk];
        in.bw = pack8(wv);
    }
    in.bias = p.gla_b[(size_t)(l * 2 + d) * 256 + h * 64 + kk];
}
DEVI void gla_cum(const GlaIn& in, float* cum) {
    const int tid = opaque_tid(), wid = tid >> 6, lane = tid & 63, fr = lane & 15, fq = lane >> 4, d = wid >> 2, kf = wid & 3;
    const int kk = kf * 16 + fr;
    float la[4][4];
#pragma unroll
    for (int f = 0; f < 4; ++f) {
        const bf16x8 az = (f == 0) ? in.z0 : (f == 1) ? in.z1 : (f == 2) ? in.z2 : in.z3;
        f32x4 acc = {0.f, 0.f, 0.f, 0.f};
        acc = __builtin_amdgcn_mfma_f32_16x16x32_bf16(az, in.bw, acc, 0, 0, 0);
#pragma unroll
        for (int r = 0; r < 4; ++r) la[f][r] = log_sigmoid_f(acc[r] + in.bias) * (1.f / 16.f);
    }
    if (d == 0) {
        float carry = 0.f;
#pragma unroll
        for (int f = 0; f < 4; ++f) {
            la[f][1] += la[f][0]; la[f][2] += la[f][1]; la[f][3] += la[f][2];
            float x = la[f][3]; const float own = x;
            float y = __shfl_up(x, 16); if (fq >= 1) x += y;
            y = __shfl_up(x, 32); if (fq >= 2) x += y;
            const float excl = x - own + carry;
            carry += __shfl(x, 48 + fr);
#pragma unroll
            for (int r = 0; r < 4; ++r) la[f][r] += excl;
        }
    } else {
        float carry = 0.f;
#pragma unroll
        for (int f = 3; f >= 0; --f) {
            la[f][2] += la[f][3]; la[f][1] += la[f][2]; la[f][0] += la[f][1];
            float x = la[f][0]; const float own = x;
            float y = __shfl_down(x, 16); if (fq <= 2) x += y;
            y = __shfl_down(x, 32); if (fq <= 1) x += y;
            const float excl = x - own + carry;
            carry += __shfl(x, fr);
#pragma unroll
            for (int r = 0; r < 4; ++r) la[f][r] += excl;
        }
    }
#pragma unroll
    for (int f = 0; f < 4; ++f)
#pragma unroll
        for (int r = 0; r < 4; ++r) cum[(d * 64 + f * 16 + fq * 4 + r) * 64 + kk] = la[f][r];
    __syncthreads();
}

DEVI void scan_a_gla(const Params& p, int l, int b, int h, int c, const GlaIn& in, char* smem) {
    float* cum = (float*)(smem + 18432);
    bf16_t* kTf = (bf16_t*)(smem + 51200); bf16_t* kTb = kTf + 64 * 72; bf16_t* vT = kTb + 64 * 72;
    const int tid = opaque_tid(), wid = tid >> 6, lane = tid & 63, fr = lane & 15, fq = lane >> 4;
    const int tk = tid >> 3, c8 = (tid & 7) * 8;
    const bf16x8 kreg = in.k, v0 = in.v0, v1 = in.v1;
    gla_cum(in, cum);
    {   float kf[8]; unpack8(kreg, kf);
#pragma unroll
        for (int e = 0; e < 8; ++e) { const int kk = c8 + e;
            kTf[kk * 72 + tk] = f2bf(kf[e] * __expf(cum[(0 * 64 + 63) * 64 + kk] - cum[(0 * 64 + tk) * 64 + kk]));
            kTb[kk * 72 + tk] = f2bf(kf[e] * __expf(cum[(1 * 64 + 0) * 64 + kk] - cum[(1 * 64 + tk) * 64 + kk])); }
#pragma unroll
        for (int e = 0; e < 8; ++e) { vT[(c8 + e) * 72 + tk] = (bf16_t)v0[e]; vT[(64 + c8 + e) * 72 + tk] = (bf16_t)v1[e]; }
    }
    if (tid < 128) { const int d = tid >> 6, kk = tid & 63;
        ((float*)(p.ws + WS_DECG))[((size_t)((b * 4 + h) * 2 + d) * NCH + order_idx(d, c)) * 64 + kk] = __expf(d == 0 ? cum[(0 * 64 + 63) * 64 + kk] : cum[(1 * 64 + 0) * 64 + kk]); }
    __syncthreads();
    {   const int dir = wid >> 2, kkf = wid & 3;
        const bf16_t* kT = dir ? kTb : kTf;
        const bf16x8 a0 = ldfrag(kT, 72, kkf * 16, 0, fr, fq), a1 = ldfrag(kT, 72, kkf * 16, 32, fr, fq);
        bf16_t* UT = (bf16_t*)(p.ws + WS_UTG) + ((size_t)((b * 4 + h) * 2 + dir) * NCH + order_idx(dir, c)) * (128 * 64);
#pragma unroll
        for (int vf = 0; vf < 8; ++vf) {
            f32x4 acc = {0.f, 0.f, 0.f, 0.f};
            acc = __builtin_amdgcn_mfma_f32_16x16x32_bf16(a0, ldfrag(vT, 72, vf * 16, 0, fr, fq), acc, 0, 0, 0);
            acc = __builtin_amdgcn_mfma_f32_16x16x32_bf16(a1, ldfrag(vT, 72, vf * 16, 32, fr, fq), acc, 0, 0, 0);
            *(u32x2*)(UT + (vf * 16 + fr) * 64 + kkf * 16 + fq * 4) = (u32x2){cvt_pk(acc[0], acc[1]), cvt_pk(acc[2], acc[3])};
        }
    }
    __syncthreads();
}

DEVI void ret_decays(int h, float& ldf, float& ldb) { ldf = log1pf(-exp2f(-(5.f + 2.f * h))); ldb = log1pf(-exp2f(-(6.f + 2.f * h))); }

struct RetIn { bf16x8 q0, q1, k0, k1, v0, v1, g0, g1; f32x4 cs0, cs1, cs2, cs3; };
DEVI void ret_load(const Params& p, int b, int h, int c, bool need_qg, RetIn& in) {
    const bf16_t* P = (const bf16_t*)(p.ws + WS_P);
    const float* rret = (const float*)(p.ws + WS_RRET);
    const int tid = opaque_tid(), tk = tid >> 3, kk16 = (tid & 7) * 16;
    const size_t rb = (size_t)(chunk_row0(b, c) + tk) * INC;
    in.k0 = *(const bf16x8*)(P + rb + C_RK + h * 128 + kk16); in.k1 = *(const bf16x8*)(P + rb + C_RK + h * 128 + kk16 + 8);
    in.v0 = *(const bf16x8*)(P + rb + C_RV + h * 128 + kk16); in.v1 = *(const bf16x8*)(P + rb + C_RV + h * 128 + kk16 + 8);
    if (need_qg) {
        in.q0 = *(const bf16x8*)(P + rb + C_RQ + h * 128 + kk16); in.q1 = *(const bf16x8*)(P + rb + C_RQ + h * 128 + kk16 + 8);
        in.g0 = *(const bf16x8*)(P + rb + C_RG + h * 128 + kk16); in.g1 = *(const bf16x8*)(P + rb + C_RG + h * 128 + kk16 + 8);
    }
    if (c >= 4) { const float* tb = rret + ((size_t)((c - 4) * 64 + tk) * 64 + (kk16 >> 1)) * 2;
        in.cs0 = *(const f32x4*)(tb); in.cs1 = *(const f32x4*)(tb + 4); in.cs2 = *(const f32x4*)(tb + 8); in.cs3 = *(const f32x4*)(tb + 12); }
}
DEVI void ret_rot(const bf16x8 r0, const bf16x8 r1, const RetIn& in, bool lat, float scale, float (&o)[16]) {
    float a[8], c[8]; unpack8(r0, a); unpack8(r1, c);
#pragma unroll
    for (int i = 0; i < 8; ++i) { o[i] = a[i]; o[8 + i] = c[i]; }
    if (lat) {
#pragma unroll
        for (int q = 0; q < 4; ++q) { const f32x4 cs = (q == 0) ? in.cs0 : (q == 1) ? in.cs1 : (q == 2) ? in.cs2 : in.cs3;
            const float x1 = o[4 * q], x2 = o[4 * q + 1], y1 = o[4 * q + 2], y2 = o[4 * q + 3];
            o[4 * q] = x1 * cs[0] - x2 * cs[1]; o[4 * q + 1] = x1 * cs[1] + x2 * cs[0];
            o[4 * q + 2] = y1 * cs[2] - y2 * cs[3]; o[4 * q + 3] = y1 * cs[3] + y2 * cs[2]; }
    }
#pragma unroll
    for (int i = 0; i < 16; ++i) o[i] *= scale;
}

DEVI void scan_a_ret(const Params& p, int l, int b, int h, int c, const RetIn& in, char* smem) {
    bf16_t* kTf = (bf16_t*)smem; bf16_t* kTb = kTf + 128 * 72; bf16_t* vT = kTb + 128 * 72;
    const int tid = opaque_tid(), wid = tid >> 6, lane = tid & 63, fr = lane & 15, fq = lane >> 4;
    const bool lat = c >= 4;
    const int tk = tid >> 3, kk16 = (tid & 7) * 16;
    float ldf, ldb; ret_decays(h, ldf, ldb);
    float kf[16];
    ret_rot(in.k0, in.k1, in, lat, 0.08838834764831845f, kf);
    const float ef = __expf(ldf * (float)(63 - tk)), eb = __expf(ldb * (float)tk);
#pragma unroll
    for (int e = 0; e < 16; ++e) { kTf[(kk16 + e) * 72 + tk] = f2bf(kf[e] * ef); kTb[(kk16 + e) * 72 + tk] = f2bf(kf[e] * eb); }
    {   const bf16x8 v0 = in.v0, v1 = in.v1;
#pragma unroll
        for (int e = 0; e < 8; ++e) { vT[(kk16 + e) * 72 + tk] = (bf16_t)v0[e]; vT[(kk16 + 8 + e) * 72 + tk] = (bf16_t)v1[e]; } }
    __syncthreads();
    {   const int dir = wid >> 2;
        const bf16_t* kT = dir ? kTb : kTf;
        bf16_t* UT = (bf16_t*)(p.ws + WS_UTR) + ((size_t)((b * 4 + h) * 2 + dir) * NCH + order_idx(dir, c)) * (128 * 128);
#pragma unroll
        for (int q = 0; q < 2; ++q) { const int kkf = (wid & 3) * 2 + q;
            const bf16x8 a0 = ldfrag(kT, 72, kkf * 16, 0, fr, fq), a1 = ldfrag(kT, 72, kkf * 16, 32, fr, fq);
#pragma unroll
            for (int vf = 0; vf < 8; ++vf) {
                f32x4 acc = {0.f, 0.f, 0.f, 0.f};
                acc = __builtin_amdgcn_mfma_f32_16x16x32_bf16(a0, ldfrag(vT, 72, vf * 16, 0, fr, fq), acc, 0, 0, 0);
                acc = __builtin_amdgcn_mfma_f32_16x16x32_bf16(a1, ldfrag(vT, 72, vf * 16, 32, fr, fq), acc, 0, 0, 0);
                *(u32x2*)(UT + (vf * 16 + fr) * 128 + kkf * 16 + fq * 4) = (u32x2){cvt_pk(acc[0], acc[1]), cvt_pk(acc[2], acc[3])};
            } }
    }
    __syncthreads();
}

DEVI void phase_prefix(const Params& p, char* smem, int widx, int nworkers) {
    const int NT_G = 32 * 2048, NT_R = 32 * 4096;
    for (int g = widx * 512 + threadIdx.x; g < NT_G + NT_R; g += nworkers * 512) {
        if (g < NT_G) {
            const int seq = g >> 11, e4 = (g & 2047) * 4, kk = e4 & 63;
            const bf16_t* U = (const bf16_t*)(p.ws + WS_UTG) + (size_t)seq * NCH * 8192 + e4;
            bf16_t* S = (bf16_t*)(p.ws + WS_STG) + (size_t)seq * NCH * 8192 + e4;
            const float* dec = (const float*)(p.ws + WS_DECG) + (size_t)seq * NCH * 64 + kk;
            f32x4 st = {0.f, 0.f, 0.f, 0.f};
#pragma unroll 12
            for (int o = 0; o < NCH; ++o) {
                const u32x2 uw = *(const u32x2*)(U + (size_t)o * 8192); const f32x4 u = {bflo(uw[0]), bfhi(uw[0]), bflo(uw[1]), bfhi(uw[1])}; const f32x4 dd = *(const f32x4*)(dec + o * 64);
                *(u32x2*)(S + (size_t)o * 8192) = (u32x2){cvt_pk(st[0], st[1]), cvt_pk(st[2], st[3])};
                st = dd * st + u;
            }
        } else {
            const int g2 = g - NT_G, seq = g2 >> 12, e4 = (g2 & 4095) * 4;
            const int h = (seq >> 1) & 3, dir = seq & 1;
            float ldf, ldb; ret_decays(h, ldf, ldb);
            const float dd = __expf(64.f * (dir ? ldb : ldf));
            const bf16_t* U = (const bf16_t*)(p.ws + WS_UTR) + (size_t)seq * NCH * 16384 + e4;
            bf16_t* S = (bf16_t*)(p.ws + WS_STR) + (size_t)seq * NCH * 16384 + e4;
            f32x4 st = {0.f, 0.f, 0.f, 0.f};
#pragma unroll 12
            for (int o = 0; o < NCH; ++o) {
                const u32x2 uw = *(const u32x2*)(U + (size_t)o * 16384); const f32x4 u = {bflo(uw[0]), bfhi(uw[0]), bflo(uw[1]), bfhi(uw[1])};
                *(u32x2*)(S + (size_t)o * 16384) = (u32x2){cvt_pk(st[0], st[1]), cvt_pk(st[2], st[3])};
                st = dd * st + u;
            }
        }
    }
}

DEVI void scan_c_tail(const float* o, int tid, const bf16x8 g0, const bf16x8 g1, int row0, bf16_t* ymix, int ycol) {
    const int tk = tid >> 3, v16 = (tid & 7) * 16;
    float ov[16]; float ss = 0.f;
#pragma unroll
    for (int q = 0; q < 4; ++q) { const f32x4 t = *(const f32x4*)(o + tk * 128 + v16 + q * 4); ov[q * 4] = t[0]; ov[q * 4 + 1] = t[1]; ov[q * 4 + 2] = t[2]; ov[q * 4 + 3] = t[3]; }
#pragma unroll
    for (int i = 0; i < 16; ++i) ss += ov[i] * ov[i];
    ss += __shfl_xor(ss, 1); ss += __shfl_xor(ss, 2); ss += __shfl_xor(ss, 4);
    const float rstd = rsqrtf(ss * (1.f / 128.f) + EPS);
    float ga[8], gb[8]; unpack8(g0, ga); unpack8(g1, gb);
    float y0[8], y1[8];
#pragma unroll
    for (int i = 0; i < 8; ++i) { y0[i] = ov[i] * rstd * silu_f(ga[i]); y1[i] = ov[8 + i] * rstd * silu_f(gb[i]); }
    *(bf16x8*)(ymix + (size_t)(row0 + tk) * DM + ycol + v16) = pack8(y0);
    *(bf16x8*)(ymix + (size_t)(row0 + tk) * DM + ycol + v16 + 8) = pack8(y1);
}

DEVI void scan_c_gla(const Params& p, int l, int b, int h, int c, const GlaIn& in, char* smem) {
    float* cum = (float*)(smem + 18432);
    float* obuf = cum;
    bf16_t* qdf = (bf16_t*)(smem + 51200); bf16_t* qdb = qdf + 64 * 72; bf16_t* kif = qdb + 64 * 72; bf16_t* kib = kif + 64 * 72;
    bf16_t* vT = kib + 64 * 72; bf16_t* att = vT + 128 * 72;
    const int tid = opaque_tid(), wid = tid >> 6, lane = tid & 63, fr = lane & 15, fq = lane >> 4;
    const int row0 = chunk_row0(b, c);
    const int tk = tid >> 3, c8 = (tid & 7) * 8;
    const bf16x8 qreg = in.q, kreg = in.k, v0 = in.v0, v1 = in.v1, gt0 = in.g0, gt1 = in.g1;
    const bf16_t* SF = (const bf16_t*)(p.ws + WS_STG) + ((size_t)((b * 4 + h) * 2 + 0) * NCH + order_idx(0, c)) * 8192;
    const bf16_t* SB = (const bf16_t*)(p.ws + WS_STG) + ((size_t)((b * 4 + h) * 2 + 1) * NCH + order_idx(1, c)) * 8192;
    const bf16x8 sf0 = *(const bf16x8*)(SF + (wid * 16 + fr) * 64 + fq * 8), sf1 = *(const bf16x8*)(SF + (wid * 16 + fr) * 64 + 32 + fq * 8);
    const bf16x8 sb0 = *(const bf16x8*)(SB + (wid * 16 + fr) * 64 + fq * 8), sb1 = *(const bf16x8*)(SB + (wid * 16 + fr) * 64 + 32 + fq * 8);
    gla_cum(in, cum);
    {   float qf[8], kf[8]; unpack8(qreg, qf); unpack8(kreg, kf);
        float a[8], bq[8], cc[8], dq[8];
#pragma unroll
        for (int e = 0; e < 8; ++e) { const float cf = cum[(0 * 64 + tk) * 64 + c8 + e], cb = cum[(1 * 64 + tk) * 64 + c8 + e];
            a[e] = qf[e] * 0.125f * __expf(cf); bq[e] = qf[e] * 0.125f * __expf(cb); cc[e] = kf[e] * __expf(-cf); dq[e] = kf[e] * __expf(-cb); }
        *(bf16x8*)(qdf + tk * 72 + c8) = pack8(a); *(bf16x8*)(qdb + tk * 72 + c8) = pack8(bq);
        *(bf16x8*)(kif + tk * 72 + c8) = pack8(cc); *(bf16x8*)(kib + tk * 72 + c8) = pack8(dq);
#pragma unroll
        for (int e = 0; e < 8; ++e) { vT[(c8 + e) * 72 + tk] = (bf16_t)v0[e]; vT[(64 + c8 + e) * 72 + tk] = (bf16_t)v1[e]; }
    }
    __syncthreads();
    {
        const int jf = wid & 3;
#pragma unroll
        for (int q = 0; q < 2; ++q) { const int iff = (wid >> 2) * 2 + q;
            f32x4 af = {0.f, 0.f, 0.f, 0.f}, ab = {0.f, 0.f, 0.f, 0.f};
            if (iff >= jf) {
                af = __builtin_amdgcn_mfma_f32_16x16x32_bf16(ldfrag(kif, 72, jf * 16, 0, fr, fq), ldfrag(qdf, 72, iff * 16, 0, fr, fq), af, 0, 0, 0);
                af = __builtin_amdgcn_mfma_f32_16x16x32_bf16(ldfrag(kif, 72, jf * 16, 32, fr, fq), ldfrag(qdf, 72, iff * 16, 32, fr, fq), af, 0, 0, 0); }
            if (iff <= jf) {
                ab = __builtin_amdgcn_mfma_f32_16x16x32_bf16(ldfrag(kib, 72, jf * 16, 0, fr, fq), ldfrag(qdb, 72, iff * 16, 0, fr, fq), ab, 0, 0, 0);
                ab = __builtin_amdgcn_mfma_f32_16x16x32_bf16(ldfrag(kib, 72, jf * 16, 32, fr, fq), ldfrag(qdb, 72, iff * 16, 32, fr, fq), ab, 0, 0, 0); }
            const int i = iff * 16 + fr, j0 = jf * 16 + fq * 4;
            float r[4];
#pragma unroll
            for (int e = 0; e < 4; ++e) r[e] = (j0 + e <= i) ? af[e] : ab[e];
            *(u32x2*)(att + i * 72 + j0) = (u32x2){cvt_pk(r[0], r[1]), cvt_pk(r[2], r[3])};
        }
    }
    __syncthreads();
    {   const int vf = wid;
        const bf16x8 vt0 = ldfrag(vT, 72, vf * 16, 0, fr, fq), vt1 = ldfrag(vT, 72, vf * 16, 32, fr, fq);
#pragma unroll
        for (int iff = 0; iff < 4; ++iff) {
            f32x4 acc = {0.f, 0.f, 0.f, 0.f};
            acc = __builtin_amdgcn_mfma_f32_16x16x32_bf16(vt0, ldfrag(att, 72, iff * 16, 0, fr, fq), acc, 0, 0, 0);
            acc = __builtin_amdgcn_mfma_f32_16x16x32_bf16(vt1, ldfrag(att, 72, iff * 16, 32, fr, fq), acc, 0, 0, 0);
            acc = __builtin_amdgcn_mfma_f32_16x16x32_bf16(sf0, ldfrag(qdf, 72, iff * 16, 0, fr, fq), acc, 0, 0, 0);
            acc = __builtin_amdgcn_mfma_f32_16x16x32_bf16(sf1, ldfrag(qdf, 72, iff * 16, 32, fr, fq), acc, 0, 0, 0);
            acc = __builtin_amdgcn_mfma_f32_16x16x32_bf16(sb0, ldfrag(qdb, 72, iff * 16, 0, fr, fq), acc, 0, 0, 0);
            acc = __builtin_amdgcn_mfma_f32_16x16x32_bf16(sb1, ldfrag(qdb, 72, iff * 16, 32, fr, fq), acc, 0, 0, 0);
            *(f32x4*)(obuf + (iff * 16 + fr) * 128 + vf * 16 + fq * 4) = acc;
        }
    }
    __syncthreads();
    scan_c_tail(obuf, tid, gt0, gt1, row0, (bf16_t*)(p.ws + WS_YMIX), 1024 + h * 128);
    __syncthreads();
}

DEVI void scan_c_ret(const Params& p, int l, int b, int h, int c, const RetIn& in, char* smem) {
    float* obuf = (float*)smem;
    bf16_t* qs = (bf16_t*)(smem + 32768); bf16_t* ks = qs + 64 * 136; bf16_t* vT = ks + 64 * 136; bf16_t* att = vT + 128 * 72;
    const int tid = opaque_tid(), wid = tid >> 6, lane = tid & 63, fr = lane & 15, fq = lane >> 4;
    const int row0 = chunk_row0(b, c); const bool lat = c >= 4;
    const int tk = tid >> 3, kk16 = (tid & 7) * 16;
    float ldf, ldb; ret_decays(h, ldf, ldb);
    const bf16x8 gt0 = in.g0, gt1 = in.g1;
    const bf16_t* SF = (const bf16_t*)(p.ws + WS_STR) + ((size_t)((b * 4 + h) * 2 + 0) * NCH + order_idx(0, c)) * 16384;
    const bf16_t* SB = (const bf16_t*)(p.ws + WS_STR) + ((size_t)((b * 4 + h) * 2 + 1) * NCH + order_idx(1, c)) * 16384;
    bf16x8 sff[4], sbf[4];
#pragma unroll
    for (int ksx = 0; ksx < 4; ++ksx) { sff[ksx] = *(const bf16x8*)(SF + (wid * 16 + fr) * 128 + ksx * 32 + fq * 8); sbf[ksx] = *(const bf16x8*)(SB + (wid * 16 + fr) * 128 + ksx * 32 + fq * 8); }
    {   float qf[16], kf[16];
        ret_rot(in.q0, in.q1, in, lat, 1.f, qf);
        ret_rot(in.k0, in.k1, in, lat, 0.08838834764831845f, kf);
        float t0[8], t1[8];
#pragma unroll
        for (int e = 0; e < 8; ++e) { t0[e] = qf[e]; t1[e] = qf[8 + e]; }
        *(bf16x8*)(qs + tk * 136 + kk16) = pack8(t0); *(bf16x8*)(qs + tk * 136 + kk16 + 8) = pack8(t1);
#pragma unroll
        for (int e = 0; e < 8; ++e) { t0[e] = kf[e]; t1[e] = kf[8 + e]; }
        *(bf16x8*)(ks + tk * 136 + kk16) = pack8(t0); *(bf16x8*)(ks + tk * 136 + kk16 + 8) = pack8(t1);
        const bf16x8 v0 = in.v0, v1 = in.v1;
#pragma unroll
        for (int e = 0; e < 8; ++e) { vT[(kk16 + e) * 72 + tk] = (bf16_t)v0[e]; vT[(kk16 + 8 + e) * 72 + tk] = (bf16_t)v1[e]; }
    }
    __syncthreads();
    {   const int jf = wid & 3;
#pragma unroll
        for (int q = 0; q < 2; ++q) { const int iff = (wid >> 2) * 2 + q;
            f32x4 a = {0.f, 0.f, 0.f, 0.f};
#pragma unroll
            for (int ksx = 0; ksx < 4; ++ksx) a = __builtin_amdgcn_mfma_f32_16x16x32_bf16(ldfrag(ks, 136, jf * 16, ksx * 32, fr, fq), ldfrag(qs, 136, iff * 16, ksx * 32, fr, fq), a, 0, 0, 0);
            const int i = iff * 16 + fr, j0 = jf * 16 + fq * 4;
            float r[4];
#pragma unroll
            for (int e = 0; e < 4; ++e) { const int j = j0 + e; r[e] = a[e] * ((j <= i) ? __expf(ldf * (float)(i - j)) : __expf(ldb * (float)(j - i))); }
            *(u32x2*)(att + i * 72 + j0) = (u32x2){cvt_pk(r[0], r[1]), cvt_pk(r[2], r[3])};
        }
    }
    __syncthreads();
    {   const int vf = wid;
        const bf16x8 vt0 = ldfrag(vT, 72, vf * 16, 0, fr, fq), vt1 = ldfrag(vT, 72, vf * 16, 32, fr, fq);
#pragma unroll
        for (int iff = 0; iff < 4; ++iff) {
            const int i = iff * 16 + fr;
            const float sf = __expf(ldf * (float)(i + 1)), sb = __expf(ldb * (float)(64 - i));
            f32x4 acc = {0.f, 0.f, 0.f, 0.f}, accf = {0.f, 0.f, 0.f, 0.f}, accb = {0.f, 0.f, 0.f, 0.f};
            acc = __builtin_amdgcn_mfma_f32_16x16x32_bf16(vt0, ldfrag(att, 72, iff * 16, 0, fr, fq), acc, 0, 0, 0);
            acc = __builtin_amdgcn_mfma_f32_16x16x32_bf16(vt1, ldfrag(att, 72, iff * 16, 32, fr, fq), acc, 0, 0, 0);
#pragma unroll
            for (int ksx = 0; ksx < 4; ++ksx) { const bf16x8 qv = ldfrag(qs, 136, iff * 16, ksx * 32, fr, fq);
                accf = __builtin_amdgcn_mfma_f32_16x16x32_bf16(sff[ksx], qv, accf, 0, 0, 0);
                accb = __builtin_amdgcn_mfma_f32_16x16x32_bf16(sbf[ksx], qv, accb, 0, 0, 0); }
            *(f32x4*)(obuf + i * 128 + vf * 16 + fq * 4) = acc + sf * accf + sb * accb;
        }
    }
    __syncthreads();
    scan_c_tail(obuf, tid, gt0, gt1, row0, (bf16_t*)(p.ws + WS_YMIX), 1536 + h * 128);
    __syncthreads();
}

namespace att {
constexpr int DQ = 192, DV = 128, NW = 8, QBLK = 32, KVBLK = 64;
constexpr int SHM_V = KVBLK * DV * 2, SHM_K = KVBLK * 400;
constexpr float THR = 8.f;
#define KSWZ(row, colB) ((row) * 400 + (colB))
#define SBAR() __builtin_amdgcn_sched_barrier(0)
DEVI int crow(int r, int hi) { return (r & 3) + 8 * (r >> 2) + 4 * hi; }
DEVI unsigned cvtpk(float lo, float hi) { unsigned r; asm volatile("v_cvt_pk_bf16_f32 %0, %1, %2" : "=v"(r) : "v"(lo), "v"(hi)); return r; }
DEVI void partialSM(f32x16& p0, f32x16& p1, float& m_reg, float& mn, float& alpha) {
    constexpr float C = 1.4426950408889634f;
    float pmax = p0[0];
#pragma unroll
    for (int r = 1; r < 16; ++r) pmax = fmaxf(pmax, p0[r]);
#pragma unroll
    for (int r = 0; r < 16; ++r) pmax = fmaxf(pmax, p1[r]);
    { auto rr = __builtin_amdgcn_permlane32_swap(__float_as_uint(pmax), __float_as_uint(pmax), false, false);
      pmax = fmaxf(__uint_as_float(rr[0]), __uint_as_float(rr[1])); }
    if (__builtin_expect(__all(pmax - m_reg <= THR), 1)) { mn = m_reg; alpha = 1.f; }
    else { mn = fmaxf(m_reg, pmax); alpha = __builtin_amdgcn_exp2f((m_reg - mn) * C); m_reg = mn; }
    const float mnC = -mn * C;
#pragma unroll
    for (int r = 0; r < 16; ++r) p0[r] = fmaf(p0[r], C, mnC);
#pragma unroll
    for (int r = 0; r < 16; ++r) p1[r] = fmaf(p1[r], C, mnC);
#pragma unroll
    for (int r = 0; r < 16; ++r) p0[r] = __builtin_amdgcn_exp2f(p0[r]);
}
DEVI void finishSM(f32x16& p0, f32x16& p1, float alpha, float& l_reg, bf16x8& pa0, bf16x8& pa1, bf16x8& pa2, bf16x8& pa3) {
#pragma unroll
    for (int r = 0; r < 16; ++r) p1[r] = __builtin_amdgcn_exp2f(p1[r]);
    float ps = 0;
#pragma unroll
    for (int r = 0; r < 16; ++r) ps += p0[r];
#pragma unroll
    for (int r = 0; r < 16; ++r) ps += p1[r];
    { auto rr = __builtin_amdgcn_permlane32_swap(__float_as_uint(ps), __float_as_uint(ps), false, false);
      ps = __uint_as_float(rr[0]) + __uint_as_float(rr[1]); }
    l_reg = l_reg * alpha + ps;
#define PK4(P, BASE, OUT) do { unsigned a0 = cvtpk(P[BASE + 0], P[BASE + 1]), a1 = cvtpk(P[BASE + 2], P[BASE + 3]);   \
    unsigned b0 = cvtpk(P[BASE + 4], P[BASE + 5]), b1 = cvtpk(P[BASE + 6], P[BASE + 7]);                              \
    auto r0 = __builtin_amdgcn_permlane32_swap(a0, b0, false, false); auto r1 = __builtin_amdgcn_permlane32_swap(a1, b1, false, false); \
    u32x4 w = {r0[0], r1[0], r0[1], r1[1]}; OUT = __builtin_bit_cast(bf16x8, w); } while (0)
    PK4(p0, 0, pa0); PK4(p0, 8, pa1); PK4(p1, 0, pa2); PK4(p1, 8, pa3);
#undef PK4
}
DEVI void qkt(f32x16& p0, f32x16& p1, const char* Ks, const bf16x8* qr, const char* qL, int r32, int hi) {
    p0 = (f32x16){0.f, 0.f, 0.f, 0.f, 0.f, 0.f, 0.f, 0.f, 0.f, 0.f, 0.f, 0.f, 0.f, 0.f, 0.f, 0.f}; p1 = p0;
#pragma unroll
    for (int d0 = 0; d0 < 12; ++d0) { const int cb = (d0 * 16 + hi * 8) * 2;
        const bf16x8 b0 = *(const bf16x8*)(Ks + KSWZ(r32, cb));
        const bf16x8 b1 = *(const bf16x8*)(Ks + KSWZ(32 + r32, cb));
        const bf16x8 qv = (d0 < 8) ? qr[d0 < 8 ? d0 : 0] : *(const bf16x8*)(qL + (d0 - 8) * 1024);
        p0 = __builtin_amdgcn_mfma_f32_32x32x16_bf16(b0, qv, p0, 0, 0, 0);
        p1 = __builtin_amdgcn_mfma_f32_32x32x16_bf16(b1, qv, p1, 0, 0, 0); }
}
DEVI int v_st(int k, int c) { const int kk = (k & ~0xC) | ((k & 4) << 1) | ((k & 8) >> 1); return ((kk >> 3) * 4 + (c >> 5)) * 512 + ((kk & 7) * 32 + (c & 31)) * 2; }
DEVI int v_rd_base(int lane) { return ((lane & 3) << 3) | (((lane >> 2) & 3) << 6) | (((lane >> 4) & 1) << 5) | (((lane >> 5) & 1) << 8); }
constexpr int v_rd_off(int d0, int ks, int half) { return d0 * 512 + ks * 4096 + half * 2048; }
template <int OFF> DEVI s16x4 tr_read(int vb) { s16x4 r; asm volatile("ds_read_b64_tr_b16 %0, %1 offset:%2" : "=&v"(r) : "v"(vb), "i"(OFF) : "memory"); return r; }
template <int D0> DEVI void pv_one(f32x16& od, int vb, bf16x8 pa0, bf16x8 pa1, bf16x8 pa2, bf16x8 pa3) {
    const s16x4 l0 = tr_read<v_rd_off(D0, 0, 0)>(vb), h0 = tr_read<v_rd_off(D0, 0, 1)>(vb), l1 = tr_read<v_rd_off(D0, 1, 0)>(vb), h1 = tr_read<v_rd_off(D0, 1, 1)>(vb);
    const s16x4 l2 = tr_read<v_rd_off(D0, 2, 0)>(vb), h2 = tr_read<v_rd_off(D0, 2, 1)>(vb), l3 = tr_read<v_rd_off(D0, 3, 0)>(vb), h3 = tr_read<v_rd_off(D0, 3, 1)>(vb);
    asm volatile("s_waitcnt lgkmcnt(0)" ::: "memory"); SBAR();
#define PKV(L, H) (bf16x8){L[0], L[1], L[2], L[3], H[0], H[1], H[2], H[3]}
    od = __builtin_amdgcn_mfma_f32_32x32x16_bf16(pa0, PKV(l0, h0), od, 0, 0, 0);
    od = __builtin_amdgcn_mfma_f32_32x32x16_bf16(pa1, PKV(l1, h1), od, 0, 0, 0);
    od = __builtin_amdgcn_mfma_f32_32x32x16_bf16(pa2, PKV(l2, h2), od, 0, 0, 0);
    od = __builtin_amdgcn_mfma_f32_32x32x16_bf16(pa3, PKV(l3, h3), od, 0, 0, 0);
#undef PKV
}
DEVI void pv_d0(f32x16* o, int vb, bf16x8 pa0, bf16x8 pa1, bf16x8 pa2, bf16x8 pa3) {
    pv_one<0>(o[0], vb, pa0, pa1, pa2, pa3); pv_one<1>(o[1], vb, pa0, pa1, pa2, pa3); pv_one<2>(o[2], vb, pa0, pa1, pa2, pa3); pv_one<3>(o[3], vb, pa0, pa1, pa2, pa3);
}
DEVI void attn_body(const bf16_t* __restrict__ Qb, const bf16_t* __restrict__ Kh, const bf16_t* __restrict__ Vh, bf16_t* __restrict__ Ob, int seq, char* lds) {
    const int tid = opaque_tid(), wid = tid >> 6, lane = tid & 63, r32 = lane & 31, hi = lane >> 5;
    char* V_lds = lds; char* K_lds = lds + 2 * SHM_V;
    float* wsf = (float*)(lds + 2 * SHM_V + 2 * SHM_K) + wid * 64; float* li_l = wsf; float* al_l = wsf + 32;
    float m_reg = -1e30f, l_reg = 0;
    f32x16 o[4];
#pragma unroll
    for (int d = 0; d < 4; ++d) o[d] = (f32x16){0.f, 0.f, 0.f, 0.f, 0.f, 0.f, 0.f, 0.f, 0.f, 0.f, 0.f, 0.f, 0.f, 0.f, 0.f, 0.f};
    bf16x8 qr[8];
    const bf16_t* Qw = Qb + (size_t)(wid * QBLK + r32) * DQ + hi * 8;
    char* qL = lds + 2 * SHM_V + 2 * SHM_K + NW * 64 * 4 + wid * 4096 + lane * 16;
#pragma unroll
    for (int d0 = 0; d0 < 8; ++d0) qr[d0] = *(const bf16x8*)(Qw + d0 * 16);
#pragma unroll
    for (int d0 = 8; d0 < 12; ++d0) *(bf16x8*)(qL + (d0 - 8) * 1024) = *(const bf16x8*)(Qw + d0 * 16);
    const int sr = tid >> 4, sc = (tid & 15) * 8, vst0 = v_st(sr, sc), vst1 = v_st(32 + sr, sc);
    const int kr0 = tid / 24, kc0 = (tid % 24) * 8, kr1 = (tid + 512) / 24, kc1 = ((tid + 512) % 24) * 8, kr2 = (tid + 1024) / 24, kc2 = ((tid + 1024) % 24) * 8;
    const int kst0 = KSWZ(kr0, kc0 * 2), kst1 = KSWZ(kr1, kc1 * 2), kst2 = KSWZ(kr2, kc2 * 2);
    const int vb0 = (int)(uintptr_t)V_lds + v_rd_base(lane);
    bf16x8 sv0, sv1, sk0, sk1, sk2;
#define SLOAD(k0) do { sv0 = *(const bf16x8*)(Vh + (size_t)((k0) + sr) * DV + sc); sv1 = *(const bf16x8*)(Vh + (size_t)((k0) + 32 + sr) * DV + sc); \
    sk0 = *(const bf16x8*)(Kh + (size_t)((k0) + kr0) * DQ + kc0); sk1 = *(const bf16x8*)(Kh + (size_t)((k0) + kr1) * DQ + kc1); sk2 = *(const bf16x8*)(Kh + (size_t)((k0) + kr2) * DQ + kc2); } while (0)
#define SWRITE(b) do { *(bf16x8*)(V_lds + (b) * SHM_V + vst0) = sv0; *(bf16x8*)(V_lds + (b) * SHM_V + vst1) = sv1; \
    *(bf16x8*)(K_lds + (b) * SHM_K + kst0) = sk0; *(bf16x8*)(K_lds + (b) * SHM_K + kst1) = sk1; *(bf16x8*)(K_lds + (b) * SHM_K + kst2) = sk2; } while (0)
#define RESC(a) do { if (__any((a) < 1.f)) { if (hi == 0) al_l[r32] = (a); asm volatile("s_waitcnt lgkmcnt(0)" ::: "memory"); \
    _Pragma("unroll") for (int d = 0; d < 4; ++d) _Pragma("unroll") for (int r = 0; r < 16; ++r) o[d][r] *= al_l[crow(r, hi)]; } } while (0)
    f32x16 pA0, pA1, pB0, pB1; float mnA, mnB, alA, alB; bf16x8 pa0, pa1, pa2, pa3; const int NT = seq / KVBLK;
    SLOAD(0); SWRITE(0); __syncthreads();
    qkt(pA0, pA1, K_lds, qr, qL, r32, hi); partialSM(pA0, pA1, m_reg, mnA, alA);
    SLOAD(KVBLK); SWRITE(1); __syncthreads();
    for (int j = 1; j + 1 < NT; j += 2) {
        SBAR(); qkt(pB0, pB1, K_lds + SHM_K, qr, qL, r32, hi);
        finishSM(pA0, pA1, alA, l_reg, pa0, pa1, pa2, pa3); SBAR();
        SLOAD((j + 1) * KVBLK); SBAR();
        pv_d0(o, vb0, pa0, pa1, pa2, pa3); partialSM(pB0, pB1, m_reg, mnB, alB);
        __syncthreads(); SWRITE(0);
        RESC(alB); __syncthreads();
        SBAR(); qkt(pA0, pA1, K_lds, qr, qL, r32, hi);
        finishSM(pB0, pB1, alB, l_reg, pa0, pa1, pa2, pa3); SBAR();
        SLOAD((j + 2) * KVBLK); SBAR();
        pv_d0(o, vb0 + SHM_V, pa0, pa1, pa2, pa3); partialSM(pA0, pA1, m_reg, mnA, alA);
        __syncthreads(); SWRITE(1);
        RESC(alA); __syncthreads();
    }
    SBAR(); qkt(pB0, pB1, K_lds + SHM_K, qr, qL, r32, hi);
    finishSM(pA0, pA1, alA, l_reg, pa0, pa1, pa2, pa3); SBAR();
    pv_d0(o, vb0, pa0, pa1, pa2, pa3); partialSM(pB0, pB1, m_reg, mnB, alB);
    __syncthreads(); RESC(alB);
    finishSM(pB0, pB1, alB, l_reg, pa0, pa1, pa2, pa3); SBAR();
    pv_d0(o, vb0 + SHM_V, pa0, pa1, pa2, pa3);
    if (hi == 0) li_l[r32] = l_reg; asm volatile("s_waitcnt lgkmcnt(0)" ::: "memory");
    float rli[16];
#pragma unroll
    for (int r = 0; r < 16; ++r) rli[r] = __builtin_amdgcn_rcpf(li_l[crow(r, hi)]);
    bf16_t* Ow = Ob + (size_t)(wid * QBLK) * DM;
#pragma unroll
    for (int r = 0; r < 16; ++r) { const int orow = crow(r, hi);
#pragma unroll
        for (int d0 = 0; d0 < 4; ++d0) Ow[(size_t)orow * DM + d0 * 32 + r32] = f2bf(o[d0][r] * rli[r]); }
    __syncthreads();
#undef SLOAD
#undef SWRITE
#undef RESC
}
}

template <int WIDTH>
DEVI void rstd_table(const bf16_t* P, int row0, int col0, float* rs) {
    constexpr int hw = WIDTH >> 1;
    const int tid = opaque_tid(), r = tid >> 1, half = tid & 1;
    const bf16_t* src = P + (size_t)(row0 + r) * INC + col0 + half * hw;
    float ss = 0.f;
#pragma unroll
    for (int i0 = 0; i0 < hw; i0 += 128) {
        bf16x8 t[16];
#pragma unroll
        for (int i = 0; i < 16; ++i) t[i] = *(const bf16x8*)(src + i0 + i * 8);
#pragma unroll
        for (int i = 0; i < 16; ++i) { float f[8]; unpack8(t[i], f);
#pragma unroll
            for (int e = 0; e < 8; ++e) ss += f[e] * f[e]; }
    }
    ss += __shfl_xor(ss, 1);
    if (half == 0) rs[r] = rsqrtf(ss / (float)WIDTH + EPS);
    __syncthreads();
}
struct EpiQ { static constexpr bool PERM = true; bf16_t* Q; const float* rs; const float* rax;
    DEVI void operator()(const f32x4 (&acc)[2][2][4][2], const pg8::Unit& u, int wr, int wc, int fr, int fq) const {
#pragma unroll
        for (int ai = 0; ai < 2; ++ai)
#pragma unroll
            for (int m = 0; m < 4; ++m) { const int rl = ai * 128 + wr * 64 + m * 16 + fr, row = u.pm * 256 + rl; const float sc = rs[u.ord * 256 + rl] * QSCALE;
                const bool lat = row < NLAT; const int b = lat ? (row >> 11) : ((row - NLAT) >> 8); const int t = lat ? (row & 2047) : ((row - NLAT) & 255);
                const int qpos = lat ? (CL + t) : t;
#pragma unroll
                for (int bj = 0; bj < 2; ++bj) { const int col = u.pn * 256 + bj * 128 + wc * 32 + 8 * fq; const int head = col / 192, d = col - head * 192;
                    f32x4 v0 = acc[ai][bj][m][0] * sc, v1 = acc[ai][bj][m][1] * sc;
                    if (lat && d >= 128) { const int pi = (d - 128) >> 1; const int pos = (pi < 16) ? (t >> 6) : (t & 63);
                        const f32x4 c0 = *(const f32x4*)(rax + (pos * 16 + (pi & 15)) * 2), c1 = *(const f32x4*)(rax + (pos * 16 + (pi & 15)) * 2 + 4);
                        v0 = (f32x4){v0[0] * c0[0] - v0[1] * c0[1], v0[0] * c0[1] + v0[1] * c0[0], v0[2] * c0[2] - v0[3] * c0[3], v0[2] * c0[3] + v0[3] * c0[2]};
                        v1 = (f32x4){v1[0] * c1[0] - v1[1] * c1[1], v1[0] * c1[1] + v1[1] * c1[0], v1[2] * c1[2] - v1[3] * c1[3], v1[2] * c1[3] + v1[3] * c1[2]}; }
                    *(u32x4*)(Q + ((size_t)(b * 8 + head) * KEYS + qpos) * 192 + d) = (u32x4){cvt_pk(v0[0], v0[1]), cvt_pk(v0[2], v0[3]), cvt_pk(v1[0], v1[1]), cvt_pk(v1[2], v1[3])}; }
                __builtin_amdgcn_sched_barrier(0); }
    } };
struct EpiKV { static constexpr bool PERM = true; bf16_t* Kb; bf16_t* Vb; const float* rs;
    DEVI void operator()(const f32x4 (&acc)[2][2][4][2], const pg8::Unit& u, int wr, int wc, int fr, int fq) const {
#pragma unroll
        for (int ai = 0; ai < 2; ++ai)
#pragma unroll
            for (int m = 0; m < 4; ++m) { const int rl = ai * 128 + wr * 64 + m * 16 + fr, row = u.pm * 256 + rl; const float sc = rs[u.ord * 256 + rl];
                const bool lat = row < NLAT; const int b = lat ? (row >> 11) : ((row - NLAT) >> 8); const int t = lat ? (row & 2047) : ((row - NLAT) & 255);
                const int kpos = lat ? (CL + t) : t; const int d = wc * 32 + 8 * fq;
                { const f32x4 v0 = acc[ai][0][m][0] * sc, v1 = acc[ai][0][m][1] * sc;
                  *(u32x4*)(Kb + ((size_t)(b * 8 + u.pn) * KEYS + kpos) * 192 + d) = (u32x4){cvt_pk(v0[0], v0[1]), cvt_pk(v0[2], v0[3]), cvt_pk(v1[0], v1[1]), cvt_pk(v1[2], v1[3])}; }
                { const f32x4 v0 = acc[ai][1][m][0] * sc, v1 = acc[ai][1][m][1] * sc;
                  *(u32x4*)(Vb + ((size_t)(b * 8 + u.pn) * KEYS + kpos) * 128 + d) = (u32x4){cvt_pk(v0[0], v0[1]), cvt_pk(v0[2], v0[3]), cvt_pk(v1[0], v1[1]), cvt_pk(v1[2], v1[3])}; } }
    } };

DEVI void phase_l2(const Params& p, int l, char* smem) {
    const bf16_t* P = (const bf16_t*)(p.ws + WS_P);
    float* rsq = (float*)(smem + 131072); float* rskv = rsq + 4 * 256;
    const float* rax = (const float*)(p.ws + WS_RAX);
    const int nqm = (l == 0) ? 36 : 32, nq = nqm * 6, nkv = 36 * 8, nsc = 2 * 16 * NCH;
    const pg8::PlainSched Sq{P, (const bf16_t*)(p.ws + WS_WUQ) + (size_t)l * 1536 * 512, INC, C_CQ, 512, nqm, 6, nq};
    const pg8::PlainSched Skv{P, (const bf16_t*)(p.ws + WS_WUKV) + (size_t)l * 2048 * 256, INC, C_CKV, 256, 36, 8, nkv};
    for (int i = 0; i < 4; ++i) { pg8::Unit u; if (Sq.next(i, u)) rstd_table<512>(P, u.pm * 256, C_CQ, rsq + i * 256); }
    for (int i = 0; i < 4; ++i) { pg8::Unit u; if (Skv.next(i, u)) rstd_table<256>(P, u.pm * 256, C_CKV, rskv + i * 256); }
#ifndef L2_GEMM_REP
#define L2_GEMM_REP 1
#endif
#ifndef L2_SCAN_REP
#define L2_SCAN_REP 1
#endif
#pragma nounroll
    for (int rep = 0; rep < L2_GEMM_REP; ++rep) {
    SUB(0) { pg8::gemm_phase((LAS unsigned char*)smem, 512, Sq, EpiQ{(bf16_t*)(p.ws + WS_Q), rsq, rax}); }
    SUB(1) { pg8::gemm_phase((LAS unsigned char*)smem, 256, Skv, EpiKV{(bf16_t*)(p.ws + WS_K), (bf16_t*)(p.ws + WS_V), rskv}); }
    }
    for (int i = 0; i < 4; ++i) {
        pg8::Unit uk; if (!Skv.next(i, uk)) break;
        const int pm = uk.pm, pn = uk.pn;
        bf16_t* Kb = (bf16_t*)(p.ws + WS_K);
        const int tid = opaque_tid(), rl = tid >> 1, half = tid & 1, row = pm * 256 + rl;
        const bool lat = row < NLAT; const int b = lat ? (row >> 11) : ((row - NLAT) >> 8); const int t = lat ? (row & 2047) : ((row - NLAT) & 255);
        const int kpos = lat ? (CL + t) : t;
        bf16_t* dst = Kb + ((size_t)(b * 8 + pn) * KEYS + kpos) * 192 + 128 + half * 32;
#pragma unroll
        for (int q = 0; q < 4; ++q) {
            float f[8]; unpack8(*(const bf16x8*)(P + (size_t)row * INC + C_KR + half * 32 + q * 8), f);
            if (lat) {
#pragma unroll
                for (int e = 0; e < 4; ++e) { const int pi = half * 16 + q * 4 + e; const int pos = (pi < 16) ? (t >> 6) : (t & 63);
                    const f32x2 cs = *(const f32x2*)(rax + (pos * 16 + (pi & 15)) * 2);
                    const float x1 = f[2 * e], x2 = f[2 * e + 1]; f[2 * e] = x1 * cs[0] - x2 * cs[1]; f[2 * e + 1] = x1 * cs[1] + x2 * cs[0]; }
            }
            *(bf16x8*)(dst + q * 8) = pack8(f);
        }
    }
    __syncthreads();
    {
        const int G = gridDim.x, nG = 16 * NCH;
        int u = (obid() + (G >> 1)) % G;
        {   GlaIn cur; bool have = u < nG;
            if (have) gla_load(p, l, (u / NCH) >> 2, (u / NCH) & 3, u % NCH, false, cur);
            while (have) { const int un = u + G; const bool hn = un < nG; GlaIn nxt;
                if (hn) gla_load(p, l, (un / NCH) >> 2, (un / NCH) & 3, un % NCH, false, nxt);
                CvtIn ci; cvt8_load(p, l, (l == 0 ? TS0A : TS1A) + u, ci);
                SUB(2) scan_a_gla(p, l, (u / NCH) >> 2, (u / NCH) & 3, u % NCH, cur, smem);
                cvt8_finish(p, l, (l == 0 ? TS0A : TS1A) + u, ci, smem);
                cur = nxt; u = un; have = hn; } }
        {   RetIn cur; bool have = u < nsc;
            if (have) { const int r = u - nG; ret_load(p, (r / NCH) >> 2, (r / NCH) & 3, r % NCH, false, cur); }
            while (have) { const int un = u + G; const bool hn = un < nsc; RetIn nxt; const int r = u - nG, rn = un - nG;
                if (hn) ret_load(p, (rn / NCH) >> 2, (rn / NCH) & 3, rn % NCH, false, nxt);
                CvtIn ci; cvt8_load(p, l, (l == 0 ? TS0A : TS1A) + u, ci);
                SUB(3) scan_a_ret(p, l, (r / NCH) >> 2, (r / NCH) & 3, r % NCH, cur, smem);
                cvt8_finish(p, l, (l == 0 ? TS0A : TS1A) + u, ci, smem);
                cur = nxt; u = un; have = hn; } }
    }
}

DEVI void phase_l4(const Params& p, int l, char* smem) {
    const bf16_t* Q = (const bf16_t*)(p.ws + WS_Q); const bf16_t* Kb = (const bf16_t*)(p.ws + WS_K); const bf16_t* Vb = (const bf16_t*)(p.ws + WS_V);
    bf16_t* ymix = (bf16_t*)(p.ws + WS_YMIX);
    const int nal = 256, nac = (l == 0) ? 32 : 0, ncs = (l == 0) ? NCH : 32, nsc = 2 * 16 * ncs;
#ifndef L4_ATT_REP
#define L4_ATT_REP 1
#endif
#ifndef L4_SCAN_REP
#define L4_SCAN_REP 1
#endif
    const bool spec = gridDim.x == 256;
    const bool conv = spec && obid() >= 256 - L4NC, dbl = spec && !conv && obid() >= 256 - 2 * L4NC;
    if (!spec) phase_prefix(p, smem, obid(), gridDim.x);
    else if (!conv && !dbl) phase_prefix(p, smem, obid(), 256 - 2 * L4NC);
    asm volatile("s_waitcnt vmcnt(0)" ::: "memory");
    __syncthreads();
    if (threadIdx.x == 0) { __builtin_amdgcn_fence(__ATOMIC_RELEASE, "agent"); asm volatile("s_waitcnt vmcnt(0)" ::: "memory");
        __hip_atomic_fetch_add((unsigned*)(p.ws + WS_BAR) + PFXCNT_WORD + 64 * l, 1u, __ATOMIC_RELAXED, __HIP_MEMORY_SCOPE_AGENT); }
    if (conv) { const int w = obid() - (256 - L4NC);
        if (l == 0) { cvt8_stream3(p, 0, T0C + w, L4NC, L4C0_PER, smem); cvt8_stream3(p, 1, T1C + w, L4NC, L4C1_PER, smem); }
        else cvt8_stream3(p, 1, T1D0 + w, L4NC, L4C2_PER, smem);
        return; }
#pragma nounroll
    for (int rep = 0; rep < L4_ATT_REP; ++rep)
#pragma nounroll
    for (int it = 0; ; ++it) {
        int u;
        if (!spec) { u = obid() + it * gridDim.x; if (u >= nal + nac) break; }
        else { if (it >= 2) break; u = (it == 0) ? obid() : (obid() < nac ? nal + obid() : (dbl ? obid() + L4NC : -1)); if (u < 0) break; }
        if (u < nal) { SUB(4) {
            const int bh = u >> 3, qb = u & 7, b = bh >> 3, h = bh & 7;
            att::attn_body(Q + ((size_t)bh * KEYS + CL + qb * 256) * 192, Kb + (size_t)bh * KEYS * 192, Vb + (size_t)bh * KEYS * 128,
                           ymix + (size_t)(b * SEQ + qb * 256) * DM + h * 128, KEYS, smem);
        } } else { SUB(4) {
            const int bh = u - nal, b = bh >> 3, h = bh & 7;
            att::attn_body(Q + (size_t)bh * KEYS * 192, Kb + (size_t)bh * KEYS * 192, Vb + (size_t)bh * KEYS * 128,
                           ymix + (size_t)(NLAT + b * CL) * DM + h * 128, CL, smem);
        } }
    }
    if (dbl) return;
    if (threadIdx.x == 0) {
        unsigned* c = (unsigned*)(p.ws + WS_BAR) + PFXCNT_WORD + 64 * l; unsigned sp = 0;
        while (__hip_atomic_load(c, __ATOMIC_RELAXED, __HIP_MEMORY_SCOPE_AGENT) < gridDim.x) { __builtin_amdgcn_s_sleep(2); if (++sp > (1u << 22)) break; }
        __builtin_amdgcn_fence(__ATOMIC_ACQUIRE, "agent");
        asm volatile("s_waitcnt vmcnt(0)" ::: "memory");
    }
    __syncthreads();
    {
        const int G = spec ? 256 - 2 * L4NC : gridDim.x, nG = 16 * ncs, c0 = NCH - ncs;
        int u = spec ? obid() : (obid() + G - (nal + nac) % G) % G;
        {   GlaIn cur; bool have = u < nG;
            if (have) gla_load(p, l, (u / ncs) >> 2, (u / ncs) & 3, u % ncs + c0, true, cur);
            while (have) { const int un = u + G; const bool hn = un < nG; GlaIn nxt;
                if (hn) gla_load(p, l, (un / ncs) >> 2, (un / ncs) & 3, un % ncs + c0, true, nxt);
                CvtIn ci; cvt8_load(p, l, (l == 0 ? TS0C : TS1C) + u, ci);
                SUB(5) scan_c_gla(p, l, (u / ncs) >> 2, (u / ncs) & 3, u % ncs + c0, cur, smem);
                cvt8_finish(p, l, (l == 0 ? TS0C : TS1C) + u, ci, smem);
                cur = nxt; u = un; have = hn; } }
        {   RetIn cur; bool have = u < nsc;
            if (have) { const int r = u - nG; ret_load(p, (r / ncs) >> 2, (r / ncs) & 3, r % ncs + c0, true, cur); }
            while (have) { const int un = u + G; const bool hn = un < nsc; RetIn nxt; const int r = u - nG, rn = un - nG;
                if (hn) ret_load(p, (rn / ncs) >> 2, (rn / ncs) & 3, rn % ncs + c0, true, nxt);
                CvtIn ci; cvt8_load(p, l, (l == 0 ? TS0C : TS1C) + u, ci);
                SUB(6) scan_c_ret(p, l, (r / ncs) >> 2, (r / ncs) & 3, r % ncs + c0, cur, smem);
                cvt8_finish(p, l, (l == 0 ? TS0C : TS1C) + u, ci, smem);
                cur = nxt; u = un; have = hn; } }
    }
}

struct EpiOut { static constexpr bool PERM = true; const Params* pp; int l;
    DEVI void operator()(const f32x4 (&acc)[2][2][4][2], const pg8::Unit& u, int wr, int wc, int fr, int fq) const {
        const Params& p = *pp; bf16_t* xres = (bf16_t*)(p.ws + WS_XRES);
        const float* mod = (const float*)(p.ws + WS_MOD) + (size_t)l * 5 * 12288;
#pragma unroll
        for (int ai = 0; ai < 2; ++ai)
#pragma unroll
            for (int m = 0; m < 4; ++m) { const int row = u.pm * 256 + ai * 128 + wr * 64 + m * 16 + fr;
                const bool lat = row < NLAT; const int b = lat ? (row >> 11) : 4;
                const float* xin = lat ? p.x + (size_t)row * DM : p.ctx + (size_t)(row - NLAT) * DM;
                const float* ga = mod + (size_t)b * 12288 + 4096;
#pragma unroll
                for (int bj = 0; bj < 2; ++bj) { const int col = u.pn * 256 + bj * 128 + wc * 32 + 8 * fq;
                    f32x4 x0, x1;
                    if (l == 0) { x0 = *(const f32x4*)(xin + col); x1 = *(const f32x4*)(xin + col + 4); }
                    else { const u32x4 w = *(const u32x4*)(xres + (size_t)row * DM + col);
                        x0 = (f32x4){bflo(w[0]), bfhi(w[0]), bflo(w[1]), bfhi(w[1])}; x1 = (f32x4){bflo(w[2]), bfhi(w[2]), bflo(w[3]), bfhi(w[3])}; }
                    const f32x4 g0 = *(const f32x4*)(ga + col), g1 = *(const f32x4*)(ga + col + 4);
                    const f32x4 r0 = x0 + g0 * acc[ai][bj][m][0], r1 = x1 + g1 * acc[ai][bj][m][1];
                    *(u32x4*)(xres + (size_t)row * DM + col) = (u32x4){cvt_pk(r0[0], r0[1]), cvt_pk(r0[2], r0[3]), cvt_pk(r1[0], r1[1]), cvt_pk(r1[2], r1[3])}; }
                __builtin_amdgcn_sched_barrier(0); }
    } };
DEVI void phase_wout(const Params& p, int l, char* smem) {
    const int nm = (l == 0) ? 36 : 32;
    pg8::PlainSched S{(const bf16_t*)(p.ws + WS_YMIX), (const bf16_t*)(p.ws + WS_WOUT) + (size_t)l * 2048 * 2048, DM, 0, 2048, nm, 8, nm * 8};
    pg8::gemm_phase((LAS unsigned char*)smem, 2048, S, EpiOut{&p, l});
    if (l == 0) tail_convert(p, 0, TAIL_WOUT_B0, T0A, TAILT_WOUT, smem);
}

template <int N>
DEVI void bitonic_desc(unsigned long long* key, int tid) {
    for (int k = 2; k <= N; k <<= 1)
        for (int j = k >> 1; j > 0; j >>= 1) {
            for (int t = tid; t < N / 2; t += 512) {
                const int i = ((t & ~(j - 1)) << 1) | (t & (j - 1)), q = i | j;
                const unsigned long long a = key[i], b = key[q];
                const bool desc = (i & k) == 0;
                if (desc ? (a < b) : (a > b)) { key[i] = b; key[q] = a; }
            }
            __syncthreads();
        }
}
DEVI void phase_rank(const Params& p, int l, char* smem) {
    unsigned long long* key = (unsigned long long*)smem;
    const float* aff = (const float*)(p.ws + WS_AFF);
    int* rank = (int*)(p.ws + WS_RANK); int* selrow = (int*)(p.ws + WS_SELROW); float* selgate = (float*)(p.ws + WS_SELGATE);
    const int tid = opaque_tid();
    const int nl = 64, nc = (l == 0) ? 64 : 0;
#ifndef RANK_REP
#define RANK_REP 1
#endif
#pragma nounroll
    for (int rep = 0; rep < RANK_REP; ++rep)
    for (int u = obid(); u < nl + nc; u += (gridDim.x == 256 ? 64 : gridDim.x)) {
        if (gridDim.x == 256 && obid() >= 64) break;
        if (u < nl) {
            const int be = u, b = be >> 4, e = be & 15;
            const float* a = aff + (size_t)be * KEYS;
            for (int i = tid; i < 2048; i += 512) key[i] = ((unsigned long long)__float_as_uint(a[i]) << 32) | (unsigned)(2047 - i);
            __syncthreads();
            bitonic_desc<2048>(key, tid);
            for (int pos = tid; pos < 2048; pos += 512) { const unsigned long long kv = key[pos]; const int i = 2047 - (int)(unsigned)(kv & 0xffffffffull);
                rank[(size_t)be * KEYS + i] = pos;
                if (pos < 256) { selrow[e * MSLOT + b * 256 + pos] = b * SEQ + i; selgate[e * MSLOT + b * 256 + pos] = __uint_as_float((unsigned)(kv >> 32)); } }
            __syncthreads();
        } else {
            const int be = u - nl, b = be >> 4, e = be & 15;
            const float* a = aff + (size_t)be * KEYS + SEQ;
            if (tid < 256) key[tid] = ((unsigned long long)__float_as_uint(a[tid]) << 32) | (unsigned)(255 - tid);
            __syncthreads();
            bitonic_desc<256>(key, tid);
            if (tid < 256) { const int pos = tid; const unsigned long long kv = key[pos]; const int i = 255 - (int)(unsigned)(kv & 0xffffffffull);
                rank[(size_t)be * KEYS + SEQ + i] = pos;
                if (pos < 32) { selrow[e * MSLOT + 1024 + b * 32 + pos] = NLAT + b * CL + i; selgate[e * MSLOT + 1024 + b * 32 + pos] = __uint_as_float((unsigned)(kv >> 32)); } }
            __syncthreads();
        }
    }
    if (gridDim.x == 256) {
        const int first = 64, bid = obid();
        const int nt = (l == 0) ? RANKT0 : RANKT1;
        if (bid >= first) cvt8_stream3(p, l, ((l == 0) ? T0B : T1B) + (bid - first), 256 - first, nt, smem);
    }
}

struct MoeGuSched { const bf16_t* hbuf; const bf16_t* Wgu; const int* selrow; int mvalid, nmt, units;
    DEVI bool next(int i, pg8::Unit& u) const {
        const int g = obid() + i * gridDim.x; if (g >= units) return false;
        int e, pm, pn;
        if (gridDim.x == 256) {
            const int c = g & 255, q = (g >> 8) * 32 + (c >> 3), per = nmt * 16, r = q % per, rr = r % (nmt * 4);
            e = 2 * (c & 7) + q / per; pm = rr % nmt; pn = (r / (nmt * 4)) * 4 + rr / nmt;
        } else { e = g / (nmt * 16); const int r = g % (nmt * 16); pm = r / 16; pn = r % 16; }
        u.e = e; u.pm = pm; u.pn = pn; u.ord = i; u.half = (nmt == 5 && pm == 4) ? 1 : 0;
        u.A = (const char*)hbuf; u.B = (const char*)Wgu + ((size_t)e * 4096 + u.pn * 256) * 2048; return true; }
    DEVI unsigned one(const pg8::Unit& u, int R, int C) const { const int slot = u.pm * 256 + R; const int row = (slot < mvalid) ? selrow[u.e * MSLOT + slot] : 0; return (unsigned)(row * (DM / 2) + C) * 2u; }
    DEVI void aoff(const pg8::Unit& u, int R0, int C0, int R1, int C1, unsigned (&o)[4]) const { o[0] = one(u, R0, C0); o[1] = one(u, R1, C1); o[2] = one(u, 128 + R0, C0); o[3] = one(u, 128 + R1, C1); }
};
struct EpiGU { static constexpr bool PERM = true; bf16_t* actb; int mvalid;
    DEVI void operator()(const f32x4 (&acc)[2][2][4][2], const pg8::Unit& u, int wr, int wc, int fr, int fq) const {
#pragma unroll
        for (int ai = 0; ai < 2; ++ai)
#pragma unroll
            for (int m = 0; m < 4; ++m) { const int slot = u.pm * 256 + ai * 128 + wr * 64 + m * 16 + fr;
                if (slot < mvalid) { const int col = u.pn * 128 + wc * 32 + 8 * fq;
                    constexpr float is = 1.f / W8_SCALE, us = ACT8_SCALE / W8_SCALE;
                    const f32x4 g0 = acc[ai][0][m][0] * is, g1 = acc[ai][0][m][1] * is, u0 = acc[ai][1][m][0] * us, u1 = acc[ai][1][m][1] * us;
                    *(u32x2*)((unsigned char*)actb + ((size_t)u.e * MSLOT + slot) * DM + col) = (u32x2){cvt4_fp8c(silu_f(g0[0]) * u0[0], silu_f(g0[1]) * u0[1], silu_f(g0[2]) * u0[2], silu_f(g0[3]) * u0[3]),
                                                                                                    cvt4_fp8c(silu_f(g1[0]) * u1[0], silu_f(g1[1]) * u1[1], silu_f(g1[2]) * u1[2], silu_f(g1[3]) * u1[3])}; } }
    } };
DEVI void phase_moe_gu(const Params& p, int l, char* smem) {
    const int mvalid = (l == 0) ? 1152 : 1024, nmt = (l == 0) ? 5 : 4;
    MoeGuSched S{(const bf16_t*)(p.ws + WS_H), (const bf16_t*)((const char*)(p.ws + WS_WGU) + (size_t)l * 16 * 4096 * 2048), (const int*)(p.ws + WS_SELROW), mvalid, nmt, 16 * nmt * 16};
    pg8::gemm_phase<MoeGuSched, EpiGU, true>((LAS unsigned char*)smem, 1024, S, EpiGU{(bf16_t*)(p.ws + WS_ACT), mvalid});
}
struct MoeDnSched { const bf16_t* actb; const bf16_t* Wdn; int nmt, units;
    DEVI bool next(int i, pg8::Unit& u) const {
        const int g = obid() + i * gridDim.x; if (g >= units) return false;
        int e, pm, pn;
        if (gridDim.x == 256 && nmt == 4) {
            const int c = g & 255, q = (g >> 8) * 32 + (c >> 3), per = nmt * 8, r = q % per, rr = r % (nmt * 4);
            e = 2 * (c & 7) + q / per; pm = rr % nmt; pn = (r / (nmt * 4)) * 4 + rr / nmt;
        } else { e = g / (nmt * 8); const int r = g % (nmt * 8); pm = r / 8; pn = r % 8; }
        u.e = e; u.pm = pm; u.pn = pn; u.ord = i; u.half = (nmt == 5 && pm == 4) ? 1 : 0;
        u.A = (const char*)actb + ((size_t)e * MSLOT + u.pm * 256) * DM; u.B = (const char*)Wdn + ((size_t)e * 2048 + u.pn * 256) * 2048; return true; }
    DEVI void aoff(const pg8::Unit&, int R0, int C0, int R1, int C1, unsigned (&o)[4]) const {
        o[0] = (unsigned)(R0 * (DM / 2) + C0) * 2u; o[1] = (unsigned)(R1 * (DM / 2) + C1) * 2u; o[2] = (unsigned)((128 + R0) * (DM / 2) + C0) * 2u; o[3] = (unsigned)((128 + R1) * (DM / 2) + C1) * 2u; }
};
struct EpiDN { static constexpr bool PERM = true; bf16_t* ydn; const float* selgate; int mvalid;
    DEVI void operator()(const f32x4 (&acc)[2][2][4][2], const pg8::Unit& u, int wr, int wc, int fr, int fq) const {
#pragma unroll
        for (int ai = 0; ai < 2; ++ai)
#pragma unroll
            for (int m = 0; m < 4; ++m) { const int slot = u.pm * 256 + ai * 128 + wr * 64 + m * 16 + fr;
                if (slot < mvalid) { const float gt = selgate[u.e * MSLOT + slot] * (1.f / (W8_SCALE * ACT8_SCALE));
#pragma unroll
                    for (int bj = 0; bj < 2; ++bj) { const int col = u.pn * 256 + bj * 128 + wc * 32 + 8 * fq; const f32x4 v0 = acc[ai][bj][m][0] * gt, v1 = acc[ai][bj][m][1] * gt;
                        *(u32x4*)(ydn + ((size_t)u.e * MSLOT + slot) * DM + col) = (u32x4){cvt_pk(v0[0], v0[1]), cvt_pk(v0[2], v0[3]), cvt_pk(v1[0], v1[1]), cvt_pk(v1[2], v1[3])}; } } }
    } };
DEVI void phase_moe_dn(const Params& p, int l, char* smem) {
    const int mvalid = (l == 0) ? 1152 : 1024, nmt = (l == 0) ? 5 : 4;
    MoeDnSched S{(const bf16_t*)(p.ws + WS_ACT), (const bf16_t*)((const char*)(p.ws + WS_WDN) + (size_t)l * 16 * 2048 * 2048), nmt, 16 * nmt * 8};
    pg8::gemm_phase<MoeDnSched, EpiDN, true>((LAS unsigned char*)smem, 1024, S, EpiDN{(bf16_t*)(p.ws + WS_YDN), (const float*)(p.ws + WS_SELGATE), mvalid});
    if (l == 0) tail_convert(p, 1, TAIL_DN_B0, 0, TAILT_DN, smem);
}

constexpr int NPHASE = 2 + 2 * 10;
__global__ void __launch_bounds__(512, 2) mega(Params p) {
    extern __shared__ __attribute__((aligned(1024))) char smem[];
    if (threadIdx.x == 0) *(uint4*)(smem + LDS_XB) = make_uint4(0u, 0u, 0u, 0u);
    __syncthreads();
    XcdBarrier bar = xcd_barrier_post((unsigned*)(p.ws + WS_BAR), (volatile LAS unsigned*)(smem + LDS_XB));
#ifndef PHMASK
#define PHMASK 0xFFFF
#endif
#ifndef PROBE_DUP
#define PROBE_DUP 0
#endif
#define RUN(bit, k, call) do { if constexpr ((PHMASK >> (bit)) & 1) { if ((k) >= p.ph_lo && (k) < p.ph_hi) { call; \
    if constexpr ((PROBE_DUP >> (bit)) & 1) { if ((bit) != 6 || l_probe == 0) { xcd_barrier(bar); call; } } \
    if ((k) + 1 < p.ph_hi) xcd_barrier(bar); } } } while (0)
    int l_probe = 0;
    RUN(0, 0, (phase_p0(p, smem), wait_mod(p), phase_rows<0>(p, 0, smem)));
#ifdef PROBE_XBAR
    for (int i = 0; i < PROBE_XBAR; ++i) xcd_barrier(bar);
#endif
    for (int l = 0; l < 2; ++l) {
        const int k0 = 2 + l * 10; l_probe = l;
        RUN(2, k0 + 0, phase_win(p, l, smem));
        RUN(3, k0 + 1, phase_l2(p, l, smem));
        RUN(5, k0 + 3, phase_l4(p, l, smem));
        RUN(6, k0 + 4, phase_wout(p, l, smem));
        RUN(7, k0 + 5, phase_rows<1>(p, l, smem));
        RUN(8, k0 + 6, phase_rank(p, l, smem));
        RUN(9, k0 + 7, phase_moe_gu(p, l, smem));
        RUN(10, k0 + 8, phase_moe_dn(p, l, smem));
        if (l == 0) RUN(11, k0 + 9, phase_rows<2>(p, 0, smem)); else RUN(12, k0 + 9, phase_rows<3>(p, 1, smem));
    }
#undef RUN
}

extern "C" void kernel_launch(void* const* d_in, const int* in_sizes, int n_in, void* d_out, int out_size, void* d_ws, size_t ws_size, hipStream_t stream) {
    static int grid = 0;
    if (!grid) {
        if (ws_size < WS_END) { fprintf(stderr, "kernel_launch: workspace too small: %zu < %zu\n", ws_size, (size_t)WS_END); return; }
        if (hipFuncSetAttribute((const void*)mega, hipFuncAttributeMaxDynamicSharedMemorySize, LDS_BYTES) != hipSuccess) { fprintf(stderr, "kernel_launch: LDS attribute failed\n"); return; }
        int dev = 0, cus = 0, per_cu = 0;
        hipGetDevice(&dev);
        hipDeviceGetAttribute(&cus, hipDeviceAttributeMultiprocessorCount, dev);
        hipOccupancyMaxActiveBlocksPerMultiprocessor(&per_cu, (const void*)mega, 512, LDS_BYTES);
        if (per_cu < 1) { fprintf(stderr, "kernel_launch: occupancy query says 0\n"); return; }
        grid = cus;
    }
    Params p{};
    p.x = (const float*)d_in[0]; p.c = (const float*)d_in[1]; p.ctx = (const float*)d_in[2]; p.c_ctx = (const float*)d_in[3];
    p.ada_w = (const float*)d_in[4]; p.ada_b = (const float*)d_in[5]; p.w_in = (const float*)d_in[6]; p.q_norm = (const float*)d_in[7];
    p.w_uq = (const float*)d_in[8]; p.kv_norm = (const float*)d_in[9]; p.w_ukv = (const float*)d_in[10]; p.gla_w2 = (const float*)d_in[11];
    p.gla_b = (const float*)d_in[12]; p.w_out = (const float*)d_in[13]; p.router_w = (const float*)d_in[14]; p.w_gate = (const float*)d_in[15];
    p.w_up = (const float*)d_in[16]; p.w_down = (const float*)d_in[17]; p.final_norm = (const float*)d_in[18];
    p.out = (float*)d_out; p.ws = (char*)d_ws;
    hipMemsetAsync((char*)d_ws + WS_BAR, 0, 16384, stream);
#if MK_ONE_LAUNCH
    p.ph_lo = 0; p.ph_hi = NPHASE;
    hipLaunchKernelGGL(mega, dim3(grid), dim3(512), LDS_BYTES, stream, p);
#else
    for (int k = 0; k < NPHASE; ++k) { p.ph_lo = k; p.ph_hi = k + 1; hipLaunchKernelGGL(mega, dim3(grid), dim3(512), LDS_BYTES, stream, p); }
#endif
    const hipError_t le = hipPeekAtLastError();
    if (le != hipSuccess) fprintf(stderr, "kernel_launch: launch failed: %s\n", hipGetErrorName(le));
}
```
